# Optimizing an MI355X kernel written in HIP

```python
import jax, jax.numpy as jnp
from jax import lax
import numpy as np

D_MODEL = 1024
BATCH = 16
SEQ = 2048
DEPTH = 1
DEC_BATCH = 8
DEC_SEQ = 4096
PAST_LEN = 128

HEAD_DIM = 64
N_HEADS_A = D_MODEL // (2 * HEAD_DIM)
N_HEADS_B = D_MODEL // (2 * HEAD_DIM)
N_KV_B = 2
GQA_GROUP = N_HEADS_B // N_KV_B
WIDTH_A = N_HEADS_A * HEAD_DIM
WIDTH_B = N_HEADS_B * HEAD_DIM
MIX_WIDTH = WIDTH_A + WIDTH_B
KV_WIDTH_B = N_KV_B * HEAD_DIM
IN_COLS = 3 * WIDTH_A + WIDTH_B + 2 * KV_WIDTH_B
DILATED_BRANCHES = ((128, 1), (512, 4), (2048, 16))
WINDOW_B = 128
BLOCK_B = 128
ROPE_THETA = 500000.0
ROPE_DIM = HEAD_DIM // 4
D_FF = 4 * D_MODEL
EPS = 1e-6
NEG_BIG = -1e30

kernel_name = "hymba_dilated_swa_encoder"


def rmsnorm(x, g):
    xf = x.astype(jnp.float32)
    y = xf * lax.rsqrt(jnp.mean(xf * xf, axis=-1, keepdims=True) + EPS)
    return (y * g.astype(jnp.float32)).astype(x.dtype)


def partial_rope(x, pos):
    half = ROPE_DIM // 2
    inv = ROPE_THETA ** (-jnp.arange(half, dtype=jnp.float32) * 2.0 / ROPE_DIM)
    ang = pos[:, None] * inv[None, :]
    cos = jnp.cos(ang)[None, :, None, :]
    sin = jnp.sin(ang)[None, :, None, :]
    xf = x.astype(jnp.float32)
    x1, x2, xp = xf[..., :half], xf[..., half:ROPE_DIM], xf[..., ROPE_DIM:]
    out = jnp.concatenate([x1 * cos - x2 * sin, x2 * cos + x1 * sin, xp], axis=-1)
    return out.astype(x.dtype)


def banded_attention(q, k, v, half_window, block, sink=None):
    N, L, Hq, dh = q.shape
    Hk = k.shape[2]
    G = Hq // Hk
    nb = -(-L // block)
    Lp = nb * block
    pad = Lp - L
    qb = jnp.pad(q, ((0, 0), (0, pad), (0, 0), (0, 0))).reshape(N, nb, block, Hk, G, dh)
    kp = jnp.pad(k, ((0, 0), (block, pad + block), (0, 0), (0, 0))).reshape(N, nb + 2, block, Hk, dh)
    vp = jnp.pad(v, ((0, 0), (block, pad + block), (0, 0), (0, 0))).reshape(N, nb + 2, block, Hk, dh)
    kw = jnp.concatenate([kp[:, :-2], kp[:, 1:-1], kp[:, 2:]], axis=2)
    vw = jnp.concatenate([vp[:, :-2], vp[:, 1:-1], vp[:, 2:]], axis=2)
    a = jnp.arange(block)[None, :, None]
    c = jnp.arange(3 * block)[None, None, :]
    j = jnp.arange(nb)[:, None, None]
    qpos = j * block + a
    kpos = j * block + c - block
    mask = (jnp.abs(qpos - kpos) <= half_window) & (kpos >= 0) & (kpos < L)
    s = jnp.einsum('nbqhgd,nbkhd->nbhgqk', qb, kw).astype(jnp.float32) * (dh ** -0.5)
    s = jnp.where(mask[None, :, None, None, :, :], s, NEG_BIG)
    m = jnp.max(s, axis=-1, keepdims=True)
    if sink is not None:
        sk = sink.astype(jnp.float32).reshape(1, 1, Hk, G, 1, 1)
        m = jnp.maximum(m, sk)
    p = jnp.exp(s - m)
    l = jnp.sum(p, axis=-1, keepdims=True)
    if sink is not None:
        l = l + jnp.exp(sk - m)
    o = jnp.einsum('nbhgqk,nbkhd->nbqhgd', p, vw.astype(jnp.float32))
    l_t = jnp.moveaxis(l[..., 0], 4, 2)
    lse = jnp.moveaxis((m + jnp.log(l))[..., 0], 4, 2)
    o = (o / l_t[..., None]).reshape(N, Lp, Hq, dh)[:, :L].astype(q.dtype)
    lse = lse.reshape(N, Lp, Hq)[:, :L]
    return o, lse


def to_dilated(t, d):
    B, S = t.shape[:2]
    t = jnp.moveaxis(t.reshape(B, S // d, d, *t.shape[2:]), 2, 1)
    return t.reshape(B * d, S // d, *t.shape[3:])


def from_dilated(t, d, B):
    Nd, M = t.shape[:2]
    t = jnp.moveaxis(t.reshape(B, d, M, *t.shape[2:]), 1, 2)
    return t.reshape(B, M * d, *t.shape[3:])


def dilated_attention(q, k, v):
    B = q.shape[0]
    outs, lses = [], []
    for window, dil in DILATED_BRANCHES:
        hw = window // (2 * dil)
        o, lse = banded_attention(to_dilated(q, dil), to_dilated(k, dil), to_dilated(v, dil), hw, hw)
        outs.append(from_dilated(o, dil, B))
        lses.append(from_dilated(lse, dil, B))
    wts = jax.nn.softmax(jnp.stack(lses, axis=0), axis=0)
    o = jnp.sum(wts[..., None] * jnp.stack(outs, axis=0).astype(jnp.float32), axis=0)
    return o.astype(q.dtype)


def encoder_layer(x, norm_attn, w_in, q_norm_a, k_norm_a, q_norm_b, k_norm_b, sink_b,
                  out_norm_a, out_norm_b, w_o, norm_mlp, w_up, w_down):
    B, S, _ = x.shape
    pos = jnp.arange(S, dtype=jnp.float32)
    xn = rmsnorm(x, norm_attn)
    h = xn @ w_in
    o0 = 0
    def take(width, heads):
        nonlocal o0
        t = h[..., o0:o0 + width].reshape(B, S, heads, HEAD_DIM)
        o0 += width
        return t
    q_a = take(WIDTH_A, N_HEADS_A)
    k_a = take(WIDTH_A, N_HEADS_A)
    v_a = take(WIDTH_A, N_HEADS_A)
    q_b = take(WIDTH_B, N_HEADS_B)
    k_b = take(KV_WIDTH_B, N_KV_B)
    v_b = take(KV_WIDTH_B, N_KV_B)
    q_a = partial_rope(rmsnorm(q_a, q_norm_a), pos)
    k_a = partial_rope(rmsnorm(k_a, k_norm_a), pos)
    q_b = partial_rope(rmsnorm(q_b, q_norm_b), pos)
    k_b = partial_rope(rmsnorm(k_b, k_norm_b), pos)
    o_a = dilated_attention(q_a, k_a, v_a).reshape(B, S, WIDTH_A)
    o_b, _ = banded_attention(q_b, k_b, v_b, WINDOW_B, BLOCK_B, sink=sink_b)
    o_b = o_b.reshape(B, S, WIDTH_B)
    mix = jnp.concatenate([rmsnorm(o_a, out_norm_a), rmsnorm(o_b, out_norm_b)], axis=-1)
    x = x + mix @ w_o
    hn = rmsnorm(x, norm_mlp)
    u = jax.nn.relu(hn @ w_up)
    return x + (u * u) @ w_down


def setup_inputs(seed: int = 0) -> dict:
    key = jax.random.key(seed)
    ks = jax.random.split(key, 16)
    f32 = jnp.float32
    def gain(k, n):
        return 1.0 + 0.01 * jax.random.normal(k, (DEPTH, n), f32)
    return {
        "x_prompt": jax.random.normal(ks[0], (BATCH, SEQ, D_MODEL), f32),
        "x_sample": jax.random.normal(ks[1], (DEC_BATCH, DEC_SEQ, D_MODEL), f32),
        "norm_attn": gain(ks[2], D_MODEL),
        "w_in": jax.random.normal(ks[3], (DEPTH, D_MODEL, IN_COLS), f32) * D_MODEL ** -0.5,
        "q_norm_a": gain(ks[4], HEAD_DIM),
        "k_norm_a": gain(ks[5], HEAD_DIM),
        "q_norm_b": gain(ks[6], HEAD_DIM),
        "k_norm_b": gain(ks[7], HEAD_DIM),
        "sink_b": 0.5 * jax.random.normal(ks[8], (DEPTH, N_HEADS_B), f32),
        "out_norm_a": gain(ks[9], WIDTH_A),
        "out_norm_b": gain(ks[10], WIDTH_B),
        "w_o": jax.random.normal(ks[11], (DEPTH, MIX_WIDTH, D_MODEL), f32) * MIX_WIDTH ** -0.5,
        "norm_mlp": gain(ks[12], D_MODEL),
        "w_up": jax.random.normal(ks[13], (DEPTH, D_MODEL, D_FF), f32) * D_MODEL ** -0.5,
        "w_down": jax.random.normal(ks[14], (DEPTH, D_FF, D_MODEL), f32) * D_FF ** -0.5,
    }


def reference(x_prompt, x_sample, norm_attn, w_in, q_norm_a, k_norm_a, q_norm_b, k_norm_b,
              sink_b, out_norm_a, out_norm_b, w_o, norm_mlp, w_up, w_down):
    yp = x_prompt
    ys = x_sample
    for l in range(DEPTH):
        params = (norm_attn[l], w_in[l], q_norm_a[l], k_norm_a[l], q_norm_b[l], k_norm_b[l],
                  sink_b[l], out_norm_a[l], out_norm_b[l], w_o[l], norm_mlp[l], w_up[l], w_down[l])
        yp = encoder_layer(yp, *params)
        ys = encoder_layer(ys, *params)
    return (yp, ys)
```

```cpp
#include <hip/hip_runtime.h>
#include <hip/hip_cooperative_groups.h>
#include <cstdio>
#include <cstdint>
namespace cg = cooperative_groups;

typedef unsigned short bf16_t;
typedef short bf16x8 __attribute__((ext_vector_type(8)));
typedef float f32x4 __attribute__((ext_vector_type(4)));
typedef unsigned u32x4 __attribute__((ext_vector_type(4)));
typedef unsigned u32x2 __attribute__((ext_vector_type(2)));

constexpr int DM = 1024, NTOK = 65536, NPROMPT = 32768, INC = 2304, DFF = 4096;
constexpr float EPS = 1e-6f;
constexpr float LOG2E = 1.4426950408889634f;
constexpr float QSCALE = 0.18033688011112042f;

constexpr size_t MiB = 1048576;
constexpr size_t WS_WIN = 0, WS_WO = 4718592, WS_WUP = 6815744, WS_WD = 15204352, WS_RS1 = 23592960, WS_SSQ2 = 440 * MiB;
constexpr size_t WS_X = 24 * MiB;
constexpr size_t WS_QKV = 152 * MiB;
constexpr size_t WS_HB = 312 * MiB;
constexpr size_t WS_U = 24 * MiB;
constexpr size_t WS_SSQH = 444 * MiB;
constexpr size_t WS_BAR = 448 * MiB;
constexpr size_t WS_NEED = 449 * MiB;

constexpr int GEMM_LDS_BYTES = 131072, LDS_BYTES = GEMM_LDS_BYTES + 64;
constexpr bool GEMM_ALIGN = true, GEMM_SP2 = true;
constexpr int ATT_NACT = 8;
constexpr int ATT_SLOTS = 16 / ATT_NACT, ATT_LA = ATT_SLOTS - 1;

struct Params {
  const float *xp, *xs, *norm_attn, *w_in, *qna, *kna, *qnb, *knb, *sink, *ona, *onb, *w_o, *norm_mlp, *w_up, *w_down;
  float* out;
  unsigned char* ws;
};

extern __shared__ __attribute__((aligned(16))) unsigned char g_shm[];

typedef __bf16 bf16v2_t __attribute__((ext_vector_type(2)));
typedef float f32v2_t __attribute__((ext_vector_type(2)));
__device__ __forceinline__ unsigned pk2(float lo, float hi) { const f32v2_t f = {lo, hi}; const bf16v2_t b = __builtin_convertvector(f, bf16v2_t); return __builtin_bit_cast(unsigned, b); }
__device__ __forceinline__ float bf2f(unsigned short b) { return __uint_as_float(((unsigned)b) << 16); }
__device__ __forceinline__ f32x4 mfma16(bf16x8 a, bf16x8 b, f32x4 c) { return __builtin_amdgcn_mfma_f32_16x16x32_bf16(a, b, c, 0, 0, 0); }

__device__ __forceinline__ int col_slot(int c) { return 128 * ((c >> 3) & 1) + 32 * (c >> 6) + 16 * ((c >> 2) & 1) + 4 * ((c >> 4) & 3) + (c & 3); }

constexpr int BM = 256, BK = 64, HALF = 128, HT = HALF * BK;
__device__ __forceinline__ int lds_byte(int r, int c) {
  int st = (r >> 4) * 2 + (c >> 5), rr = r & 15, cc = c & 31, ob = rr * 64 + cc * 2;
  return st * 1024 + (ob ^ (((ob >> 9) & 1) << 5));
}
__device__ __forceinline__ void stage_rc(int b, int& R, int& C) {
  int st = b / 1024, sb = b % 1024, swz = sb ^ (((sb >> 9) & 1) << 5);
  R = (st >> 1) * 16 + swz / 64; C = (st & 1) * 32 + (swz % 64) / 2;
}

__device__ __forceinline__ bool tile_of(int L, int nM, int nN, int& pm, int& pn) {
  const int nwg = nM * nN; if (L >= nwg) return false;
  int wgid = L; { const int q = nwg / 8, r = nwg % 8, xcd = wgid % 8, off = wgid / 8; wgid = (xcd < r ? xcd * (q + 1) : r * (q + 1) + (xcd - r) * q) + off; }
  const int nig = 8 * nN, gid = wgid / nig, fm = gid * 8, gsz = (nM - fm) < 8 ? (nM - fm) : 8;
  pm = fm + ((wgid % nig) % gsz); pn = (wgid % nig) / gsz; return true;
}
#define LAS __attribute__((address_space(3)))
template <class Epi, bool ALIGN_EPI, bool SP2, bool MID = false>
__device__ __forceinline__ void gemm_phase(const bf16_t* __restrict__ Ag, const bf16_t* __restrict__ Btg, const int M, const int N, const int K, const Epi& E) {
  LAS unsigned char* lds = (LAS unsigned char*)g_shm;
  int tid = threadIdx.x; asm volatile("" : "+v"(tid));
  const int wid = __builtin_amdgcn_readfirstlane(tid >> 6), lane = tid & 63, wr = wid >> 2, wc = wid & 3, fr = lane & 15, fq = lane >> 4;
  const int nt = K / BK, nM = M / BM, nN = N / BM, G = gridDim.x, cu = blockIdx.x;
  constexpr int HTB = HALF * BK * 2;
  unsigned voff[2];
#pragma unroll
  for (int i = 0; i < 2; ++i) { int R, C; stage_rc(tid * 16 + i * 8192, R, C); voff[i] = (unsigned)(R * K + C) * 2u; }
  const size_t kstep = (size_t)(BK * 2), hstep = (size_t)HALF * K * 2, tstep = 2 * hstep;
  const unsigned ldsw = (unsigned)wid * 1024u;
  const int aoff = lds_byte(wr * 64 + fr, fq * 8), boff = lds_byte(wc * 32 + fr, fq * 8);
#define PG8_SA(b, h) (((b) * 2 + (h)) * HTB)
#define PG8_SB(b, h) ((4 + (b) * 2 + (h)) * HTB)
#define PG8_STAGE(bufoff, gbase) do { _Pragma("unroll") for (int _i = 0; _i < 2; ++_i) \
    __builtin_amdgcn_global_load_lds((const __attribute__((address_space(1))) unsigned*)((const char*)(gbase) + voff[_i]), (LAS unsigned*)(lds + (bufoff) + ldsw + _i * 8192), 16, 0, 0); } while (0)
#define PG8_LDA(dst, b, h) do { _Pragma("unroll") for (int m = 0; m < 4; ++m) _Pragma("unroll") for (int k = 0; k < 2; ++k) dst[m][k] = *(const LAS bf16x8*)(lds + PG8_SA(b, h) + aoff + m * 2048 + k * 1024); } while (0)
#define PG8_LDB(dst, b, h) do { _Pragma("unroll") for (int n = 0; n < 2; ++n) _Pragma("unroll") for (int k = 0; k < 2; ++k) dst[n][k] = *(const LAS bf16x8*)(lds + PG8_SB(b, h) + boff + n * 2048 + k * 1024); } while (0)
#define PG8_MMA(ai, bj, At, Bt) do { __builtin_amdgcn_s_setprio(1); _Pragma("unroll") for (int m = 0; m < 4; ++m) _Pragma("unroll") for (int n = 0; n < 2; ++n) _Pragma("unroll") for (int k = 0; k < 2; ++k) \
    acc[ai][bj][m][n] = __builtin_amdgcn_mfma_f32_16x16x32_bf16(Bt[n][k], At[m][k], acc[ai][bj][m][n], 0, 0, 0); __builtin_amdgcn_s_setprio(0); } while (0)
#define PG8_WAIT_V(n) asm volatile("s_waitcnt vmcnt(" #n ")" ::: "memory")
#define PG8_WAIT_L(n) asm volatile("s_waitcnt lgkmcnt(" #n ")" ::: "memory")
#define PG8_BAR __builtin_amdgcn_s_barrier()
#define PG8_SCHED __builtin_amdgcn_sched_barrier(0)
  int cpm, cpn, npm = 0, npn = 0, ui = 0;
  if (!tile_of(cu, nM, nN, cpm, cpn)) return;
  f32x4 acc[2][2][4][2];
#pragma unroll
  for (int a = 0; a < 2; ++a)
#pragma unroll
    for (int b = 0; b < 2; ++b)
#pragma unroll
      for (int m = 0; m < 4; ++m)
#pragma unroll
        for (int n = 0; n < 2; ++n) acc[a][b][m][n] = (f32x4){0.f, 0.f, 0.f, 0.f};
  bf16x8 At[4][2], B0[2][2], B1[2][2];
  const char* cA = (const char*)Ag + (size_t)cpm * tstep; const char* cB = (const char*)Btg + (size_t)cpn * tstep;
  static_assert(SP2, "this body is the two-super-phase loop");
  PG8_STAGE(PG8_SB(0, 0), cB); PG8_STAGE(PG8_SB(0, 1), cB + hstep); PG8_STAGE(PG8_SA(0, 0), cA); PG8_STAGE(PG8_SA(0, 1), cA + hstep);
  PG8_STAGE(PG8_SB(1, 0), cB + kstep); PG8_STAGE(PG8_SA(1, 0), cA + kstep); PG8_STAGE(PG8_SB(1, 1), cB + hstep + kstep);
  if (wr == 1) PG8_BAR;
  PG8_WAIT_V(0); PG8_BAR;
  PG8_BAR;
#define K2_ITER(FIRST) do { \
      const bool last = (t == nt - 2); \
      const char* a1 = cA + (size_t)(t + 1) * kstep; \
      const char* a2 = last ? nA : cA + (size_t)(t + 2) * kstep; const char* b2 = last ? nB : cB + (size_t)(t + 2) * kstep; \
      const char* a3 = a2 + kstep; const char* b3 = b2 + kstep; \
      if constexpr (MID) { if (t == (nt >> 1)) E.mid(acc, cpm * BM); } \
      PG8_LDB(B0, 0, 0); PG8_LDB(B1, 0, 1); PG8_SCHED; PG8_LDA(At, 0, 0); PG8_STAGE(PG8_SA(1, 1), a1 + hstep); \
      if constexpr (!(FIRST)) PG8_WAIT_V(8); \
      PG8_WAIT_L(0); PG8_BAR; PG8_MMA(0, 0, At, B0); PG8_MMA(0, 1, At, B1); PG8_BAR; PG8_SCHED; \
      PG8_LDA(At, 0, 1); PG8_STAGE(PG8_SB(0, 0), b2); PG8_STAGE(PG8_SB(0, 1), b2 + hstep); PG8_STAGE(PG8_SA(0, 0), a2); \
      if constexpr (!(FIRST)) PG8_WAIT_V(8); \
      PG8_WAIT_L(0); PG8_BAR; PG8_MMA(1, 0, At, B0); PG8_MMA(1, 1, At, B1); PG8_BAR; PG8_SCHED; \
      PG8_LDB(B0, 1, 0); PG8_LDB(B1, 1, 1); PG8_SCHED; PG8_LDA(At, 1, 0); PG8_STAGE(PG8_SA(0, 1), a2 + hstep); \
      PG8_WAIT_V(8); PG8_WAIT_L(0); PG8_BAR; PG8_MMA(0, 0, At, B0); PG8_MMA(0, 1, At, B1); PG8_BAR; PG8_SCHED; \
      PG8_LDA(At, 1, 1); PG8_STAGE(PG8_SB(1, 0), b3); PG8_STAGE(PG8_SB(1, 1), b3 + hstep); PG8_STAGE(PG8_SA(1, 0), a3); \
      PG8_WAIT_V(8); PG8_WAIT_L(0); PG8_BAR; PG8_MMA(1, 0, At, B0); PG8_MMA(1, 1, At, B1); PG8_BAR; PG8_SCHED; \
    } while (0)
  for (;;) {
    const bool has_next = tile_of((ui + 1) * G + cu, nM, nN, npm, npn);
    const char* nA = has_next ? (const char*)Ag + (size_t)npm * tstep : cA; const char* nB = has_next ? (const char*)Btg + (size_t)npn * tstep : cB;
    { const int t = 0; K2_ITER(true); }
    for (int t = 2; t < nt; t += 2) K2_ITER(false);
    if constexpr (ALIGN_EPI) { if (wr == 0) PG8_BAR; }
    PG8_WAIT_V(0);
    E(acc, cpm * BM, cpn * BM, wr, wc, fr, fq);
    if (!has_next) break;
#pragma unroll
    for (int a = 0; a < 2; ++a)
#pragma unroll
      for (int b = 0; b < 2; ++b)
#pragma unroll
        for (int m = 0; m < 4; ++m)
#pragma unroll
          for (int n = 0; n < 2; ++n) acc[a][b][m][n] = (f32x4){0.f, 0.f, 0.f, 0.f};
    cpm = npm; cpn = npn; cA = nA; cB = nB; ++ui;
    if constexpr (ALIGN_EPI) { if (wr == 1) PG8_BAR; }
  }
  PG8_WAIT_V(0);
  if constexpr (!ALIGN_EPI) { if (wr == 0) PG8_BAR; }
  PG8_BAR;
#undef K2_ITER
#undef PG8_SA
#undef PG8_SB
#undef PG8_STAGE
#undef PG8_LDA
#undef PG8_LDB
#undef PG8_MMA
}

#define EPI_IDS \
    int tid_ = threadIdx.x; asm volatile("" : "+v"(tid_));     \
    const int wid_ = tid_ >> 6, lane_ = tid_ & 63, wr = wid_ >> 2, wc = wid_ & 3, fr = lane_ & 15, fq = lane_ >> 4;
#define PACK16(v, w0, w1) \
    w0.x = pk2(v[0], v[1]); w0.y = pk2(v[2], v[3]); w0.z = pk2(v[4], v[5]); w0.w = pk2(v[6], v[7]); \
    w1.x = pk2(v[8], v[9]); w1.y = pk2(v[10], v[11]); w1.z = pk2(v[12], v[13]); w1.w = pk2(v[14], v[15]);

struct EpiQKV {
  bf16_t* qkv; const float* rs1; const float *qna, *kna, *qnb, *knb;
  __device__ __forceinline__ void operator()(const f32x4 (&acc)[2][2][4][2], int brow, int bcol, int, int, int, int) const {
    EPI_IDS
    const int ct = bcol >> 8;
    const float* gp = nullptr; float extra = 1.f;
    if (ct < 2) { gp = qna; extra = QSCALE; } else if (ct < 4) gp = kna; else if (ct < 6) gp = nullptr; else if (ct < 8) { gp = qnb; extra = QSCALE; } else gp = (wc < 2) ? knb : nullptr;
    float gn[16];
    if (gp) {
#pragma unroll
      for (int i = 0; i < 16; ++i) gn[i] = gp[16 * fq + i] * extra;
    }
    float rsv[8];
#pragma unroll
    for (int r = 0; r < 8; ++r) rsv[r] = rs1[brow + (r >> 2) * HALF + wr * 64 + (r & 3) * 16 + fr];
    const int smask = (brow < NPROMPT) ? 2047 : 4095;
#pragma unroll
    for (int ai = 0; ai < 2; ++ai)
#pragma unroll
      for (int m = 0; m < 4; ++m) {
        const int row = brow + ai * HALF + wr * 64 + m * 16 + fr;
        const float rs = rsv[ai * 4 + m];
        float v[16];
#pragma unroll
        for (int bj = 0; bj < 2; ++bj)
#pragma unroll
          for (int n = 0; n < 2; ++n)
#pragma unroll
            for (int j = 0; j < 4; ++j) v[8 * bj + 4 * n + j] = acc[ai][bj][m][n][j] * rs;
        if (gp) {
          float ss = 0.f;
#pragma unroll
          for (int i = 0; i < 16; ++i) ss += v[i] * v[i];
          ss += __shfl_xor(ss, 16); ss += __shfl_xor(ss, 32);
          const float inv = rsqrtf(ss * (1.0f / 64.0f) + EPS);
#pragma unroll
          for (int i = 0; i < 16; ++i) v[i] = v[i] * inv * gn[i];
          if (fq == 0) {
            const float pos = (float)(row & smask);
#pragma unroll
            for (int i = 0; i < 8; ++i) {
              const float ci = i == 0 ? 1.5915494309e-01f : i == 1 ? 3.0863763405e-02f : i == 2 ? 5.9851857127e-03f : i == 3 ? 1.1606636412e-03f : i == 4 ? 2.2507907904e-04f : i == 5 ? 4.3647952793e-05f : i == 6 ? 8.4643308082e-06f : 1.6414262628e-06f;
              const float tr = __builtin_amdgcn_fractf(pos * ci);
              const float c = __builtin_amdgcn_cosf(tr), s = __builtin_amdgcn_sinf(tr);
              const float x1 = v[i], x2 = v[8 + i];
              v[i] = x1 * c - x2 * s; v[8 + i] = x2 * c + x1 * s;
            }
          }
        }
        u32x4 w0, w1; PACK16(v, w0, w1)
        bf16_t* dst = qkv + (size_t)row * INC + bcol + 64 * wc + 16 * fq;
        *(u32x4*)dst = w0; *(u32x4*)(dst + 8) = w1;
      }
  }
};

struct EpiWo {
  const float *xp, *xs; bf16_t* hb; float* ssq2p; const float* ssqh;
  __device__ __forceinline__ void scales(int row, float& sa, float& sb) const {
    const float* sp = ssqh + (size_t)row * 16;
    const f32x4 a = *(const f32x4*)sp, b = *(const f32x4*)(sp + 4), c = *(const f32x4*)(sp + 8), d = *(const f32x4*)(sp + 12);
    sa = rsqrtf((((a[0] + a[1]) + (a[2] + a[3])) + ((b[0] + b[1]) + (b[2] + b[3]))) * (1.0f / 512.0f) + EPS);
    sb = rsqrtf((((c[0] + c[1]) + (c[2] + c[3])) + ((d[0] + d[1]) + (d[2] + d[3]))) * (1.0f / 512.0f) + EPS);
  }
  __device__ __forceinline__ void mid(f32x4 (&acc)[2][2][4][2], int brow) const {
    EPI_IDS
    (void)wc; (void)fq;
#pragma unroll
    for (int ai = 0; ai < 2; ++ai)
#pragma unroll
      for (int m = 0; m < 4; ++m) {
        float sa, sb; scales(brow + ai * HALF + wr * 64 + m * 16 + fr, sa, sb);
        const float ratio = sa / sb;
#pragma unroll
        for (int bj = 0; bj < 2; ++bj)
#pragma unroll
          for (int n = 0; n < 2; ++n) acc[ai][bj][m][n] = acc[ai][bj][m][n] * ratio;
      }
  }
  __device__ __forceinline__ void operator()(const f32x4 (&acc)[2][2][4][2], int brow, int bcol, int, int, int, int) const {
    EPI_IDS
    const float* xbase = (brow < NPROMPT) ? (xp + (size_t)brow * DM) : (xs + (size_t)(brow - NPROMPT) * DM);
#pragma unroll
    for (int ai = 0; ai < 2; ++ai) {
      f32x4 xv[4][4]; float sbv[4];
#pragma unroll
      for (int m = 0; m < 4; ++m) {
        const int rl = ai * HALF + wr * 64 + m * 16 + fr;
        const float* xr = xbase + (size_t)rl * DM + bcol + 64 * wc + 16 * fq;
#pragma unroll
        for (int q = 0; q < 4; ++q) xv[m][q] = *(const f32x4*)(xr + 4 * q);
        float sa; scales(brow + rl, sa, sbv[m]);
      }
#pragma unroll
      for (int m = 0; m < 4; ++m) {
        const int rl = ai * HALF + wr * 64 + m * 16 + fr;
        float v[16]; float ss = 0.f;
#pragma unroll
        for (int bj = 0; bj < 2; ++bj)
#pragma unroll
          for (int n = 0; n < 2; ++n)
#pragma unroll
            for (int j = 0; j < 4; ++j) { const float h = xv[m][2 * bj + n][j] + acc[ai][bj][m][n][j] * sbv[m]; v[8 * bj + 4 * n + j] = h; ss += h * h; }
        ss += __shfl_xor(ss, 16); ss += __shfl_xor(ss, 32);
        if (fq == 0) ssq2p[(size_t)(brow + rl) * 16 + (bcol >> 8) * 4 + wc] = ss;
        u32x4 w0, w1; PACK16(v, w0, w1)
        bf16_t* dst = hb + (size_t)(brow + rl) * DM + bcol + 64 * wc + 16 * fq;
        *(u32x4*)dst = w0; *(u32x4*)(dst + 8) = w1;
      }
      __builtin_amdgcn_sched_barrier(0);
    }
  }
};

struct EpiUp {
  bf16_t* u; const float* ssq2p; int row_base;
  __device__ __forceinline__ void operator()(const f32x4 (&acc)[2][2][4][2], int brow, int bcol, int, int, int, int) const {
    EPI_IDS
    float s2v[8];
#pragma unroll
    for (int r = 0; r < 8; ++r) {
      const float* sp = ssq2p + (size_t)(row_base + brow + (r >> 2) * HALF + wr * 64 + (r & 3) * 16 + fr) * 16;
      const f32x4 a = *(const f32x4*)sp, b = *(const f32x4*)(sp + 4), c = *(const f32x4*)(sp + 8), d = *(const f32x4*)(sp + 12);
      const float tot = (((a[0] + a[1]) + (a[2] + a[3])) + ((b[0] + b[1]) + (b[2] + b[3]))) + (((c[0] + c[1]) + (c[2] + c[3])) + ((d[0] + d[1]) + (d[2] + d[3])));
      s2v[r] = rsqrtf(tot * (1.0f / DM) + EPS);
    }
#pragma unroll
    for (int ai = 0; ai < 2; ++ai)
#pragma unroll
      for (int m = 0; m < 4; ++m) {
        const int rl = brow + ai * HALF + wr * 64 + m * 16 + fr;
        const float s2 = s2v[ai * 4 + m];
        float v[16];
#pragma unroll
        for (int bj = 0; bj < 2; ++bj)
#pragma unroll
          for (int n = 0; n < 2; ++n)
#pragma unroll
            for (int j = 0; j < 4; ++j) { const float z = fmaxf(acc[ai][bj][m][n][j] * s2, 0.f); v[8 * bj + 4 * n + j] = z * z; }
        u32x4 w0, w1; PACK16(v, w0, w1)
        bf16_t* dst = u + (size_t)rl * DFF + bcol + 64 * wc + 16 * fq;
        *(u32x4*)dst = w0; *(u32x4*)(dst + 8) = w1;
      }
  }
};

struct EpiDown {
  const bf16_t* hb; float* out; int row_base;
  __device__ __forceinline__ void operator()(const f32x4 (&acc)[2][2][4][2], int brow, int bcol, int, int, int, int) const {
    EPI_IDS
#pragma unroll
    for (int ai = 0; ai < 2; ++ai) {
      u32x4 hv[4][2];
#pragma unroll
      for (int m = 0; m < 4; ++m) {
        const size_t off = (size_t)(row_base + brow + ai * HALF + wr * 64 + m * 16 + fr) * DM + bcol + 64 * wc + 16 * fq;
        hv[m][0] = *(const u32x4*)(hb + off); hv[m][1] = *(const u32x4*)(hb + off + 8);
      }
#pragma unroll
      for (int m = 0; m < 4; ++m) {
        const size_t off = (size_t)(row_base + brow + ai * HALF + wr * 64 + m * 16 + fr) * DM + bcol + 64 * wc + 16 * fq;
        float* dst = out + off;
#pragma unroll
        for (int bj = 0; bj < 2; ++bj)
#pragma unroll
          for (int n = 0; n < 2; ++n) {
            const unsigned a = hv[m][bj][2 * n], b = hv[m][bj][2 * n + 1];
            f32x4 o;
            o[0] = __uint_as_float(a << 16) + acc[ai][bj][m][n][0]; o[1] = __uint_as_float(a & 0xffff0000u) + acc[ai][bj][m][n][1];
            o[2] = __uint_as_float(b << 16) + acc[ai][bj][m][n][2]; o[3] = __uint_as_float(b & 0xffff0000u) + acc[ai][bj][m][n][3];
            *(f32x4*)(dst + 8 * bj + 4 * n) = o;
          }
      }
      __builtin_amdgcn_sched_barrier(0);
    }
  }
};

__device__ __forceinline__ void p0_transpose_item(const float* __restrict__ W, int K, int N, bf16_t* __restrict__ WT, const float* __restrict__ g0, const float* __restrict__ g1, float* scr, int item, int lane) {
  const int nblk = N / 32, kb = item / nblk, nb = item % nblk, k0 = 64 * kb, n0 = 32 * nb;
#pragma unroll 8
  for (int i = 0; i < 32; ++i) {
    const int kk = 2 * i + (lane >> 5), k = k0 + kk;
    float gv = 1.f; if (g0) gv = (g1 && k >= 512) ? g1[k - 512] : g0[k];
    scr[kk * 33 + (lane & 31)] = W[(size_t)k * N + n0 + (lane & 31)] * gv;
  }
  asm volatile("s_waitcnt lgkmcnt(0)" ::: "memory");
  const int c = lane & 7;
#pragma unroll
  for (int j = 0; j < 4; ++j) {
    const int n = (lane >> 3) + 8 * j; const float* s = scr + (8 * c) * 33 + n;
    u32x4 o; o.x = pk2(s[0 * 33], s[1 * 33]); o.y = pk2(s[2 * 33], s[3 * 33]); o.z = pk2(s[4 * 33], s[5 * 33]); o.w = pk2(s[6 * 33], s[7 * 33]);
    const int col = n0 + n, drow = (col & ~255) + col_slot(col & 255);
    *(u32x4*)(WT + (size_t)drow * K + k0 + 8 * c) = o;
  }
  asm volatile("s_waitcnt lgkmcnt(0)" ::: "memory");
}

__device__ __forceinline__ void p0_prologue(const Params& p) {
  int tid = threadIdx.x; asm volatile("" : "+v"(tid));
  const int wave = tid >> 6, lane = tid & 63;
  const int gw = blockIdx.x * 8 + wave, NGW = gridDim.x * 8;
  float* scr = (float*)(g_shm + wave * 16384);
  bf16_t* WinT = (bf16_t*)(p.ws + WS_WIN); bf16_t* WoT = (bf16_t*)(p.ws + WS_WO); bf16_t* WupT = (bf16_t*)(p.ws + WS_WUP); bf16_t* WdT = (bf16_t*)(p.ws + WS_WD);
  constexpr int I_IN = 16 * 72, I_O = 16 * 32, I_UP = 16 * 128, I_DN = 64 * 32, NIT = I_IN + I_O + I_UP + I_DN;
  for (int it = gw; it < NIT; it += NGW) {
    int r = it;
    if (r < I_IN) { p0_transpose_item(p.w_in, DM, INC, WinT, p.norm_attn, nullptr, scr, r, lane); continue; } r -= I_IN;
    if (r < I_O) { p0_transpose_item(p.w_o, DM, DM, WoT, p.ona, p.onb, scr, r, lane); continue; } r -= I_O;
    if (r < I_UP) { p0_transpose_item(p.w_up, DM, DFF, WupT, p.norm_mlp, nullptr, scr, r, lane); continue; } r -= I_UP;
    p0_transpose_item(p.w_down, DFF, DM, WdT, nullptr, nullptr, scr, r, lane);
  }
  bf16_t* xb = (bf16_t*)(p.ws + WS_X); float* rs1 = (float*)(p.ws + WS_RS1);
  for (int row4 = gw * 4; row4 < NTOK; row4 += NGW * 4) {
    f32x4 v[4][4];
#pragma unroll
    for (int r = 0; r < 4; ++r) {
      const int row = row4 + r;
      const float* xr = (row < NPROMPT) ? (p.xp + (size_t)row * DM) : (p.xs + (size_t)(row - NPROMPT) * DM);
#pragma unroll
      for (int j = 0; j < 4; ++j) v[r][j] = *(const f32x4*)(xr + 256 * j + 4 * lane);
    }
#pragma unroll
    for (int r = 0; r < 4; ++r) {
      const int row = row4 + r; float s = 0.f;
#pragma unroll
      for (int j = 0; j < 4; ++j) s += (v[r][j][0] * v[r][j][0] + v[r][j][1] * v[r][j][1]) + (v[r][j][2] * v[r][j][2] + v[r][j][3] * v[r][j][3]);
#pragma unroll
      for (int o = 1; o < 64; o <<= 1) s += __shfl_xor(s, o);
#pragma unroll
      for (int j = 0; j < 4; ++j) { u32x2 w; w.x = pk2(v[r][j][0], v[r][j][1]); w.y = pk2(v[r][j][2], v[r][j][3]); *(u32x2*)(xb + (size_t)row * DM + 256 * j + 4 * lane) = w; }
      if (lane == 0) rs1[row] = rsqrtf(s * (1.0f / DM) + EPS);
    }
  }
}

struct ChunkSrc { int rowc, d, M, kc0; };

__device__ __forceinline__ void issue_chunk(const bf16_t* __restrict__ qkv, const ChunkSrc cs, int koff, int voff, int lane, unsigned char* slot) {
  const unsigned ck = (unsigned)(koff * 2), cv = (unsigned)(voff * 2);
#pragma unroll
  for (int i = 0; i < 4; ++i) {
    const int r = (lane >> 3) + 8 * i;
    int kc = cs.kc0 + r; kc = kc < 0 ? 0 : (kc > cs.M - 1 ? cs.M - 1 : kc);
    const unsigned row = __umul24((unsigned)cs.d, (unsigned)kc) + (unsigned)cs.rowc;
    const unsigned rb = __umul24(row, (unsigned)(INC * 2));
    const unsigned chk = (unsigned)(((lane & 7) ^ ((r >> 1) & 7)) << 4), chv = (unsigned)(((lane & 7) ^ (((r >> 1) & 3) << 1)) << 4);
    __builtin_amdgcn_global_load_lds((const __attribute__((address_space(1))) unsigned*)((const char*)qkv + (rb + (ck + chk))), (LAS unsigned*)(slot + i * 1024), 16, 0, 0);
    __builtin_amdgcn_global_load_lds((const __attribute__((address_space(1))) unsigned*)((const char*)qkv + (rb + (cv + chv))), (LAS unsigned*)(slot + 4096 + i * 1024), 16, 0, 0);
  }
}
__device__ __forceinline__ void read_vt(unsigned a0, unsigned a1, unsigned a2, unsigned a3, bf16x8 (&Vt)[4]) {
  u32x2 r00, r01, r10, r11, r20, r21, r30, r31;
  asm volatile(
      "ds_read_b64_tr_b16 %0, %8\n\tds_read_b64_tr_b16 %1, %8 offset:2048\n\t"
      "ds_read_b64_tr_b16 %2, %9\n\tds_read_b64_tr_b16 %3, %9 offset:2048\n\t"
      "ds_read_b64_tr_b16 %4, %10\n\tds_read_b64_tr_b16 %5, %10 offset:2048\n\t"
      "ds_read_b64_tr_b16 %6, %11\n\tds_read_b64_tr_b16 %7, %11 offset:2048\n\t"
      "s_waitcnt lgkmcnt(0)"
      : "=&v"(r00), "=&v"(r01), "=&v"(r10), "=&v"(r11), "=&v"(r20), "=&v"(r21), "=&v"(r30), "=&v"(r31)
      : "v"(a0), "v"(a1), "v"(a2), "v"(a3) : "memory");
  u32x4 t;
  t.x = r00.x; t.y = r00.y; t.z = r01.x; t.w = r01.y; Vt[0] = __builtin_bit_cast(bf16x8, t);
  t.x = r10.x; t.y = r10.y; t.z = r11.x; t.w = r11.y; Vt[1] = __builtin_bit_cast(bf16x8, t);
  t.x = r20.x; t.y = r20.y; t.z = r21.x; t.w = r21.y; Vt[2] = __builtin_bit_cast(bf16x8, t);
  t.x = r30.x; t.y = r30.y; t.z = r31.x; t.w = r31.y; Vt[3] = __builtin_bit_cast(bf16x8, t);
}
__device__ __forceinline__ void tile_chunk(const bf16x8 (&Kf)[2][2], const bf16x8 (&Q)[2], const bf16x8 (&Vt)[4], f32x4 (&o)[4], float& l, int kcl, int lo, unsigned span, float negm) {
  f32x4 s0 = {negm, negm, negm, negm}, s1 = s0;
  s0 = mfma16(Kf[0][0], Q[0], s0); s0 = mfma16(Kf[0][1], Q[1], s0);
  s1 = mfma16(Kf[1][0], Q[0], s1); s1 = mfma16(Kf[1][1], Q[1], s1);
  float pv[8]; float sum = 0.f;
#pragma unroll
  for (int j = 0; j < 4; ++j) {
    pv[j] = ((unsigned)(kcl + j - lo) <= span) ? __builtin_amdgcn_exp2f(s0[j]) : 0.f;
    pv[4 + j] = ((unsigned)(kcl + 16 + j - lo) <= span) ? __builtin_amdgcn_exp2f(s1[j]) : 0.f;
    sum += pv[j] + pv[4 + j];
  }
  l += sum;
  u32x4 pk; pk.x = pk2(pv[0], pv[1]); pk.y = pk2(pv[2], pv[3]); pk.z = pk2(pv[4], pv[5]); pk.w = pk2(pv[6], pv[7]);
  const bf16x8 P = __builtin_bit_cast(bf16x8, pk);
#pragma unroll
  for (int dt = 0; dt < 4; ++dt) o[dt] = mfma16(Vt[dt], P, o[dt]);
}

template <int TMASK, class DESC>
__device__ __forceinline__ void run_branch(const bf16_t* __restrict__ qkv, const DESC& desc, int& gi, const int total, const int nchunks, const int M, const int kstart, int koff, int voff,
                                           int qcb, int qstep, int hw, float negm, int lane, unsigned char* ring, const bf16x8 (&Q)[4][2], f32x4 (&o)[4][4], float (&l)[4]) {
  const int g = lane >> 4;
  int lo[4]; unsigned span[4];
#pragma unroll
  for (int t = 0; t < 4; ++t) { const int qc = qcb + t * qstep; lo[t] = qc - hw < 0 ? 0 : qc - hw; const int hi = qc + hw > M - 1 ? M - 1 : qc + hw; span[t] = (unsigned)(hi - lo[t]); }
  const int qp = (lane & 15) >> 2, pp = lane & 3, rl = 4 * g + qp, f = (rl >> 1) & 3;
  const unsigned vbase = (unsigned)(size_t)ring + 4096 + rl * 128 + pp * 8;
  const unsigned a0 = vbase + ((0 ^ f) << 5), a1 = vbase + ((1 ^ f) << 5), a2 = vbase + ((2 ^ f) << 5), a3 = vbase + ((3 ^ f) << 5);
  const int krow = lane & 15;
  const LAS unsigned char* kb0 = (const LAS unsigned char*)ring + krow * 128 + (((0 + g) ^ (krow >> 1)) << 4);
  const LAS unsigned char* kb1 = (const LAS unsigned char*)ring + krow * 128 + (((4 + g) ^ (krow >> 1)) << 4);
#pragma unroll 1
  for (int c = 0; c < nchunks; ++c, ++gi) {
    const unsigned soff = (unsigned)(gi & (ATT_SLOTS - 1)) * 8192u;
    bf16x8 Kf[2][2];
    if constexpr (ATT_LA == 1) {
      asm volatile("s_waitcnt vmcnt(0)" ::: "memory");
      Kf[0][0] = *(const LAS bf16x8*)(kb0 + soff); Kf[0][1] = *(const LAS bf16x8*)(kb1 + soff);
      Kf[1][0] = *(const LAS bf16x8*)(kb0 + soff + 2048); Kf[1][1] = *(const LAS bf16x8*)(kb1 + soff + 2048);
      if (gi + 1 < total) issue_chunk(qkv, desc(gi + 1), koff, voff, lane, ring + ((gi + 1) & 1) * 8192);
    } else {
      if (gi + ATT_LA < total) issue_chunk(qkv, desc(gi + ATT_LA), koff, voff, lane, ring + ((gi + ATT_LA) & (ATT_SLOTS - 1)) * 8192);
      const int rem = total - 1 - gi;
      if (ATT_LA >= 3 && rem >= 3) asm volatile("s_waitcnt vmcnt(24)" ::: "memory");
      else if (ATT_LA >= 2 && rem >= 2) asm volatile("s_waitcnt vmcnt(16)" ::: "memory");
      else if (rem >= 1) asm volatile("s_waitcnt vmcnt(8)" ::: "memory");
      else asm volatile("s_waitcnt vmcnt(0)" ::: "memory");
      Kf[0][0] = *(const LAS bf16x8*)(kb0 + soff); Kf[0][1] = *(const LAS bf16x8*)(kb1 + soff);
      Kf[1][0] = *(const LAS bf16x8*)(kb0 + soff + 2048); Kf[1][1] = *(const LAS bf16x8*)(kb1 + soff + 2048);
    }
    bf16x8 Vt[4];
    read_vt(a0 + soff, a1 + soff, a2 + soff, a3 + soff, Vt);
    const int kcl = kstart + 32 * c + 4 * g;
#pragma unroll
    for (int t = 0; t < 4; ++t)
      if (TMASK & (1 << t)) tile_chunk(Kf, Q[t], Vt, o[t], l[t], kcl, lo[t], span[t], negm);
  }
}

__device__ __forceinline__ float wave_max(float v) {
#pragma unroll
  for (int o = 1; o < 64; o <<= 1) v = fmaxf(v, __shfl_xor(v, o));
  return v;
}

__device__ __forceinline__ void attn_phase(const Params& p) {
  int tid = threadIdx.x; asm volatile("" : "+v"(tid));
  const int wave = __builtin_amdgcn_readfirstlane(tid >> 6), lane = tid & 63, qi = lane & 15, g = lane >> 4;
  if (wave >= ATT_NACT) return;
  const bf16_t* qkv = (const bf16_t*)(p.ws + WS_QKV);
  bf16_t* mix = (bf16_t*)(p.ws + WS_X);
  float* ssqh = (float*)(p.ws + WS_SSQH);
  unsigned char* ring = g_shm + wave * (ATT_SLOTS * 8192);
  const float mfixA = 8.0f * LOG2E * wave_max(fabsf(p.qna[lane])) * wave_max(fabsf(p.kna[lane]));
  const float mfixB = 8.0f * LOG2E * wave_max(fabsf(p.qnb[lane])) * wave_max(fabsf(p.knb[lane]));
  const int xcd = blockIdx.x & 7, wx = (blockIdx.x >> 3) * ATT_NACT + wave, nwx = (gridDim.x >> 3) * ATT_NACT;
  for (int li = wx; li < 2048; li += nwx) {
    const int kind = (li / nwx) & 1;
    const int lk = ((li / nwx) >> 1) * nwx + (li % nwx);
    const int grp = xcd * 128 + (lk & 127), sub = lk >> 7;
    const int r64 = grp * 64;
    const int S = r64 < NPROMPT ? 2048 : 4096;
    const int row0 = r64 & ~(S - 1);
    bf16x8 Q[4][2]; f32x4 o[4][4]; float l[4];
#pragma unroll
    for (int t = 0; t < 4; ++t) {
#pragma unroll
      for (int dt = 0; dt < 4; ++dt) o[t][dt] = (f32x4){0.f, 0.f, 0.f, 0.f};
    }
    int tok[4], colb[4];
    int gi = 0;
    if (kind == 0) {
      const int sidx = (r64 - row0) >> 6, c4 = sidx & 3, p0 = (sidx >> 2) * 16, h = sub;
#pragma unroll
      for (int t = 0; t < 4; ++t) {
        tok[t] = 16 * (p0 + qi) + c4 + 4 * t; colb[t] = h * 64; l[t] = 0.f;
        const bf16_t* rp = qkv + (size_t)(row0 + tok[t]) * INC + h * 64 + g * 8;
        Q[t][0] = *(const bf16x8*)rp; Q[t][1] = *(const bf16x8*)(rp + 32);
      }
      const int koff = 512 + h * 64, voff = 1024 + h * 64;
      auto desc = [=](int i) -> ChunkSrc {
        ChunkSrc r;
        if (i < 12) { r.rowc = row0; r.d = 1; r.M = S; r.kc0 = 16 * p0 - 64 + 32 * i; }
        else if (i < 18) { r.rowc = row0 + c4; r.d = 4; r.M = S >> 2; r.kc0 = 4 * p0 - 64 + 32 * (i - 12); }
        else { const int j = i - 18, t = j / 5, c = j - 5 * t; r.rowc = row0 + c4 + 4 * t; r.d = 16; r.M = S >> 4; r.kc0 = p0 - 64 + 32 * c; }
        return r;
      };
      constexpr int TOTAL = 38;
#pragma unroll
      for (int i = 0; i < ATT_LA; ++i) issue_chunk(qkv, desc(i), koff, voff, lane, ring + i * 8192);
      run_branch<15>(qkv, desc, gi, TOTAL, 12, S, 16 * p0 - 64, koff, voff, 16 * (p0 + qi) + c4, 4, 64, -mfixA, lane, ring, Q, o, l);
      run_branch<15>(qkv, desc, gi, TOTAL, 6, S >> 2, 4 * p0 - 64, koff, voff, 4 * (p0 + qi), 1, 64, -mfixA, lane, ring, Q, o, l);
      run_branch<1>(qkv, desc, gi, TOTAL, 5, S >> 4, p0 - 64, koff, voff, p0 + qi, 0, 64, -mfixA, lane, ring, Q, o, l);
      run_branch<2>(qkv, desc, gi, TOTAL, 5, S >> 4, p0 - 64, koff, voff, p0 + qi, 0, 64, -mfixA, lane, ring, Q, o, l);
      run_branch<4>(qkv, desc, gi, TOTAL, 5, S >> 4, p0 - 64, koff, voff, p0 + qi, 0, 64, -mfixA, lane, ring, Q, o, l);
      run_branch<8>(qkv, desc, gi, TOTAL, 5, S >> 4, p0 - 64, koff, voff, p0 + qi, 0, 64, -mfixA, lane, ring, Q, o, l);
    } else {
      const int kvh = sub & 1, qsub = sub >> 1, q0 = (r64 - row0) + 16 * qsub;
#pragma unroll
      for (int t = 0; t < 4; ++t) {
        const int hq = kvh * 4 + t;
        tok[t] = q0 + qi; colb[t] = 512 + hq * 64;
        l[t] = (g == 0) ? __builtin_amdgcn_exp2f(p.sink[hq] * LOG2E - mfixB) : 0.f;
        const bf16_t* rp = qkv + (size_t)(row0 + tok[t]) * INC + 1536 + hq * 64 + g * 8;
        Q[t][0] = *(const bf16x8*)rp; Q[t][1] = *(const bf16x8*)(rp + 32);
      }
      const int koff = 2048 + kvh * 64, voff = 2176 + kvh * 64;
      auto desc = [=](int i) -> ChunkSrc { ChunkSrc r; r.rowc = row0; r.d = 1; r.M = S; r.kc0 = q0 - 128 + 32 * i; return r; };
      constexpr int TOTAL = 9;
#pragma unroll
      for (int i = 0; i < ATT_LA; ++i) issue_chunk(qkv, desc(i), koff, voff, lane, ring + i * 8192);
      run_branch<15>(qkv, desc, gi, TOTAL, 9, S, q0 - 128, koff, voff, q0 + qi, 0, 128, -mfixB, lane, ring, Q, o, l);
    }
#pragma unroll
    for (int t = 0; t < 4; ++t) {
      float L = l[t]; L += __shfl_xor(L, 16); L += __shfl_xor(L, 32);
      const float inv = 1.0f / L; float ss = 0.f;
#pragma unroll
      for (int dt = 0; dt < 4; ++dt)
#pragma unroll
        for (int j = 0; j < 4; ++j) { const float x = o[t][dt][j] * inv; o[t][dt][j] = x; ss += x * x; }
      ss += __shfl_xor(ss, 16); ss += __shfl_xor(ss, 32);
      const size_t row = (size_t)(row0 + tok[t]);
      if (g == 0) ssqh[row * 16 + (colb[t] >> 6)] = ss;
      bf16_t* dst = mix + row * DM + colb[t] + 4 * g;
#pragma unroll
      for (int dt = 0; dt < 4; ++dt) { u32x2 w; w.x = pk2(o[t][dt][0], o[t][dt][1]); w.y = pk2(o[t][dt][2], o[t][dt][3]); *(u32x2*)(dst + 16 * dt) = w; }
    }
  }
}

#define XB_TMO      128
#define XB_XCNT(j)  (256  + 64 * (j))
#define XB_XSUB(j)  (1280 + 64 * (j))
#define XB_XGEN(j)  (2304 + 64 * (j))
#define XB_TOP      3328
#define XB_TOPGEN   3392
#define XCD_BAR_WORDS 3456
#define XB_SPIN_CAP (1u << 18)
__device__ __forceinline__ unsigned xb_ld(unsigned* p)              { return __hip_atomic_load(p, __ATOMIC_RELAXED, __HIP_MEMORY_SCOPE_AGENT); }
__device__ __forceinline__ unsigned xb_add(unsigned* p, unsigned v) { return __hip_atomic_fetch_add(p, v, __ATOMIC_RELAXED, __HIP_MEMORY_SCOPE_AGENT); }
__device__ __forceinline__ unsigned xb_xcc_id() { return (unsigned)__builtin_amdgcn_s_getreg((3 << 11) | 20) & 0xFu; }
#define XB_SPIN(cond, bar) do { unsigned _sp = 0; while (cond) { __builtin_amdgcn_s_sleep(1); \
    if ((++_sp & 255u) == 0u) { if (xb_ld(&(bar)[XB_TMO])) break; if (_sp > XB_SPIN_CAP) { atomicAdd(&(bar)[XB_TMO], 1u); break; } } } } while (0)
struct XcdBarrier { unsigned* bar; unsigned x; volatile LAS unsigned* st; };
__device__ __forceinline__ XcdBarrier xcd_barrier_post(unsigned* bar, volatile LAS unsigned* st) {
  XcdBarrier b; b.bar = bar; b.x = xb_xcc_id(); b.st = st;
  if (threadIdx.x == 0) (void)xb_add(&bar[XB_XCNT(b.x)], 1u);
  return b;
}
__device__ __forceinline__ void xcd_barrier_complete(unsigned* bar, unsigned x, unsigned& nloc, unsigned& nx) {
  const unsigned G = gridDim.x * gridDim.y * gridDim.z;
  unsigned sum, cnt, mine, sp = 0u;
  for (;;) {
    sum = 0u; cnt = 0u; mine = 0u;
#pragma unroll
    for (unsigned j = 0; j < 16; ++j) { const unsigned c = xb_ld(&bar[XB_XCNT(j)]); sum += c; cnt += (c > 0u) ? 1u : 0u; mine = (j == x) ? c : mine; }
    if (sum == G) break;
    __builtin_amdgcn_s_sleep(1);
    if ((++sp & 255u) == 0u) { if (xb_ld(&bar[XB_TMO])) break; if (sp > XB_SPIN_CAP) { atomicAdd(&bar[XB_TMO], 1u); break; } }
  }
  nloc = mine > 0u ? mine : 1u; nx = cnt > 0u ? cnt : 1u;
}
__device__ __forceinline__ void xcd_barrier_impl(const XcdBarrier& b) {
  asm volatile("s_waitcnt vmcnt(0)" ::: "memory");
  __syncthreads();
  if (threadIdx.x == 0) {
    unsigned* bar = b.bar;
    __builtin_amdgcn_s_waitcnt(0);
    unsigned nloc = b.st[0], nx = b.st[1];
    if (nloc == 0u) { xcd_barrier_complete(bar, b.x, nloc, nx); b.st[0] = nloc; b.st[1] = nx; }
    const unsigned old = xb_add(&bar[XB_XSUB(b.x)], 1u);
    const unsigned gen = old / nloc;
    if (old + 1u == (gen + 1u) * nloc) {
      __builtin_amdgcn_fence(__ATOMIC_RELEASE, "agent");
      asm volatile("s_waitcnt vmcnt(0)" ::: "memory");
      const unsigned og = xb_add(&bar[XB_TOP], 1u);
      const unsigned tg = og / nx;
      if (og + 1u == (tg + 1u) * nx) xb_add(&bar[XB_TOPGEN], 1u);
      else XB_SPIN(xb_ld(&bar[XB_TOPGEN]) == tg, bar);
      __builtin_amdgcn_fence(__ATOMIC_ACQUIRE, "agent");
      xb_add(&bar[XB_XGEN(b.x)], 1u);
      asm volatile("s_waitcnt vmcnt(0)" ::: "memory");
    } else {
      XB_SPIN(xb_ld(&bar[XB_XGEN(b.x)]) == gen, bar);
      __builtin_amdgcn_fence(__ATOMIC_ACQUIRE, "agent");
      asm volatile("s_waitcnt vmcnt(0)" ::: "memory");
    }
  }
  __syncthreads();
}

__device__ __forceinline__ void xcd_barrier(unsigned char* ws) {
  XcdBarrier b; b.bar = (unsigned*)(ws + WS_BAR); b.x = xb_xcc_id(); b.st = (volatile LAS unsigned*)((LAS unsigned char*)g_shm + GEMM_LDS_BYTES);
  xcd_barrier_impl(b);
}

typedef const __attribute__((address_space(4))) Params* KArgs;
__device__ __forceinline__ Params load_params() {
#if defined(__HIP_DEVICE_COMPILE__)
  KArgs kp = (KArgs)__builtin_amdgcn_kernarg_segment_ptr();
  asm volatile("" : "+s"(kp));
  Params r;
  r.xp = kp->xp; r.xs = kp->xs; r.norm_attn = kp->norm_attn; r.w_in = kp->w_in; r.qna = kp->qna; r.kna = kp->kna; r.qnb = kp->qnb; r.knb = kp->knb; r.sink = kp->sink;
  r.ona = kp->ona; r.onb = kp->onb; r.w_o = kp->w_o; r.norm_mlp = kp->norm_mlp; r.w_up = kp->w_up; r.w_down = kp->w_down; r.out = kp->out; r.ws = kp->ws;
  return r;
#else
  return Params{};
#endif
}

__global__ void __launch_bounds__(512) fwd_megakernel(Params p_unused) {
  cg::grid_group grid = cg::this_grid();
  {
    const Params p = load_params();
    volatile LAS unsigned* xst = (volatile LAS unsigned*)((LAS unsigned char*)g_shm + GEMM_LDS_BYTES);
    if (threadIdx.x == 0) { xst[0] = 0u; xst[1] = 0u; }
    (void)xcd_barrier_post((unsigned*)(p.ws + WS_BAR), xst);
    p0_prologue(p);
    if (p.ws == nullptr) grid.sync();
    xcd_barrier(p.ws);
  }
  {
    const Params p = load_params();
    EpiQKV e{(bf16_t*)(p.ws + WS_QKV), (const float*)(p.ws + WS_RS1), p.qna, p.kna, p.qnb, p.knb};
    gemm_phase<EpiQKV, GEMM_ALIGN, GEMM_SP2>((const bf16_t*)(p.ws + WS_X), (const bf16_t*)(p.ws + WS_WIN), NTOK, INC, DM, e);
    xcd_barrier(p.ws);
  }
  {
    const Params p = load_params();
    attn_phase(p);
    xcd_barrier(p.ws);
  }
  {
    const Params p = load_params();
    EpiWo e{p.xp, p.xs, (bf16_t*)(p.ws + WS_HB), (float*)(p.ws + WS_SSQ2), (const float*)(p.ws + WS_SSQH)};
    gemm_phase<EpiWo, GEMM_ALIGN, GEMM_SP2, true>((const bf16_t*)(p.ws + WS_X), (const bf16_t*)(p.ws + WS_WO), NTOK, DM, DM, e);
    xcd_barrier(p.ws);
  }
  for (int half = 0; half < 2; ++half) {
    const int rb = half * NPROMPT;
    {
      const Params p = load_params();
      EpiUp e{(bf16_t*)(p.ws + WS_U), (const float*)(p.ws + WS_SSQ2), rb};
      gemm_phase<EpiUp, GEMM_ALIGN, GEMM_SP2>((const bf16_t*)(p.ws + WS_HB) + (size_t)rb * DM, (const bf16_t*)(p.ws + WS_WUP), NPROMPT, DFF, DM, e);
      xcd_barrier(p.ws);
    }
    {
      const Params p = load_params();
      EpiDown e{(const bf16_t*)(p.ws + WS_HB), p.out, rb};
      gemm_phase<EpiDown, GEMM_ALIGN, GEMM_SP2>((const bf16_t*)(p.ws + WS_U), (const bf16_t*)(p.ws + WS_WD), NPROMPT, DM, DFF, e);
      if (half == 0) xcd_barrier(p.ws);
    }
  }
}

extern "C" void kernel_launch(void* const* d_in, const int* in_sizes, int n_in, void* d_out, int out_size, void* d_ws, size_t ws_size, hipStream_t stream) {
  static int grid_blocks = 0;
  if (!grid_blocks) {
    if (n_in != 15 || ws_size < WS_NEED) { fprintf(stderr, "kernel_launch: unexpected n_in %d / ws_size %zu\n", n_in, ws_size); grid_blocks = -1; return; }
    int dev = 0, cus = 0, per_cu = 0;
    hipGetDevice(&dev);
    hipDeviceGetAttribute(&cus, hipDeviceAttributeMultiprocessorCount, dev);
    if (hipFuncSetAttribute((const void*)fwd_megakernel, hipFuncAttributeMaxDynamicSharedMemorySize, LDS_BYTES) != hipSuccess) { fprintf(stderr, "hipFuncSetAttribute failed\n"); grid_blocks = -1; return; }
    hipOccupancyMaxActiveBlocksPerMultiprocessor(&per_cu, (const void*)fwd_megakernel, 512, LDS_BYTES);
    if (per_cu < 1) { fprintf(stderr, "occupancy query says %d blocks/CU\n", per_cu); per_cu = 1; }
    (void)hipGetLastError();
    grid_blocks = cus;
  }
  if (grid_blocks < 0) return;
  if (hipMemsetAsync((char*)d_ws + WS_BAR, 0, 16384, stream) != hipSuccess) { fprintf(stderr, "hipMemsetAsync of the barrier words failed\n"); return; }
  Params p{};
  p.xp = (const float*)d_in[0]; p.xs = (const float*)d_in[1]; p.norm_attn = (const float*)d_in[2]; p.w_in = (const float*)d_in[3];
  p.qna = (const float*)d_in[4]; p.kna = (const float*)d_in[5]; p.qnb = (const float*)d_in[6]; p.knb = (const float*)d_in[7];
  p.sink = (const float*)d_in[8]; p.ona = (const float*)d_in[9]; p.onb = (const float*)d_in[10]; p.w_o = (const float*)d_in[11];
  p.norm_mlp = (const float*)d_in[12]; p.w_up = (const float*)d_in[13]; p.w_down = (const float*)d_in[14];
  p.out = (float*)d_out; p.ws = (unsigned char*)d_ws;
  void* args[] = {&p};
  hipError_t e = hipLaunchCooperativeKernel((const void*)fwd_megakernel, dim3(grid_blocks), dim3(512), args, LDS_BYTES, stream);
  if (e != hipSuccess) fprintf(stderr, "cooperative launch failed: %s (grid %d)\n", hipGetErrorString(e), grid_blocks);
}
```

```cpp
#include <hip/hip_runtime.h>
#include <hip/hip_cooperative_groups.h>
#include <cstdio>
#include <cstdint>
namespace cg = cooperative_groups;

typedef unsigned short bf16_t;
typedef short bf16x8 __attribute__((ext_vector_type(8)));
typedef float f32x4 __attribute__((ext_vector_type(4)));
typedef unsigned u32x4 __attribute__((ext_vector_type(4)));
typedef unsigned u32x2 __attribute__((ext_vector_type(2)));

constexpr int DM = 1024, NTOK = 65536, NPROMPT = 32768, INC = 2304, DFF = 4096;
constexpr float EPS = 1e-6f;
constexpr float LOG2E = 1.4426950408889634f;
constexpr float QSCALE = 0.18033688011112042f;

constexpr size_t MiB = 1048576;
constexpr size_t WS_WIN = 0, WS_WO = 4718592, WS_WUP = 6815744, WS_WD = 15204352, WS_RS1 = 23592960, WS_SSQ2 = 440 * MiB;
constexpr size_t WS_X = 24 * MiB;
constexpr size_t WS_QKV = 152 * MiB;
constexpr size_t WS_HB = 312 * MiB;
constexpr size_t WS_U = 24 * MiB;
constexpr size_t WS_SSQH = 444 * MiB;
constexpr size_t WS_BAR = 448 * MiB;
constexpr size_t WS_NEED = 449 * MiB;

constexpr int GEMM_LDS_BYTES = 131072, LDS_BYTES = GEMM_LDS_BYTES + 64;
constexpr bool GEMM_ALIGN = true, GEMM_SP2 = true;
constexpr int ATT_NACT = 8;
constexpr int ATT_SLOTS = 16 / ATT_NACT, ATT_LA = ATT_SLOTS - 1;

struct Params {
  const float *xp, *xs, *norm_attn, *w_in, *qna, *kna, *qnb, *knb, *sink, *ona, *onb, *w_o, *norm_mlp, *w_up, *w_down;
  float* out;
  unsigned char* ws;
};

extern __shared__ __attribute__((aligned(16))) unsigned char g_shm[];

typedef __bf16 bf16v2_t __attribute__((ext_vector_type(2)));
typedef float f32v2_t __attribute__((ext_vector_type(2)));
__device__ __forceinline__ unsigned pk2(float lo, float hi) { const f32v2_t f = {lo, hi}; const bf16v2_t b = __builtin_convertvector(f, bf16v2_t); return __builtin_bit_cast(unsigned, b); }
__device__ __forceinline__ float bf2f(unsigned short b) { return __uint_as_float(((unsigned)b) << 16); }
__device__ __forceinline__ f32x4 mfma16(bf16x8 a, bf16x8 b, f32x4 c) { return __builtin_amdgcn_mfma_f32_16x16x32_bf16(a, b, c, 0, 0, 0); }

__device__ __forceinline__ int col_slot(int c, int mode) {
  if (mode == 0) return 128 * ((c >> 3) & 1) + 32 * (c >> 6) + 16 * ((c >> 2) & 1) + 4 * ((c >> 4) & 3) + (c & 3);
  if (mode == 1) return 128 * ((c >> 5) & 1) + 32 * (c >> 6) + 16 * ((c >> 2) & 1) + 4 * ((c >> 3) & 3) + (c & 3);
  return c;
}

constexpr int BM = 256, BK = 64, HALF = 128, HT = HALF * BK;
__device__ __forceinline__ int lds_byte(int r, int c) {
  int st = (r >> 4) * 2 + (c >> 5), rr = r & 15, cc = c & 31, ob = rr * 64 + cc * 2;
  return st * 1024 + (ob ^ (((ob >> 9) & 1) << 5));
}
__device__ __forceinline__ void stage_rc(int b, int& R, int& C) {
  int st = b / 1024, sb = b % 1024, swz = sb ^ (((sb >> 9) & 1) << 5);
  R = (st >> 1) * 16 + swz / 64; C = (st & 1) * 32 + (swz % 64) / 2;
}

__device__ __forceinline__ bool tile_of(int L, int nM, int nN, int& pm, int& pn) {
  const int nwg = nM * nN; if (L >= nwg) return false;
  int wgid = L; { const int q = nwg / 8, r = nwg % 8, xcd = wgid % 8, off = wgid / 8; wgid = (xcd < r ? xcd * (q + 1) : r * (q + 1) + (xcd - r) * q) + off; }
  const int nig = 8 * nN, gid = wgid / nig, fm = gid * 8, gsz = (nM - fm) < 8 ? (nM - fm) : 8;
  pm = fm + ((wgid % nig) % gsz); pn = (wgid % nig) / gsz; return true;
}
#define LAS __attribute__((address_space(3)))
template <class Epi, bool ALIGN_EPI, bool SP2, bool MID = false>
__device__ __forceinline__ void gemm_phase(const bf16_t* __restrict__ Ag, const bf16_t* __restrict__ Btg, const int M, const int N, const int K, const Epi& E) {
  LAS unsigned char* lds = (LAS unsigned char*)g_shm;
  int tid = threadIdx.x; asm volatile("" : "+v"(tid));
  const int wid = __builtin_amdgcn_readfirstlane(tid >> 6), lane = tid & 63, wr = wid >> 2, wc = wid & 3, fr = lane & 15, fq = lane >> 4;
  const int nt = K / BK, nM = M / BM, nN = N / BM, G = gridDim.x, cu = blockIdx.x;
  constexpr int HTB = HALF * BK * 2;
  unsigned voff[2];
#pragma unroll
  for (int i = 0; i < 2; ++i) { int R, C; stage_rc(tid * 16 + i * 8192, R, C); voff[i] = (unsigned)(R * K + C) * 2u; }
  const size_t kstep = (size_t)(BK * 2), hstep = (size_t)HALF * K * 2, tstep = 2 * hstep;
  const unsigned ldsw = (unsigned)wid * 1024u;
  const int aoff = lds_byte(wr * 64 + fr, fq * 8), boff = lds_byte(wc * 32 + fr, fq * 8);
#define PG8_SA(b, h) (((b) * 2 + (h)) * HTB)
#define PG8_SB(b, h) ((4 + (b) * 2 + (h)) * HTB)
#define PG8_STAGE(bufoff, gbase) do { _Pragma("unroll") for (int _i = 0; _i < 2; ++_i) \
    __builtin_amdgcn_global_load_lds((const __attribute__((address_space(1))) unsigned*)((const char*)(gbase) + voff[_i]), (LAS unsigned*)(lds + (bufoff) + ldsw + _i * 8192), 16, 0, 0); } while (0)
#define PG8_LDA(dst, b, h) do { _Pragma("unroll") for (int m = 0; m < 4; ++m) _Pragma("unroll") for (int k = 0; k < 2; ++k) dst[m][k] = *(const LAS bf16x8*)(lds + PG8_SA(b, h) + aoff + m * 2048 + k * 1024); } while (0)
#define PG8_LDB(dst, b, h) do { _Pragma("unroll") for (int n = 0; n < 2; ++n) _Pragma("unroll") for (int k = 0; k < 2; ++k) dst[n][k] = *(const LAS bf16x8*)(lds + PG8_SB(b, h) + boff + n * 2048 + k * 1024); } while (0)
#define PG8_MMA(ai, bj, At, Bt) do { __builtin_amdgcn_s_setprio(1); _Pragma("unroll") for (int m = 0; m < 4; ++m) _Pragma("unroll") for (int n = 0; n < 2; ++n) _Pragma("unroll") for (int k = 0; k < 2; ++k) \
    acc[ai][bj][m][n] = __builtin_amdgcn_mfma_f32_16x16x32_bf16(Bt[n][k], At[m][k], acc[ai][bj][m][n], 0, 0, 0); __builtin_amdgcn_s_setprio(0); } while (0)
#define PG8_WAIT_V(n) asm volatile("s_waitcnt vmcnt(" #n ")" ::: "memory")
#define PG8_WAIT_L(n) asm volatile("s_waitcnt lgkmcnt(" #n ")" ::: "memory")
#define PG8_BAR __builtin_amdgcn_s_barrier()
#define PG8_SCHED __builtin_amdgcn_sched_barrier(0)
  int cpm, cpn, npm = 0, npn = 0, ui = 0;
  if (!tile_of(cu, nM, nN, cpm, cpn)) return;
  f32x4 acc[2][2][4][2];
#pragma unroll
  for (int a = 0; a < 2; ++a)
#pragma unroll
    for (int b = 0; b < 2; ++b)
#pragma unroll
      for (int m = 0; m < 4; ++m)
#pragma unroll
        for (int n = 0; n < 2; ++n) acc[a][b][m][n] = (f32x4){0.f, 0.f, 0.f, 0.f};
  bf16x8 At[4][2], B0[2][2], B1[2][2];
  const char* cA = (const char*)Ag + (size_t)cpm * tstep; const char* cB = (const char*)Btg + (size_t)cpn * tstep;
  static_assert(SP2, "this body is the two-super-phase loop");
  PG8_STAGE(PG8_SB(0, 0), cB); PG8_STAGE(PG8_SB(0, 1), cB + hstep); PG8_STAGE(PG8_SA(0, 0), cA); PG8_STAGE(PG8_SA(0, 1), cA + hstep);
  PG8_STAGE(PG8_SB(1, 0), cB + kstep); PG8_STAGE(PG8_SA(1, 0), cA + kstep); PG8_STAGE(PG8_SB(1, 1), cB + hstep + kstep);
  if (wr == 1) PG8_BAR;
  PG8_WAIT_V(0); PG8_BAR;
  PG8_BAR;
#define K2_ITER(FIRST) do { \
      const bool last = (t == nt - 2); \
      const char* a1 = cA + (size_t)(t + 1) * kstep; \
      const char* a2 = last ? nA : cA + (size_t)(t + 2) * kstep; const char* b2 = last ? nB : cB + (size_t)(t + 2) * kstep; \
      const char* a3 = a2 + kstep; const char* b3 = b2 + kstep; \
      if constexpr (MID) { if (t == (nt >> 1)) E.mid(acc, cpm * BM); } \
      PG8_LDB(B0, 0, 0); PG8_LDB(B1, 0, 1); PG8_SCHED; PG8_LDA(At, 0, 0); PG8_STAGE(PG8_SA(1, 1), a1 + hstep); \
      if constexpr (!(FIRST)) PG8_WAIT_V(8); \
      PG8_WAIT_L(0); PG8_BAR; PG8_MMA(0, 0, At, B0); PG8_MMA(0, 1, At, B1); PG8_BAR; PG8_SCHED; \
      PG8_LDA(At, 0, 1); PG8_STAGE(PG8_SB(0, 0), b2); PG8_STAGE(PG8_SB(0, 1), b2 + hstep); PG8_STAGE(PG8_SA(0, 0), a2); \
      if constexpr (!(FIRST)) PG8_WAIT_V(8); \
      PG8_WAIT_L(0); PG8_BAR; PG8_MMA(1, 0, At, B0); PG8_MMA(1, 1, At, B1); PG8_BAR; PG8_SCHED; \
      PG8_LDB(B0, 1, 0); PG8_LDB(B1, 1, 1); PG8_SCHED; PG8_LDA(At, 1, 0); PG8_STAGE(PG8_SA(0, 1), a2 + hstep); \
      PG8_WAIT_V(8); PG8_WAIT_L(0); PG8_BAR; PG8_MMA(0, 0, At, B0); PG8_MMA(0, 1, At, B1); PG8_BAR; PG8_SCHED; \
      PG8_LDA(At, 1, 1); PG8_STAGE(PG8_SB(1, 0), b3); PG8_STAGE(PG8_SB(1, 1), b3 + hstep); PG8_STAGE(PG8_SA(1, 0), a3); \
      PG8_WAIT_V(8); PG8_WAIT_L(0); PG8_BAR; PG8_MMA(1, 0, At, B0); PG8_MMA(1, 1, At, B1); PG8_BAR; PG8_SCHED; \
    } while (0)
  for (;;) {
    const bool has_next = tile_of((ui + 1) * G + cu, nM, nN, npm, npn);
    const char* nA = has_next ? (const char*)Ag + (size_t)npm * tstep : cA; const char* nB = has_next ? (const char*)Btg + (size_t)npn * tstep : cB;
    { const int t = 0; K2_ITER(true); }
    for (int t = 2; t < nt; t += 2) K2_ITER(false);
    if constexpr (ALIGN_EPI) { if (wr == 0) PG8_BAR; }
    PG8_WAIT_V(0);
    E(acc, cpm * BM, cpn * BM, wr, wc, fr, fq);
    if (!has_next) break;
#pragma unroll
    for (int a = 0; a < 2; ++a)
#pragma unroll
      for (int b = 0; b < 2; ++b)
#pragma unroll
        for (int m = 0; m < 4; ++m)
#pragma unroll
          for (int n = 0; n < 2; ++n) acc[a][b][m][n] = (f32x4){0.f, 0.f, 0.f, 0.f};
    cpm = npm; cpn = npn; cA = nA; cB = nB; ++ui;
    if constexpr (ALIGN_EPI) { if (wr == 1) PG8_BAR; }
  }
  PG8_WAIT_V(0);
  if constexpr (!ALIGN_EPI) { if (wr == 0) PG8_BAR; }
  PG8_BAR;
#undef K2_ITER
#undef PG8_SA
#undef PG8_SB
#undef PG8_STAGE
#undef PG8_LDA
#undef PG8_LDB
#undef PG8_MMA
}

#define EPI_IDS \
    int tid_ = threadIdx.x; asm volatile("" : "+v"(tid_));     \
    const int wid_ = tid_ >> 6, lane_ = tid_ & 63, wr = wid_ >> 2, wc = wid_ & 3, fr = lane_ & 15, fq = lane_ >> 4;
#define PACK16(v, w0, w1) \
    w0.x = pk2(v[0], v[1]); w0.y = pk2(v[2], v[3]); w0.z = pk2(v[4], v[5]); w0.w = pk2(v[6], v[7]); \
    w1.x = pk2(v[8], v[9]); w1.y = pk2(v[10], v[11]); w1.z = pk2(v[12], v[13]); w1.w = pk2(v[14], v[15]);

struct EpiQKV {
  bf16_t* qkv; const float* rs1; const float *qna, *kna, *qnb, *knb;
  __device__ __forceinline__ void operator()(const f32x4 (&acc)[2][2][4][2], int brow, int bcol, int, int, int, int) const {
    EPI_IDS
    const int ct = bcol >> 8;
    const float* gp = nullptr; float extra = 1.f;
    if (ct < 2) { gp = qna; extra = QSCALE; } else if (ct < 4) gp = kna; else if (ct < 6) gp = nullptr; else if (ct < 8) { gp = qnb; extra = QSCALE; } else gp = (wc < 2) ? knb : nullptr;
    float gn[16];
    if (gp) {
#pragma unroll
      for (int i = 0; i < 16; ++i) gn[i] = gp[16 * fq + i] * extra;
    }
    float rsv[8];
#pragma unroll
    for (int r = 0; r < 8; ++r) rsv[r] = rs1[brow + (r >> 2) * HALF + wr * 64 + (r & 3) * 16 + fr];
    const int smask = (brow < NPROMPT) ? 2047 : 4095;
#pragma unroll
    for (int ai = 0; ai < 2; ++ai)
#pragma unroll
      for (int m = 0; m < 4; ++m) {
        const int row = brow + ai * HALF + wr * 64 + m * 16 + fr;
        const float rs = rsv[ai * 4 + m];
        float v[16];
#pragma unroll
        for (int bj = 0; bj < 2; ++bj)
#pragma unroll
          for (int n = 0; n < 2; ++n)
#pragma unroll
            for (int j = 0; j < 4; ++j) v[8 * bj + 4 * n + j] = acc[ai][bj][m][n][j] * rs;
        if (gp) {
          float ss = 0.f;
#pragma unroll
          for (int i = 0; i < 16; ++i) ss += v[i] * v[i];
          ss += __shfl_xor(ss, 16); ss += __shfl_xor(ss, 32);
          const float inv = rsqrtf(ss * (1.0f / 64.0f) + EPS);
#pragma unroll
          for (int i = 0; i < 16; ++i) v[i] = v[i] * inv * gn[i];
          if (fq == 0) {
            const float pos = (float)(row & smask);
#pragma unroll
            for (int i = 0; i < 8; ++i) {
              const float ci = i == 0 ? 1.5915494309e-01f : i == 1 ? 3.0863763405e-02f : i == 2 ? 5.9851857127e-03f : i == 3 ? 1.1606636412e-03f : i == 4 ? 2.2507907904e-04f : i == 5 ? 4.3647952793e-05f : i == 6 ? 8.4643308082e-06f : 1.6414262628e-06f;
              const float tr = __builtin_amdgcn_fractf(pos * ci);
              const float c = __builtin_amdgcn_cosf(tr), s = __builtin_amdgcn_sinf(tr);
              const float x1 = v[i], x2 = v[8 + i];
              v[i] = x1 * c - x2 * s; v[8 + i] = x2 * c + x1 * s;
            }
          }
        }
        u32x4 w0, w1; PACK16(v, w0, w1)
        bf16_t* dst = qkv + (size_t)row * INC + bcol + 64 * wc + 16 * fq;
        *(u32x4*)dst = w0; *(u32x4*)(dst + 8) = w1;
      }
  }
};

struct EpiWo {
  const float *xp, *xs; bf16_t* hb; float* ssq2p; const float* ssqh;
  __device__ __forceinline__ void scales(int row, float& sa, float& sb) const {
    const float* sp = ssqh + (size_t)row * 16;
    const f32x4 a = *(const f32x4*)sp, b = *(const f32x4*)(sp + 4), c = *(const f32x4*)(sp + 8), d = *(const f32x4*)(sp + 12);
    sa = rsqrtf((((a[0] + a[1]) + (a[2] + a[3])) + ((b[0] + b[1]) + (b[2] + b[3]))) * (1.0f / 512.0f) + EPS);
    sb = rsqrtf((((c[0] + c[1]) + (c[2] + c[3])) + ((d[0] + d[1]) + (d[2] + d[3]))) * (1.0f / 512.0f) + EPS);
  }
  __device__ __forceinline__ void mid(f32x4 (&acc)[2][2][4][2], int brow) const {
    EPI_IDS
    (void)wc; (void)fq;
#pragma unroll
    for (int ai = 0; ai < 2; ++ai)
#pragma unroll
      for (int m = 0; m < 4; ++m) {
        float sa, sb; scales(brow + ai * HALF + wr * 64 + m * 16 + fr, sa, sb);
        const float ratio = sa / sb;
#pragma unroll
        for (int bj = 0; bj < 2; ++bj)
#pragma unroll
          for (int n = 0; n < 2; ++n) acc[ai][bj][m][n] = acc[ai][bj][m][n] * ratio;
      }
  }
  __device__ __forceinline__ void operator()(const f32x4 (&acc)[2][2][4][2], int brow, int bcol, int, int, int, int) const {
    EPI_IDS
    const float* xbase = (brow < NPROMPT) ? (xp + (size_t)brow * DM) : (xs + (size_t)(brow - NPROMPT) * DM);
#pragma unroll
    for (int ai = 0; ai < 2; ++ai) {
      f32x4 xv[4][4]; float sbv[4];
#pragma unroll
      for (int m = 0; m < 4; ++m) {
        const int rl = ai * HALF + wr * 64 + m * 16 + fr;
        const float* xr = xbase + (size_t)rl * DM + bcol + 64 * wc + 8 * fq;
#pragma unroll
        for (int q = 0; q < 4; ++q) xv[m][q] = *(const f32x4*)(xr + 32 * (q >> 1) + 4 * (q & 1));
        float sa; scales(brow + rl, sa, sbv[m]);
      }
#pragma unroll
      for (int m = 0; m < 4; ++m) {
        const int rl = ai * HALF + wr * 64 + m * 16 + fr;
        float v[16]; float ss = 0.f;
#pragma unroll
        for (int bj = 0; bj < 2; ++bj)
#pragma unroll
          for (int n = 0; n < 2; ++n)
#pragma unroll
            for (int j = 0; j < 4; ++j) { const float h = xv[m][2 * bj + n][j] + acc[ai][bj][m][n][j] * sbv[m]; v[8 * bj + 4 * n + j] = h; ss += h * h; }
        ss += __shfl_xor(ss, 16); ss += __shfl_xor(ss, 32);
        if (fq == 0) ssq2p[(size_t)(brow + rl) * 16 + (bcol >> 8) * 4 + wc] = ss;
        u32x4 w0, w1; PACK16(v, w0, w1)
        bf16_t* dst = hb + (size_t)(brow + rl) * DM + bcol + 64 * wc + 8 * fq;
        *(u32x4*)dst = w0; *(u32x4*)(dst + 32) = w1;
      }
      __builtin_amdgcn_sched_barrier(0);
    }
  }
};

struct EpiUp {
  bf16_t* u; const float* ssq2p; int row_base;
  __device__ __forceinline__ void operator()(const f32x4 (&acc)[2][2][4][2], int brow, int bcol, int, int, int, int) const {
    EPI_IDS
    float s2v[8];
#pragma unroll
    for (int r = 0; r < 8; ++r) {
      const float* sp = ssq2p + (size_t)(row_base + brow + (r >> 2) * HALF + wr * 64 + (r & 3) * 16 + fr) * 16;
      const f32x4 a = *(const f32x4*)sp, b = *(const f32x4*)(sp + 4), c = *(const f32x4*)(sp + 8), d = *(const f32x4*)(sp + 12);
      const float tot = (((a[0] + a[1]) + (a[2] + a[3])) + ((b[0] + b[1]) + (b[2] + b[3]))) + (((c[0] + c[1]) + (c[2] + c[3])) + ((d[0] + d[1]) + (d[2] + d[3])));
      s2v[r] = rsqrtf(tot * (1.0f / DM) + EPS);
    }
#pragma unroll
    for (int ai = 0; ai < 2; ++ai)
#pragma unroll
      for (int m = 0; m < 4; ++m) {
        const int rl = brow + ai * HALF + wr * 64 + m * 16 + fr;
        const float s2 = s2v[ai * 4 + m];
        float v[16];
#pragma unroll
        for (int bj = 0; bj < 2; ++bj)
#pragma unroll
          for (int n = 0; n < 2; ++n)
#pragma unroll
            for (int j = 0; j < 4; ++j) { const float z = fmaxf(acc[ai][bj][m][n][j] * s2, 0.f); v[8 * bj + 4 * n + j] = z * z; }
        u32x4 w0, w1; PACK16(v, w0, w1)
        bf16_t* dst = u + (size_t)rl * DFF + bcol + 64 * wc + 8 * fq;
        *(u32x4*)dst = w0; *(u32x4*)(dst + 32) = w1;
      }
  }
};

struct EpiDown {
  const bf16_t* hb; float* out; int row_base;
  __device__ __forceinline__ void operator()(const f32x4 (&acc)[2][2][4][2], int brow, int bcol, int, int, int, int) const {
    EPI_IDS
#pragma unroll
    for (int ai = 0; ai < 2; ++ai) {
      u32x2 hv[4][2][2];
#pragma unroll
      for (int m = 0; m < 4; ++m) {
        const size_t off = (size_t)(row_base + brow + ai * HALF + wr * 64 + m * 16 + fr) * DM + bcol + 32 * wc + 4 * fq;
#pragma unroll
        for (int bj = 0; bj < 2; ++bj)
#pragma unroll
          for (int n = 0; n < 2; ++n) hv[m][bj][n] = *(const u32x2*)(hb + off + 128 * bj + 16 * n);
      }
#pragma unroll
      for (int m = 0; m < 4; ++m) {
        const size_t off = (size_t)(row_base + brow + ai * HALF + wr * 64 + m * 16 + fr) * DM + bcol + 32 * wc + 4 * fq;
        float* dst = out + off;
#pragma unroll
        for (int bj = 0; bj < 2; ++bj)
#pragma unroll
          for (int n = 0; n < 2; ++n) {
            const unsigned a = hv[m][bj][n].x, b = hv[m][bj][n].y;
            f32x4 o;
            o[0] = __uint_as_float(a << 16) + acc[ai][bj][m][n][0]; o[1] = __uint_as_float(a & 0xffff0000u) + acc[ai][bj][m][n][1];
            o[2] = __uint_as_float(b << 16) + acc[ai][bj][m][n][2]; o[3] = __uint_as_float(b & 0xffff0000u) + acc[ai][bj][m][n][3];
            *(f32x4*)(dst + 128 * bj + 16 * n) = o;
          }
      }
      __builtin_amdgcn_sched_barrier(0);
    }
  }
};

__device__ __forceinline__ void p0_transpose_item(const float* __restrict__ W, int K, int N, bf16_t* __restrict__ WT, const float* __restrict__ g0, const float* __restrict__ g1, float* scr, int item, int lane, int mode) {
  const int nblk = N / 32, kb = item / nblk, nb = item % nblk, k0 = 64 * kb, n0 = 32 * nb;
#pragma unroll 8
  for (int i = 0; i < 32; ++i) {
    const int kk = 2 * i + (lane >> 5), k = k0 + kk;
    float gv = 1.f; if (g0) gv = (g1 && k >= 512) ? g1[k - 512] : g0[k];
    scr[kk * 33 + (lane & 31)] = W[(size_t)k * N + n0 + (lane & 31)] * gv;
  }
  asm volatile("s_waitcnt lgkmcnt(0)" ::: "memory");
  const int c = lane & 7;
#pragma unroll
  for (int j = 0; j < 4; ++j) {
    const int n = (lane >> 3) + 8 * j; const float* s = scr + (8 * c) * 33 + n;
    u32x4 o; o.x = pk2(s[0 * 33], s[1 * 33]); o.y = pk2(s[2 * 33], s[3 * 33]); o.z = pk2(s[4 * 33], s[5 * 33]); o.w = pk2(s[6 * 33], s[7 * 33]);
    const int col = n0 + n, drow = (col & ~255) + col_slot(col & 255, mode);
    *(u32x4*)(WT + (size_t)drow * K + k0 + 8 * c) = o;
  }
  asm volatile("s_waitcnt lgkmcnt(0)" ::: "memory");
}

__device__ __forceinline__ void p0_prologue(const Params& p) {
  int tid = threadIdx.x; asm volatile("" : "+v"(tid));
  const int wave = tid >> 6, lane = tid & 63;
  const int gw = blockIdx.x * 8 + wave, NGW = gridDim.x * 8;
  float* scr = (float*)(g_shm + wave * 16384);
  bf16_t* WinT = (bf16_t*)(p.ws + WS_WIN); bf16_t* WoT = (bf16_t*)(p.ws + WS_WO); bf16_t* WupT = (bf16_t*)(p.ws + WS_WUP); bf16_t* WdT = (bf16_t*)(p.ws + WS_WD);
  constexpr int I_IN = 16 * 72, I_O = 16 * 32, I_UP = 16 * 128, I_DN = 64 * 32, NIT = I_IN + I_O + I_UP + I_DN;
  for (int it = gw; it < NIT; it += NGW) {
    int r = it;
    if (r < I_IN) { p0_transpose_item(p.w_in, DM, INC, WinT, p.norm_attn, nullptr, scr, r, lane, 0); continue; } r -= I_IN;
    if (r < I_O) { p0_transpose_item(p.w_o, DM, DM, WoT, p.ona, p.onb, scr, r, lane, 1); continue; } r -= I_O;
    if (r < I_UP) { p0_transpose_item(p.w_up, DM, DFF, WupT, p.norm_mlp, nullptr, scr, r, lane, 1); continue; } r -= I_UP;
    p0_transpose_item(p.w_down, DFF, DM, WdT, nullptr, nullptr, scr, r, lane, 2);
  }
  bf16_t* xb = (bf16_t*)(p.ws + WS_X); float* rs1 = (float*)(p.ws + WS_RS1);
  for (int row4 = gw * 4; row4 < NTOK; row4 += NGW * 4) {
    f32x4 v[4][4];
#pragma unroll
    for (int r = 0; r < 4; ++r) {
      const int row = row4 + r;
      const float* xr = (row < NPROMPT) ? (p.xp + (size_t)row * DM) : (p.xs + (size_t)(row - NPROMPT) * DM);
#pragma unroll
      for (int j = 0; j < 4; ++j) v[r][j] = *(const f32x4*)(xr + 256 * j + 4 * lane);
    }
#pragma unroll
    for (int r = 0; r < 4; ++r) {
      const int row = row4 + r; float s = 0.f;
#pragma unroll
      for (int j = 0; j < 4; ++j) s += (v[r][j][0] * v[r][j][0] + v[r][j][1] * v[r][j][1]) + (v[r][j][2] * v[r][j][2] + v[r][j][3] * v[r][j][3]);
#pragma unroll
      for (int o = 1; o < 64; o <<= 1) s += __shfl_xor(s, o);
#pragma unroll
      for (int j = 0; j < 4; ++j) { u32x2 w; w.x = pk2(v[r][j][0], v[r][j][1]); w.y = pk2(v[r][j][2], v[r][j][3]); *(u32x2*)(xb + (size_t)row * DM + 256 * j + 4 * lane) = w; }
      if (lane == 0) rs1[row] = rsqrtf(s * (1.0f / DM) + EPS);
    }
  }
}

struct ChunkSrc { int rowc, d, M, kc0; };

__device__ __forceinline__ void issue_chunk(const bf16_t* __restrict__ qkv, const ChunkSrc cs, int koff, int voff, int lane, unsigned char* slot) {
  const unsigned ck = (unsigned)(koff * 2), cv = (unsigned)(voff * 2);
#pragma unroll
  for (int i = 0; i < 4; ++i) {
    const int r = (lane >> 3) + 8 * i;
    int kc = cs.kc0 + r; kc = kc < 0 ? 0 : (kc > cs.M - 1 ? cs.M - 1 : kc);
    const unsigned row = __umul24((unsigned)cs.d, (unsigned)kc) + (unsigned)cs.rowc;
    const unsigned rb = __umul24(row, (unsigned)(INC * 2));
    const unsigned chk = (unsigned)(((lane & 7) ^ ((r >> 1) & 7)) << 4), chv = (unsigned)(((lane & 7) ^ (((r >> 1) & 3) << 1)) << 4);
    __builtin_amdgcn_global_load_lds((const __attribute__((address_space(1))) unsigned*)((const char*)qkv + (rb + (ck + chk))), (LAS unsigned*)(slot + i * 1024), 16, 0, 0);
    __builtin_amdgcn_global_load_lds((const __attribute__((address_space(1))) unsigned*)((const char*)qkv + (rb + (cv + chv))), (LAS unsigned*)(slot + 4096 + i * 1024), 16, 0, 0);
  }
}
__device__ __forceinline__ void read_vt(unsigned a0, unsigned a1, unsigned a2, unsigned a3, bf16x8 (&Vt)[4]) {
  u32x2 r00, r01, r10, r11, r20, r21, r30, r31;
  asm volatile(
      "ds_read_b64_tr_b16 %0, %8\n\tds_read_b64_tr_b16 %1, %8 offset:2048\n\t"
      "ds_read_b64_tr_b16 %2, %9\n\tds_read_b64_tr_b16 %3, %9 offset:2048\n\t"
      "ds_read_b64_tr_b16 %4, %10\n\tds_read_b64_tr_b16 %5, %10 offset:2048\n\t"
      "ds_read_b64_tr_b16 %6, %11\n\tds_read_b64_tr_b16 %7, %11 offset:2048\n\t"
      "s_waitcnt lgkmcnt(0)"
      : "=&v"(r00), "=&v"(r01), "=&v"(r10), "=&v"(r11), "=&v"(r20), "=&v"(r21), "=&v"(r30), "=&v"(r31)
      : "v"(a0), "v"(a1), "v"(a2), "v"(a3) : "memory");
  u32x4 t;
  t.x = r00.x; t.y = r00.y; t.z = r01.x; t.w = r01.y; Vt[0] = __builtin_bit_cast(bf16x8, t);
  t.x = r10.x; t.y = r10.y; t.z = r11.x; t.w = r11.y; Vt[1] = __builtin_bit_cast(bf16x8, t);
  t.x = r20.x; t.y = r20.y; t.z = r21.x; t.w = r21.y; Vt[2] = __builtin_bit_cast(bf16x8, t);
  t.x = r30.x; t.y = r30.y; t.z = r31.x; t.w = r31.y; Vt[3] = __builtin_bit_cast(bf16x8, t);
}
__device__ __forceinline__ void tile_chunk(const bf16x8 (&Kf)[2][2], const bf16x8 (&Q)[2], const bf16x8 (&Vt)[4], f32x4 (&o)[4], float& l, int kcl, int lo, unsigned span, float negm) {
  f32x4 s0 = {negm, negm, negm, negm}, s1 = s0;
  s0 = mfma16(Kf[0][0], Q[0], s0); s0 = mfma16(Kf[0][1], Q[1], s0);
  s1 = mfma16(Kf[1][0], Q[0], s1); s1 = mfma16(Kf[1][1], Q[1], s1);
  float pv[8]; float sum = 0.f;
#pragma unroll
  for (int j = 0; j < 4; ++j) {
    pv[j] = ((unsigned)(kcl + j - lo) <= span) ? __builtin_amdgcn_exp2f(s0[j]) : 0.f;
    pv[4 + j] = ((unsigned)(kcl + 16 + j - lo) <= span) ? __builtin_amdgcn_exp2f(s1[j]) : 0.f;
    sum += pv[j] + pv[4 + j];
  }
  l += sum;
  u32x4 pk; pk.x = pk2(pv[0], pv[1]); pk.y = pk2(pv[2], pv[3]); pk.z = pk2(pv[4], pv[5]); pk.w = pk2(pv[6], pv[7]);
  const bf16x8 P = __builtin_bit_cast(bf16x8, pk);
#pragma unroll
  for (int dt = 0; dt < 4; ++dt) o[dt] = mfma16(Vt[dt], P, o[dt]);
}

template <int TMASK, class DESC>
__device__ __forceinline__ void run_branch(const bf16_t* __restrict__ qkv, const DESC& desc, int& gi, const int total, const int nchunks, const int M, const int kstart, int koff, int voff,
                                           int qcb, int qstep, int hw, float negm, int lane, unsigned char* ring, const bf16x8 (&Q)[4][2], f32x4 (&o)[4][4], float (&l)[4]) {
  const int g = lane >> 4;
  int lo[4]; unsigned span[4];
#pragma unroll
  for (int t = 0; t < 4; ++t) { const int qc = qcb + t * qstep; lo[t] = qc - hw < 0 ? 0 : qc - hw; const int hi = qc + hw > M - 1 ? M - 1 : qc + hw; span[t] = (unsigned)(hi - lo[t]); }
  const int qp = (lane & 15) >> 2, pp = lane & 3, rl = 4 * g + qp, f = (rl >> 1) & 3;
  const unsigned vbase = (unsigned)(size_t)ring + 4096 + rl * 128 + pp * 8;
  const unsigned a0 = vbase + ((0 ^ f) << 5), a1 = vbase + ((1 ^ f) << 5), a2 = vbase + ((2 ^ f) << 5), a3 = vbase + ((3 ^ f) << 5);
  const int krow = lane & 15;
  const LAS unsigned char* kb0 = (const LAS unsigned char*)ring + krow * 128 + (((0 + g) ^ (krow >> 1)) << 4);
  const LAS unsigned char* kb1 = (const LAS unsigned char*)ring + krow * 128 + (((4 + g) ^ (krow >> 1)) << 4);
#pragma unroll 1
  for (int c = 0; c < nchunks; ++c, ++gi) {
    const unsigned soff = (unsigned)(gi & (ATT_SLOTS - 1)) * 8192u;
    bf16x8 Kf[2][2];
    if constexpr (ATT_LA == 1) {
      asm volatile("s_waitcnt vmcnt(0)" ::: "memory");
      Kf[0][0] = *(const LAS bf16x8*)(kb0 + soff); Kf[0][1] = *(const LAS bf16x8*)(kb1 + soff);
      Kf[1][0] = *(const LAS bf16x8*)(kb0 + soff + 2048); Kf[1][1] = *(const LAS bf16x8*)(kb1 + soff + 2048);
      if (gi + 1 < total) issue_chunk(qkv, desc(gi + 1), koff, voff, lane, ring + ((gi + 1) & 1) * 8192);
    } else {
      if (gi + ATT_LA < total) issue_chunk(qkv, desc(gi + ATT_LA), koff, voff, lane, ring + ((gi + ATT_LA) & (ATT_SLOTS - 1)) * 8192);
      const int rem = total - 1 - gi;
      if (ATT_LA >= 3 && rem >= 3) asm volatile("s_waitcnt vmcnt(24)" ::: "memory");
      else if (ATT_LA >= 2 && rem >= 2) asm volatile("s_waitcnt vmcnt(16)" ::: "memory");
      else if (rem >= 1) asm volatile("s_waitcnt vmcnt(8)" ::: "memory");
      else asm volatile("s_waitcnt vmcnt(0)" ::: "memory");
      Kf[0][0] = *(const LAS bf16x8*)(kb0 + soff); Kf[0][1] = *(const LAS bf16x8*)(kb1 + soff);
      Kf[1][0] = *(const LAS bf16x8*)(kb0 + soff + 2048); Kf[1][1] = *(const LAS bf16x8*)(kb1 + soff + 2048);
    }
    bf16x8 Vt[4];
    read_vt(a0 + soff, a1 + soff, a2 + soff, a3 + soff, Vt);
    const int kcl = kstart + 32 * c + 4 * g;
#pragma unroll
    for (int t = 0; t < 4; ++t)
      if (TMASK & (1 << t)) tile_chunk(Kf, Q[t], Vt, o[t], l[t], kcl, lo[t], span[t], negm);
  }
}

__device__ __forceinline__ float wave_max(float v) {
#pragma unroll
  for (int o = 1; o < 64; o <<= 1) v = fmaxf(v, __shfl_xor(v, o));
  return v;
}

__device__ __forceinline__ void attn_phase(const Params& p) {
  int tid = threadIdx.x; asm volatile("" : "+v"(tid));
  const int wave = __builtin_amdgcn_readfirstlane(tid >> 6), lane = tid & 63, qi = lane & 15, g = lane >> 4;
  if (wave >= ATT_NACT) return;
  const bf16_t* qkv = (const bf16_t*)(p.ws + WS_QKV);
  bf16_t* mix = (bf16_t*)(p.ws + WS_X);
  float* ssqh = (float*)(p.ws + WS_SSQH);
  unsigned char* ring = g_shm + wave * (ATT_SLOTS * 8192);
  const float mfixA = 8.0f * LOG2E * wave_max(fabsf(p.qna[lane])) * wave_max(fabsf(p.kna[lane]));
  const float mfixB = 8.0f * LOG2E * wave_max(fabsf(p.qnb[lane])) * wave_max(fabsf(p.knb[lane]));
  const int xcd = blockIdx.x & 7, wx = (blockIdx.x >> 3) * ATT_NACT + wave, nwx = (gridDim.x >> 3) * ATT_NACT;
  for (int li = wx; li < 2048; li += nwx) {
    const int kind = (li / nwx) & 1;
    const int lk = ((li / nwx) >> 1) * nwx + (li % nwx);
    const int grp = xcd * 128 + (lk & 127), sub = lk >> 7;
    const int r64 = grp * 64;
    const int S = r64 < NPROMPT ? 2048 : 4096;
    const int row0 = r64 & ~(S - 1);
    bf16x8 Q[4][2]; f32x4 o[4][4]; float l[4];
#pragma unroll
    for (int t = 0; t < 4; ++t) {
#pragma unroll
      for (int dt = 0; dt < 4; ++dt) o[t][dt] = (f32x4){0.f, 0.f, 0.f, 0.f};
    }
    int tok[4], colb[4];
    int gi = 0;
    if (kind == 0) {
      const int sidx = (r64 - row0) >> 6, c4 = sidx & 3, p0 = (sidx >> 2) * 16, h = sub;
#pragma unroll
      for (int t = 0; t < 4; ++t) {
        tok[t] = 16 * (p0 + qi) + c4 + 4 * t; colb[t] = h * 64; l[t] = 0.f;
        const bf16_t* rp = qkv + (size_t)(row0 + tok[t]) * INC + h * 64 + g * 8;
        Q[t][0] = *(const bf16x8*)rp; Q[t][1] = *(const bf16x8*)(rp + 32);
      }
      const int koff = 512 + h * 64, voff = 1024 + h * 64;
      auto desc = [=](int i) -> ChunkSrc {
        ChunkSrc r;
        if (i < 12) { r.rowc = row0; r.d = 1; r.M = S; r.kc0 = 16 * p0 - 64 + 32 * i; }
        else if (i < 18) { r.rowc = row0 + c4; r.d = 4; r.M = S >> 2; r.kc0 = 4 * p0 - 64 + 32 * (i - 12); }
        else { const int j = i - 18, t = j / 5, c = j - 5 * t; r.rowc = row0 + c4 + 4 * t; r.d = 16; r.M = S >> 4; r.kc0 = p0 - 64 + 32 * c; }
        return r;
      };
      constexpr int TOTAL = 38;
#pragma unroll
      for (int i = 0; i < ATT_LA; ++i) issue_chunk(qkv, desc(i), koff, voff, lane, ring + i * 8192);
      run_branch<15>(qkv, desc, gi, TOTAL, 12, S, 16 * p0 - 64, koff, voff, 16 * (p0 + qi) + c4, 4, 64, -mfixA, lane, ring, Q, o, l);
      run_branch<15>(qkv, desc, gi, TOTAL, 6, S >> 2, 4 * p0 - 64, koff, voff, 4 * (p0 + qi), 1, 64, -mfixA, lane, ring, Q, o, l);
      run_branch<1>(qkv, desc, gi, TOTAL, 5, S >> 4, p0 - 64, koff, voff, p0 + qi, 0, 64, -mfixA, lane, ring, Q, o, l);
      run_branch<2>(qkv, desc, gi, TOTAL, 5, S >> 4, p0 - 64, koff, voff, p0 + qi, 0, 64, -mfixA, lane, ring, Q, o, l);
      run_branch<4>(qkv, desc, gi, TOTAL, 5, S >> 4, p0 - 64, koff, voff, p0 + qi, 0, 64, -mfixA, lane, ring, Q, o, l);
      run_branch<8>(qkv, desc, gi, TOTAL, 5, S >> 4, p0 - 64, koff, voff, p0 + qi, 0, 64, -mfixA, lane, ring, Q, o, l);
    } else {
      const int kvh = sub & 1, qsub = sub >> 1, q0 = (r64 - row0) + 16 * qsub;
#pragma unroll
      for (int t = 0; t < 4; ++t) {
        const int hq = kvh * 4 + t;
        tok[t] = q0 + qi; colb[t] = 512 + hq * 64;
        l[t] = (g == 0) ? __builtin_amdgcn_exp2f(p.sink[hq] * LOG2E - mfixB) : 0.f;
        const bf16_t* rp = qkv + (size_t)(row0 + tok[t]) * INC + 1536 + hq * 64 + g * 8;
        Q[t][0] = *(const bf16x8*)rp; Q[t][1] = *(const bf16x8*)(rp + 32);
      }
      const int koff = 2048 + kvh * 64, voff = 2176 + kvh * 64;
      auto desc = [=](int i) -> ChunkSrc { ChunkSrc r; r.rowc = row0; r.d = 1; r.M = S; r.kc0 = q0 - 128 + 32 * i; return r; };
      constexpr int TOTAL = 9;
#pragma unroll
      for (int i = 0; i < ATT_LA; ++i) issue_chunk(qkv, desc(i), koff, voff, lane, ring + i * 8192);
      run_branch<15>(qkv, desc, gi, TOTAL, 9, S, q0 - 128, koff, voff, q0 + qi, 0, 128, -mfixB, lane, ring, Q, o, l);
    }
#pragma unroll
    for (int t = 0; t < 4; ++t) {
      float L = l[t]; L += __shfl_xor(L, 16); L += __shfl_xor(L, 32);
      const float inv = 1.0f / L; float ss = 0.f;
#pragma unroll
      for (int dt = 0; dt < 4; ++dt)
#pragma unroll
        for (int j = 0; j < 4; ++j) { const float x = o[t][dt][j] * inv; o[t][dt][j] = x; ss += x * x; }
      ss += __shfl_xor(ss, 16); ss += __shfl_xor(ss, 32);
      const size_t row = (size_t)(row0 + tok[t]);
      if (g == 0) ssqh[row * 16 + (colb[t] >> 6)] = ss;
      bf16_t* dst = mix + row * DM + colb[t] + 4 * g;
#pragma unroll
      for (int dt = 0; dt < 4; ++dt) { u32x2 w; w.x = pk2(o[t][dt][0], o[t][dt][1]); w.y = pk2(o[t][dt][2], o[t][dt][3]); *(u32x2*)(dst + 16 * dt) = w; }
    }
  }
}

#define XB_TMO      128
#define XB_XCNT(j)  (256  + 64 * (j))
#define XB_XSUB(j)  (1280 + 64 * (j))
#define XB_XGEN(j)  (2304 + 64 * (j))
#define XB_TOP      3328
#define XB_TOPGEN   3392
#define XCD_BAR_WORDS 3456
#define XB_SPIN_CAP (1u << 18)
__device__ __forceinline__ unsigned xb_ld(unsigned* p)              { return __hip_atomic_load(p, __ATOMIC_RELAXED, __HIP_MEMORY_SCOPE_AGENT); }
__device__ __forceinline__ unsigned xb_add(unsigned* p, unsigned v) { return __hip_atomic_fetch_add(p, v, __ATOMIC_RELAXED, __HIP_MEMORY_SCOPE_AGENT); }
__device__ __forceinline__ unsigned xb_xcc_id() { return (unsigned)__builtin_amdgcn_s_getreg((3 << 11) | 20) & 0xFu; }
#define XB_SPIN(cond, bar) do { unsigned _sp = 0; while (cond) { __builtin_amdgcn_s_sleep(1); \
    if ((++_sp & 255u) == 0u) { if (xb_ld(&(bar)[XB_TMO])) break; if (_sp > XB_SPIN_CAP) { atomicAdd(&(bar)[XB_TMO], 1u); break; } } } } while (0)
struct XcdBarrier { unsigned* bar; unsigned x; volatile LAS unsigned* st; };
__device__ __forceinline__ XcdBarrier xcd_barrier_post(unsigned* bar, volatile LAS unsigned* st) {
  XcdBarrier b; b.bar = bar; b.x = xb_xcc_id(); b.st = st;
  if (threadIdx.x == 0) (void)xb_add(&bar[XB_XCNT(b.x)], 1u);
  return b;
}
__device__ __forceinline__ void xcd_barrier_complete(unsigned* bar, unsigned x, unsigned& nloc, unsigned& nx) {
  const unsigned G = gridDim.x * gridDim.y * gridDim.z;
  unsigned sum, cnt, mine, sp = 0u;
  for (;;) {
    sum = 0u; cnt = 0u; mine = 0u;
#pragma unroll
    for (unsigned j = 0; j < 16; ++j) { const unsigned c = xb_ld(&bar[XB_XCNT(j)]); sum += c; cnt += (c > 0u) ? 1u : 0u; mine = (j == x) ? c : mine; }
    if (sum == G) break;
    __builtin_amdgcn_s_sleep(1);
    if ((++sp & 255u) == 0u) { if (xb_ld(&bar[XB_TMO])) break; if (sp > XB_SPIN_CAP) { atomicAdd(&bar[XB_TMO], 1u); break; } }
  }
  nloc = mine > 0u ? mine : 1u; nx = cnt > 0u ? cnt : 1u;
}
__device__ __forceinline__ void xcd_barrier_impl(const XcdBarrier& b) {
  asm volatile("s_waitcnt vmcnt(0)" ::: "memory");
  __syncthreads();
  if (threadIdx.x == 0) {
    unsigned* bar = b.bar;
    __builtin_amdgcn_s_waitcnt(0);
    unsigned nloc = b.st[0], nx = b.st[1];
    if (nloc == 0u) { xcd_barrier_complete(bar, b.x, nloc, nx); b.st[0] = nloc; b.st[1] = nx; }
    const unsigned old = xb_add(&bar[XB_XSUB(b.x)], 1u);
    const unsigned gen = old / nloc;
    if (old + 1u == (gen + 1u) * nloc) {
      __builtin_amdgcn_fence(__ATOMIC_RELEASE, "agent");
      asm volatile("s_waitcnt vmcnt(0)" ::: "memory");
      const unsigned og = xb_add(&bar[XB_TOP], 1u);
      const unsigned tg = og / nx;
      if (og + 1u == (tg + 1u) * nx) xb_add(&bar[XB_TOPGEN], 1u);
      else XB_SPIN(xb_ld(&bar[XB_TOPGEN]) == tg, bar);
      __builtin_amdgcn_fence(__ATOMIC_ACQUIRE, "agent");
      xb_add(&bar[XB_XGEN(b.x)], 1u);
      asm volatile("s_waitcnt vmcnt(0)" ::: "memory");
    } else {
      XB_SPIN(xb_ld(&bar[XB_XGEN(b.x)]) == gen, bar);
      __builtin_amdgcn_fence(__ATOMIC_ACQUIRE, "agent");
      asm volatile("s_waitcnt vmcnt(0)" ::: "memory");
    }
  }
  __syncthreads();
}

__device__ __forceinline__ void xcd_barrier(unsigned char* ws) {
  XcdBarrier b; b.bar = (unsigned*)(ws + WS_BAR); b.x = xb_xcc_id(); b.st = (volatile LAS unsigned*)((LAS unsigned char*)g_shm + GEMM_LDS_BYTES);
  xcd_barrier_impl(b);
}

typedef const __attribute__((address_space(4))) Params* KArgs;
__device__ __forceinline__ Params load_params() {
#if defined(__HIP_DEVICE_COMPILE__)
  KArgs kp = (KArgs)__builtin_amdgcn_kernarg_segment_ptr();
  asm volatile("" : "+s"(kp));
  Params r;
  r.xp = kp->xp; r.xs = kp->xs; r.norm_attn = kp->norm_attn; r.w_in = kp->w_in; r.qna = kp->qna; r.kna = kp->kna; r.qnb = kp->qnb; r.knb = kp->knb; r.sink = kp->sink;
  r.ona = kp->ona; r.onb = kp->onb; r.w_o = kp->w_o; r.norm_mlp = kp->norm_mlp; r.w_up = kp->w_up; r.w_down = kp->w_down; r.out = kp->out; r.ws = kp->ws;
  return r;
#else
  return Params{};
#endif
}

__global__ void __launch_bounds__(512) fwd_megakernel(Params p_unused) {
  cg::grid_group grid = cg::this_grid();
  {
    const Params p = load_params();
    volatile LAS unsigned* xst = (volatile LAS unsigned*)((LAS unsigned char*)g_shm + GEMM_LDS_BYTES);
    if (threadIdx.x == 0) { xst[0] = 0u; xst[1] = 0u; }
    (void)xcd_barrier_post((unsigned*)(p.ws + WS_BAR), xst);
    p0_prologue(p);
    if (p.ws == nullptr) grid.sync();
    xcd_barrier(p.ws);
  }
  {
    const Params p = load_params();
    EpiQKV e{(bf16_t*)(p.ws + WS_QKV), (const float*)(p.ws + WS_RS1), p.qna, p.kna, p.qnb, p.knb};
    gemm_phase<EpiQKV, GEMM_ALIGN, GEMM_SP2>((const bf16_t*)(p.ws + WS_X), (const bf16_t*)(p.ws + WS_WIN), NTOK, INC, DM, e);
    xcd_barrier(p.ws);
  }
  {
    const Params p = load_params();
    attn_phase(p);
    xcd_barrier(p.ws);
  }
  {
    const Params p = load_params();
    EpiWo e{p.xp, p.xs, (bf16_t*)(p.ws + WS_HB), (float*)(p.ws + WS_SSQ2), (const float*)(p.ws + WS_SSQH)};
    gemm_phase<EpiWo, GEMM_ALIGN, GEMM_SP2, true>((const bf16_t*)(p.ws + WS_X), (const bf16_t*)(p.ws + WS_WO), NTOK, DM, DM, e);
    xcd_barrier(p.ws);
  }
  for (int half = 0; half < 2; ++half) {
    const int rb = half * NPROMPT;
    {
      const Params p = load_params();
      EpiUp e{(bf16_t*)(p.ws + WS_U), (const float*)(p.ws + WS_SSQ2), rb};
      gemm_phase<EpiUp, GEMM_ALIGN, GEMM_SP2>((const bf16_t*)(p.ws + WS_HB) + (size_t)rb * DM, (const bf16_t*)(p.ws + WS_WUP), NPROMPT, DFF, DM, e);
      xcd_barrier(p.ws);
    }
    {
      const Params p = load_params();
      EpiDown e{(const bf16_t*)(p.ws + WS_HB), p.out, rb};
      gemm_phase<EpiDown, GEMM_ALIGN, GEMM_SP2>((const bf16_t*)(p.ws + WS_U), (const bf16_t*)(p.ws + WS_WD), NPROMPT, DM, DFF, e);
      if (half == 0) xcd_barrier(p.ws);
    }
  }
}

extern "C" void kernel_launch(void* const* d_in, const int* in_sizes, int n_in, void* d_out, int out_size, void* d_ws, size_t ws_size, hipStream_t stream) {
  static int grid_blocks = 0;
  if (!grid_blocks) {
    if (n_in != 15 || ws_size < WS_NEED) { fprintf(stderr, "kernel_launch: unexpected n_in %d / ws_size %zu\n", n_in, ws_size); grid_blocks = -1; return; }
    int dev = 0, cus = 0, per_cu = 0;
    hipGetDevice(&dev);
    hipDeviceGetAttribute(&cus, hipDeviceAttributeMultiprocessorCount, dev);
    if (hipFuncSetAttribute((const void*)fwd_megakernel, hipFuncAttributeMaxDynamicSharedMemorySize, LDS_BYTES) != hipSuccess) { fprintf(stderr, "hipFuncSetAttribute failed\n"); grid_blocks = -1; return; }
    hipOccupancyMaxActiveBlocksPerMultiprocessor(&per_cu, (const void*)fwd_megakernel, 512, LDS_BYTES);
    if (per_cu < 1) { fprintf(stderr, "occupancy query says %d blocks/CU\n", per_cu); per_cu = 1; }
    (void)hipGetLastError();
    grid_blocks = cus;
  }
  if (grid_blocks < 0) return;
  if (hipMemsetAsync((char*)d_ws + WS_BAR, 0, 16384, stream) != hipSuccess) { fprintf(stderr, "hipMemsetAsync of the barrier words failed\n"); return; }
  Params p{};
  p.xp = (const float*)d_in[0]; p.xs = (const float*)d_in[1]; p.norm_attn = (const float*)d_in[2]; p.w_in = (const float*)d_in[3];
  p.qna = (const float*)d_in[4]; p.kna = (const float*)d_in[5]; p.qnb = (const float*)d_in[6]; p.knb = (const float*)d_in[7];
  p.sink = (const float*)d_in[8]; p.ona = (const float*)d_in[9]; p.onb = (const float*)d_in[10]; p.w_o = (const float*)d_in[11];
  p.norm_mlp = (const float*)d_in[12]; p.w_up = (const float*)d_in[13]; p.w_down = (const float*)d_in[14];
  p.out = (float*)d_out; p.ws = (unsigned char*)d_ws;
  void* args[] = {&p};
  hipError_t e = hipLaunchCooperativeKernel((const void*)fwd_megakernel, dim3(grid_blocks), dim3(512), args, LDS_BYTES, stream);
  if (e != hipSuccess) fprintf(stderr, "cooperative launch failed: %s (grid %d)\n", hipGetErrorString(e), grid_blocks);
}
```

```cpp
#include <hip/hip_runtime.h>
#include <hip/hip_cooperative_groups.h>
#include <cstdio>
#include <cstdint>
namespace cg = cooperative_groups;

typedef unsigned short bf16_t;
typedef short bf16x8 __attribute__((ext_vector_type(8)));
typedef float f32x4 __attribute__((ext_vector_type(4)));
typedef unsigned u32x4 __attribute__((ext_vector_type(4)));
typedef unsigned u32x2 __attribute__((ext_vector_type(2)));

constexpr int DM = 1024, NTOK = 65536, NPROMPT = 32768, INC = 2304, DFF = 4096;
constexpr float EPS = 1e-6f;
constexpr float LOG2E = 1.4426950408889634f;
constexpr float QSCALE = 0.18033688011112042f;

constexpr size_t MiB = 1048576;
constexpr size_t WS_WIN = 0, WS_WO = 4718592, WS_WUP = 6815744, WS_WD = 15204352, WS_RS1 = 23592960, WS_SSQ2 = 440 * MiB;
constexpr size_t WS_X = 24 * MiB;
constexpr size_t WS_QKV = 152 * MiB;
constexpr size_t WS_HB = 312 * MiB;
constexpr size_t WS_U = 24 * MiB;
constexpr size_t WS_SSQH = 444 * MiB;
constexpr size_t WS_BAR = 448 * MiB;
constexpr size_t WS_NEED = 449 * MiB;

constexpr int GEMM_LDS_BYTES = 131072, LDS_BYTES = GEMM_LDS_BYTES + 64;
constexpr bool GEMM_ALIGN = true, GEMM_SP2 = true;
constexpr int ATT_NACT = 8;
constexpr int ATT_SLOTS = 16 / ATT_NACT, ATT_LA = ATT_SLOTS - 1;

struct Params {
  const float *xp, *xs, *norm_attn, *w_in, *qna, *kna, *qnb, *knb, *sink, *ona, *onb, *w_o, *norm_mlp, *w_up, *w_down;
  float* out;
  unsigned char* ws;
};

extern __shared__ __attribute__((aligned(16))) unsigned char g_shm[];

typedef __bf16 bf16v2_t __attribute__((ext_vector_type(2)));
typedef float f32v2_t __attribute__((ext_vector_type(2)));
__device__ __forceinline__ unsigned pk2(float lo, float hi) { const f32v2_t f = {lo, hi}; const bf16v2_t b = __builtin_convertvector(f, bf16v2_t); return __builtin_bit_cast(unsigned, b); }
__device__ __forceinline__ float bf2f(unsigned short b) { return __uint_as_float(((unsigned)b) << 16); }
__device__ __forceinline__ f32x4 mfma16(bf16x8 a, bf16x8 b, f32x4 c) { return __builtin_amdgcn_mfma_f32_16x16x32_bf16(a, b, c, 0, 0, 0); }

__device__ __forceinline__ int col_slot(int c, int mode) {
  if (mode == 0) return 128 * ((c >> 3) & 1) + 32 * (c >> 6) + 16 * ((c >> 2) & 1) + 4 * ((c >> 4) & 3) + (c & 3);
  if (mode == 1) return 128 * ((c >> 5) & 1) + 32 * (c >> 6) + 16 * ((c >> 2) & 1) + 4 * ((c >> 3) & 3) + (c & 3);
  return c;
}

constexpr int BM = 256, BK = 64, HALF = 128, HT = HALF * BK;
__device__ __forceinline__ int lds_byte(int r, int c) {
  int st = (r >> 4) * 2 + (c >> 5), rr = r & 15, cc = c & 31, ob = rr * 64 + cc * 2;
  return st * 1024 + (ob ^ (((ob >> 9) & 1) << 5));
}
__device__ __forceinline__ void stage_rc(int b, int& R, int& C) {
  int st = b / 1024, sb = b % 1024, swz = sb ^ (((sb >> 9) & 1) << 5);
  R = (st >> 1) * 16 + swz / 64; C = (st & 1) * 32 + (swz % 64) / 2;
}

__device__ __forceinline__ bool tile_of(int L, int nM, int nN, int& pm, int& pn) {
  const int nwg = nM * nN; if (L >= nwg) return false;
  int wgid = L; { const int q = nwg / 8, r = nwg % 8, xcd = wgid % 8, off = wgid / 8; wgid = (xcd < r ? xcd * (q + 1) : r * (q + 1) + (xcd - r) * q) + off; }
  const int nig = 8 * nN, gid = wgid / nig, fm = gid * 8, gsz = (nM - fm) < 8 ? (nM - fm) : 8;
  pm = fm + ((wgid % nig) % gsz); pn = (wgid % nig) / gsz; return true;
}
#define LAS __attribute__((address_space(3)))
template <class Epi, bool ALIGN_EPI, bool SP2, bool MID = false>
__device__ __forceinline__ void gemm_phase(const bf16_t* __restrict__ Ag, const bf16_t* __restrict__ Btg, const int M, const int N, const int K, const Epi& E) {
  LAS unsigned char* lds = (LAS unsigned char*)g_shm;
  int tid = threadIdx.x; asm volatile("" : "+v"(tid));
  const int wid = __builtin_amdgcn_readfirstlane(tid >> 6), lane = tid & 63, wr = wid >> 2, wc = wid & 3, fr = lane & 15, fq = lane >> 4;
  const int nt = K / BK, nM = M / BM, nN = N / BM, G = gridDim.x, cu = blockIdx.x;
  constexpr int HTB = HALF * BK * 2;
  unsigned voff[2];
#pragma unroll
  for (int i = 0; i < 2; ++i) { int R, C; stage_rc(tid * 16 + i * 8192, R, C); voff[i] = (unsigned)(R * K + C) * 2u; }
  const size_t kstep = (size_t)(BK * 2), hstep = (size_t)HALF * K * 2, tstep = 2 * hstep;
  const unsigned ldsw = (unsigned)wid * 1024u;
  const int aoff = lds_byte(wr * 64 + fr, fq * 8), boff = lds_byte(wc * 32 + fr, fq * 8);
#define PG8_SA(b, h) (((b) * 2 + (h)) * HTB)
#define PG8_SB(b, h) ((4 + (b) * 2 + (h)) * HTB)
#define PG8_STAGE(bufoff, gbase) do { _Pragma("unroll") for (int _i = 0; _i < 2; ++_i) \
    __builtin_amdgcn_global_load_lds((const __attribute__((address_space(1))) unsigned*)((const char*)(gbase) + voff[_i]), (LAS unsigned*)(lds + (bufoff) + ldsw + _i * 8192), 16, 0, 0); } while (0)
#define PG8_LDA(dst, b, h) do { _Pragma("unroll") for (int m = 0; m < 4; ++m) _Pragma("unroll") for (int k = 0; k < 2; ++k) dst[m][k] = *(const LAS bf16x8*)(lds + PG8_SA(b, h) + aoff + m * 2048 + k * 1024); } while (0)
#define PG8_LDB(dst, b, h) do { _Pragma("unroll") for (int n = 0; n < 2; ++n) _Pragma("unroll") for (int k = 0; k < 2; ++k) dst[n][k] = *(const LAS bf16x8*)(lds + PG8_SB(b, h) + boff + n * 2048 + k * 1024); } while (0)
#define PG8_MMA(ai, bj, At, Bt) do { __builtin_amdgcn_s_setprio(1); _Pragma("unroll") for (int m = 0; m < 4; ++m) _Pragma("unroll") for (int n = 0; n < 2; ++n) _Pragma("unroll") for (int k = 0; k < 2; ++k) \
    acc[ai][bj][m][n] = __builtin_amdgcn_mfma_f32_16x16x32_bf16(Bt[n][k], At[m][k], acc[ai][bj][m][n], 0, 0, 0); __builtin_amdgcn_s_setprio(0); } while (0)
#define PG8_WAIT_V(n) asm volatile("s_waitcnt vmcnt(" #n ")" ::: "memory")
#define PG8_WAIT_L(n) asm volatile("s_waitcnt lgkmcnt(" #n ")" ::: "memory")
#define PG8_BAR __builtin_amdgcn_s_barrier()
#define PG8_SCHED __builtin_amdgcn_sched_barrier(0)
  int cpm, cpn, npm = 0, npn = 0, ui = 0;
  if (!tile_of(cu, nM, nN, cpm, cpn)) return;
  f32x4 acc[2][2][4][2];
#pragma unroll
  for (int a = 0; a < 2; ++a)
#pragma unroll
    for (int b = 0; b < 2; ++b)
#pragma unroll
      for (int m = 0; m < 4; ++m)
#pragma unroll
        for (int n = 0; n < 2; ++n) acc[a][b][m][n] = (f32x4){0.f, 0.f, 0.f, 0.f};
  bf16x8 At[4][2], B0[2][2], B1[2][2];
  const char* cA = (const char*)Ag + (size_t)cpm * tstep; const char* cB = (const char*)Btg + (size_t)cpn * tstep;
  static_assert(SP2, "this body is the two-super-phase loop");
  PG8_STAGE(PG8_SB(0, 0), cB); PG8_STAGE(PG8_SB(0, 1), cB + hstep); PG8_STAGE(PG8_SA(0, 0), cA); PG8_STAGE(PG8_SA(0, 1), cA + hstep);
  PG8_STAGE(PG8_SB(1, 0), cB + kstep); PG8_STAGE(PG8_SA(1, 0), cA + kstep); PG8_STAGE(PG8_SB(1, 1), cB + hstep + kstep);
  if (wr == 1) PG8_BAR;
  PG8_WAIT_V(0); PG8_BAR;
  PG8_BAR;
#define K2_ITER(FIRST) do { \
      const bool last = (t == nt - 2); \
      const char* a1 = cA + (size_t)(t + 1) * kstep; \
      const char* a2 = last ? nA : cA + (size_t)(t + 2) * kstep; const char* b2 = last ? nB : cB + (size_t)(t + 2) * kstep; \
      const char* a3 = a2 + kstep; const char* b3 = b2 + kstep; \
      if constexpr (MID) { if (t == (nt >> 1)) E.mid(acc, cpm * BM); } \
      PG8_LDB(B0, 0, 0); PG8_LDB(B1, 0, 1); PG8_SCHED; PG8_LDA(At, 0, 0); PG8_STAGE(PG8_SA(1, 1), a1 + hstep); \
      if constexpr (!(FIRST)) PG8_WAIT_V(8); \
      PG8_WAIT_L(0); PG8_BAR; PG8_MMA(0, 0, At, B0); PG8_MMA(0, 1, At, B1); PG8_BAR; PG8_SCHED; \
      PG8_LDA(At, 0, 1); PG8_STAGE(PG8_SB(0, 0), b2); PG8_STAGE(PG8_SB(0, 1), b2 + hstep); PG8_STAGE(PG8_SA(0, 0), a2); \
      if constexpr (!(FIRST)) PG8_WAIT_V(8); \
      PG8_WAIT_L(0); PG8_BAR; PG8_MMA(1, 0, At, B0); PG8_MMA(1, 1, At, B1); PG8_BAR; PG8_SCHED; \
      PG8_LDB(B0, 1, 0); PG8_LDB(B1, 1, 1); PG8_SCHED; PG8_LDA(At, 1, 0); PG8_STAGE(PG8_SA(0, 1), a2 + hstep); \
      PG8_WAIT_V(8); PG8_WAIT_L(0); PG8_BAR; PG8_MMA(0, 0, At, B0); PG8_MMA(0, 1, At, B1); PG8_BAR; PG8_SCHED; \
      PG8_LDA(At, 1, 1); PG8_STAGE(PG8_SB(1, 0), b3); PG8_STAGE(PG8_SB(1, 1), b3 + hstep); PG8_STAGE(PG8_SA(1, 0), a3); \
      PG8_WAIT_V(8); PG8_WAIT_L(0); PG8_BAR; PG8_MMA(1, 0, At, B0); PG8_MMA(1, 1, At, B1); PG8_BAR; PG8_SCHED; \
    } while (0)
  for (;;) {
    const bool has_next = tile_of((ui + 1) * G + cu, nM, nN, npm, npn);
    const char* nA = has_next ? (const char*)Ag + (size_t)npm * tstep : cA; const char* nB = has_next ? (const char*)Btg + (size_t)npn * tstep : cB;
    { const int t = 0; K2_ITER(true); }
    for (int t = 2; t < nt; t += 2) K2_ITER(false);
    if constexpr (ALIGN_EPI) { if (wr == 0) PG8_BAR; }
    PG8_WAIT_V(0);
    E(acc, cpm * BM, cpn * BM, wr, wc, fr, fq);
    if (!has_next) break;
#pragma unroll
    for (int a = 0; a < 2; ++a)
#pragma unroll
      for (int b = 0; b < 2; ++b)
#pragma unroll
        for (int m = 0; m < 4; ++m)
#pragma unroll
          for (int n = 0; n < 2; ++n) acc[a][b][m][n] = (f32x4){0.f, 0.f, 0.f, 0.f};
    cpm = npm; cpn = npn; cA = nA; cB = nB; ++ui;
    if constexpr (ALIGN_EPI) { if (wr == 1) PG8_BAR; }
  }
  PG8_WAIT_V(0);
  if constexpr (!ALIGN_EPI) { if (wr == 0) PG8_BAR; }
  PG8_BAR;
#undef K2_ITER
#undef PG8_SA
#undef PG8_SB
#undef PG8_STAGE
#undef PG8_LDA
#undef PG8_LDB
#undef PG8_MMA
}

#define EPI_IDS \
    int tid_ = threadIdx.x; asm volatile("" : "+v"(tid_));     \
    const int wid_ = tid_ >> 6, lane_ = tid_ & 63, wr = wid_ >> 2, wc = wid_ & 3, fr = lane_ & 15, fq = lane_ >> 4;
#define PACK16(v, w0, w1) \
    w0.x = pk2(v[0], v[1]); w0.y = pk2(v[2], v[3]); w0.z = pk2(v[4], v[5]); w0.w = pk2(v[6], v[7]); \
    w1.x = pk2(v[8], v[9]); w1.y = pk2(v[10], v[11]); w1.z = pk2(v[12], v[13]); w1.w = pk2(v[14], v[15]);

struct EpiQKV {
  bf16_t* qkv; const float* rs1; const float *qna, *kna, *qnb, *knb;
  __device__ __forceinline__ void operator()(const f32x4 (&acc)[2][2][4][2], int brow, int bcol, int, int, int, int) const {
    EPI_IDS
    const int ct = bcol >> 8;
    const float* gp = nullptr; float extra = 1.f;
    if (ct < 2) { gp = qna; extra = QSCALE; } else if (ct < 4) gp = kna; else if (ct < 6) gp = nullptr; else if (ct < 8) { gp = qnb; extra = QSCALE; } else gp = (wc < 2) ? knb : nullptr;
    float gn[16];
    if (gp) {
#pragma unroll
      for (int i = 0; i < 16; ++i) gn[i] = gp[32 * (i >> 3) + 8 * fq + (i & 7)] * extra;
    }
    float rsv[8];
#pragma unroll
    for (int r = 0; r < 8; ++r) rsv[r] = rs1[brow + (r >> 2) * HALF + wr * 64 + (r & 3) * 16 + fr];
    const int smask = (brow < NPROMPT) ? 2047 : 4095;
#pragma unroll
    for (int ai = 0; ai < 2; ++ai)
#pragma unroll
      for (int m = 0; m < 4; ++m) {
        const int row = brow + ai * HALF + wr * 64 + m * 16 + fr;
        const float rs = rsv[ai * 4 + m];
        float v[16];
#pragma unroll
        for (int bj = 0; bj < 2; ++bj)
#pragma unroll
          for (int n = 0; n < 2; ++n)
#pragma unroll
            for (int j = 0; j < 4; ++j) v[8 * bj + 4 * n + j] = acc[ai][bj][m][n][j] * rs;
        if (gp) {
          float ss = 0.f;
#pragma unroll
          for (int i = 0; i < 16; ++i) ss += v[i] * v[i];
          ss += __shfl_xor(ss, 16); ss += __shfl_xor(ss, 32);
          const float inv = rsqrtf(ss * (1.0f / 64.0f) + EPS);
#pragma unroll
          for (int i = 0; i < 16; ++i) v[i] = v[i] * inv * gn[i];
          {
            const float pos = (float)(row & smask);
            const float sgn = fq == 0 ? -1.0f : 1.0f;
#pragma unroll
            for (int i = 0; i < 8; ++i) {
              const float ci = i == 0 ? 1.5915494309e-01f : i == 1 ? 3.0863763405e-02f : i == 2 ? 5.9851857127e-03f : i == 3 ? 1.1606636412e-03f : i == 4 ? 2.2507907904e-04f : i == 5 ? 4.3647952793e-05f : i == 6 ? 8.4643308082e-06f : 1.6414262628e-06f;
              const float vp = __shfl_xor(v[i], 16);
              const float tr = __builtin_amdgcn_fractf(pos * ci);
              const float c = __builtin_amdgcn_cosf(tr), s = __builtin_amdgcn_sinf(tr);
              const float r = v[i] * c + sgn * (vp * s);
              v[i] = fq < 2 ? r : v[i];
            }
          }
        }
        u32x4 w0, w1; PACK16(v, w0, w1)
        bf16_t* dst = qkv + (size_t)row * INC + bcol + 64 * wc + 8 * fq;
        *(u32x4*)dst = w0; *(u32x4*)(dst + 32) = w1;
      }
  }
};

struct EpiWo {
  const float *xp, *xs; bf16_t* hb; float* ssq2p; const float* ssqh;
  __device__ __forceinline__ void scales(int row, float& sa, float& sb) const {
    const float* sp = ssqh + (size_t)row * 16;
    const f32x4 a = *(const f32x4*)sp, b = *(const f32x4*)(sp + 4), c = *(const f32x4*)(sp + 8), d = *(const f32x4*)(sp + 12);
    sa = rsqrtf((((a[0] + a[1]) + (a[2] + a[3])) + ((b[0] + b[1]) + (b[2] + b[3]))) * (1.0f / 512.0f) + EPS);
    sb = rsqrtf((((c[0] + c[1]) + (c[2] + c[3])) + ((d[0] + d[1]) + (d[2] + d[3]))) * (1.0f / 512.0f) + EPS);
  }
  __device__ __forceinline__ void mid(f32x4 (&acc)[2][2][4][2], int brow) const {
    EPI_IDS
    (void)wc; (void)fq;
#pragma unroll
    for (int ai = 0; ai < 2; ++ai)
#pragma unroll
      for (int m = 0; m < 4; ++m) {
        float sa, sb; scales(brow + ai * HALF + wr * 64 + m * 16 + fr, sa, sb);
        const float ratio = sa / sb;
#pragma unroll
        for (int bj = 0; bj < 2; ++bj)
#pragma unroll
          for (int n = 0; n < 2; ++n) acc[ai][bj][m][n] = acc[ai][bj][m][n] * ratio;
      }
  }
  __device__ __forceinline__ void operator()(const f32x4 (&acc)[2][2][4][2], int brow, int bcol, int, int, int, int) const {
    EPI_IDS
    const float* xbase = (brow < NPROMPT) ? (xp + (size_t)brow * DM) : (xs + (size_t)(brow - NPROMPT) * DM);
#pragma unroll
    for (int ai = 0; ai < 2; ++ai) {
      f32x4 xv[4][4]; float sbv[4];
#pragma unroll
      for (int m = 0; m < 4; ++m) {
        const int rl = ai * HALF + wr * 64 + m * 16 + fr;
        const float* xr = xbase + (size_t)rl * DM + bcol + 64 * wc + 8 * fq;
#pragma unroll
        for (int q = 0; q < 4; ++q) xv[m][q] = *(const f32x4*)(xr + 32 * (q >> 1) + 4 * (q & 1));
        float sa; scales(brow + rl, sa, sbv[m]);
      }
#pragma unroll
      for (int m = 0; m < 4; ++m) {
        const int rl = ai * HALF + wr * 64 + m * 16 + fr;
        float v[16]; float ss = 0.f;
#pragma unroll
        for (int bj = 0; bj < 2; ++bj)
#pragma unroll
          for (int n = 0; n < 2; ++n)
#pragma unroll
            for (int j = 0; j < 4; ++j) { const float h = xv[m][2 * bj + n][j] + acc[ai][bj][m][n][j] * sbv[m]; v[8 * bj + 4 * n + j] = h; ss += h * h; }
        ss += __shfl_xor(ss, 16); ss += __shfl_xor(ss, 32);
        if (fq == 0) ssq2p[(size_t)(brow + rl) * 16 + (bcol >> 8) * 4 + wc] = ss;
        u32x4 w0, w1; PACK16(v, w0, w1)
        bf16_t* dst = hb + (size_t)(brow + rl) * DM + bcol + 64 * wc + 8 * fq;
        *(u32x4*)dst = w0; *(u32x4*)(dst + 32) = w1;
      }
      __builtin_amdgcn_sched_barrier(0);
    }
  }
};

struct EpiUp {
  bf16_t* u; const float* ssq2p; int row_base;
  __device__ __forceinline__ void operator()(const f32x4 (&acc)[2][2][4][2], int brow, int bcol, int, int, int, int) const {
    EPI_IDS
    float s2v[8];
#pragma unroll
    for (int r = 0; r < 8; ++r) {
      const float* sp = ssq2p + (size_t)(row_base + brow + (r >> 2) * HALF + wr * 64 + (r & 3) * 16 + fr) * 16;
      const f32x4 a = *(const f32x4*)sp, b = *(const f32x4*)(sp + 4), c = *(const f32x4*)(sp + 8), d = *(const f32x4*)(sp + 12);
      const float tot = (((a[0] + a[1]) + (a[2] + a[3])) + ((b[0] + b[1]) + (b[2] + b[3]))) + (((c[0] + c[1]) + (c[2] + c[3])) + ((d[0] + d[1]) + (d[2] + d[3])));
      s2v[r] = rsqrtf(tot * (1.0f / DM) + EPS);
    }
#pragma unroll
    for (int ai = 0; ai < 2; ++ai)
#pragma unroll
      for (int m = 0; m < 4; ++m) {
        const int rl = brow + ai * HALF + wr * 64 + m * 16 + fr;
        const float s2 = s2v[ai * 4 + m];
        float v[16];
#pragma unroll
        for (int bj = 0; bj < 2; ++bj)
#pragma unroll
          for (int n = 0; n < 2; ++n)
#pragma unroll
            for (int j = 0; j < 4; ++j) { const float z = fmaxf(acc[ai][bj][m][n][j] * s2, 0.f); v[8 * bj + 4 * n + j] = z * z; }
        u32x4 w0, w1; PACK16(v, w0, w1)
        bf16_t* dst = u + (size_t)rl * DFF + bcol + 64 * wc + 8 * fq;
        *(u32x4*)dst = w0; *(u32x4*)(dst + 32) = w1;
      }
  }
};

struct EpiDown {
  const bf16_t* hb; float* out; int row_base;
  __device__ __forceinline__ void operator()(const f32x4 (&acc)[2][2][4][2], int brow, int bcol, int, int, int, int) const {
    EPI_IDS
#pragma unroll
    for (int ai = 0; ai < 2; ++ai) {
      u32x2 hv[4][2][2];
#pragma unroll
      for (int m = 0; m < 4; ++m) {
        const size_t off = (size_t)(row_base + brow + ai * HALF + wr * 64 + m * 16 + fr) * DM + bcol + 32 * wc + 4 * fq;
#pragma unroll
        for (int bj = 0; bj < 2; ++bj)
#pragma unroll
          for (int n = 0; n < 2; ++n) hv[m][bj][n] = *(const u32x2*)(hb + off + 128 * bj + 16 * n);
      }
#pragma unroll
      for (int m = 0; m < 4; ++m) {
        const size_t off = (size_t)(row_base + brow + ai * HALF + wr * 64 + m * 16 + fr) * DM + bcol + 32 * wc + 4 * fq;
        float* dst = out + off;
#pragma unroll
        for (int bj = 0; bj < 2; ++bj)
#pragma unroll
          for (int n = 0; n < 2; ++n) {
            const unsigned a = hv[m][bj][n].x, b = hv[m][bj][n].y;
            f32x4 o;
            o[0] = __uint_as_float(a << 16) + acc[ai][bj][m][n][0]; o[1] = __uint_as_float(a & 0xffff0000u) + acc[ai][bj][m][n][1];
            o[2] = __uint_as_float(b << 16) + acc[ai][bj][m][n][2]; o[3] = __uint_as_float(b & 0xffff0000u) + acc[ai][bj][m][n][3];
            *(f32x4*)(dst + 128 * bj + 16 * n) = o;
          }
      }
      __builtin_amdgcn_sched_barrier(0);
    }
  }
};

__device__ __forceinline__ void p0_transpose_item(const float* __restrict__ W, int K, int N, bf16_t* __restrict__ WT, const float* __restrict__ g0, const float* __restrict__ g1, float* scr, int item, int lane, int mode) {
  const int nblk = N / 32, kb = item / nblk, nb = item % nblk, k0 = 64 * kb, n0 = 32 * nb;
#pragma unroll 8
  for (int i = 0; i < 32; ++i) {
    const int kk = 2 * i + (lane >> 5), k = k0 + kk;
    float gv = 1.f; if (g0) gv = (g1 && k >= 512) ? g1[k - 512] : g0[k];
    scr[kk * 33 + (lane & 31)] = W[(size_t)k * N + n0 + (lane & 31)] * gv;
  }
  asm volatile("s_waitcnt lgkmcnt(0)" ::: "memory");
  const int c = lane & 7;
#pragma unroll
  for (int j = 0; j < 4; ++j) {
    const int n = (lane >> 3) + 8 * j; const float* s = scr + (8 * c) * 33 + n;
    u32x4 o; o.x = pk2(s[0 * 33], s[1 * 33]); o.y = pk2(s[2 * 33], s[3 * 33]); o.z = pk2(s[4 * 33], s[5 * 33]); o.w = pk2(s[6 * 33], s[7 * 33]);
    const int col = n0 + n, drow = (col & ~255) + col_slot(col & 255, mode);
    *(u32x4*)(WT + (size_t)drow * K + k0 + 8 * c) = o;
  }
  asm volatile("s_waitcnt lgkmcnt(0)" ::: "memory");
}

__device__ __forceinline__ void p0_prologue(const Params& p) {
  int tid = threadIdx.x; asm volatile("" : "+v"(tid));
  const int wave = tid >> 6, lane = tid & 63;
  const int gw = blockIdx.x * 8 + wave, NGW = gridDim.x * 8;
  float* scr = (float*)(g_shm + wave * 16384);
  bf16_t* WinT = (bf16_t*)(p.ws + WS_WIN); bf16_t* WoT = (bf16_t*)(p.ws + WS_WO); bf16_t* WupT = (bf16_t*)(p.ws + WS_WUP); bf16_t* WdT = (bf16_t*)(p.ws + WS_WD);
  constexpr int I_IN = 16 * 72, I_O = 16 * 32, I_UP = 16 * 128, I_DN = 64 * 32, NIT = I_IN + I_O + I_UP + I_DN;
  for (int it = gw; it < NIT; it += NGW) {
    int r = it;
    if (r < I_IN) { p0_transpose_item(p.w_in, DM, INC, WinT, p.norm_attn, nullptr, scr, r, lane, 1); continue; } r -= I_IN;
    if (r < I_O) { p0_transpose_item(p.w_o, DM, DM, WoT, p.ona, p.onb, scr, r, lane, 1); continue; } r -= I_O;
    if (r < I_UP) { p0_transpose_item(p.w_up, DM, DFF, WupT, p.norm_mlp, nullptr, scr, r, lane, 1); continue; } r -= I_UP;
    p0_transpose_item(p.w_down, DFF, DM, WdT, nullptr, nullptr, scr, r, lane, 2);
  }
  bf16_t* xb = (bf16_t*)(p.ws + WS_X); float* rs1 = (float*)(p.ws + WS_RS1);
  for (int row4 = gw * 4; row4 < NTOK; row4 += NGW * 4) {
    f32x4 v[4][4];
#pragma unroll
    for (int r = 0; r < 4; ++r) {
      const int row = row4 + r;
      const float* xr = (row < NPROMPT) ? (p.xp + (size_t)row * DM) : (p.xs + (size_t)(row - NPROMPT) * DM);
#pragma unroll
      for (int j = 0; j < 4; ++j) v[r][j] = *(const f32x4*)(xr + 256 * j + 4 * lane);
    }
#pragma unroll
    for (int r = 0; r < 4; ++r) {
      const int row = row4 + r; float s = 0.f;
#pragma unroll
      for (int j = 0; j < 4; ++j) s += (v[r][j][0] * v[r][j][0] + v[r][j][1] * v[r][j][1]) + (v[r][j][2] * v[r][j][2] + v[r][j][3] * v[r][j][3]);
#pragma unroll
      for (int o = 1; o < 64; o <<= 1) s += __shfl_xor(s, o);
#pragma unroll
      for (int j = 0; j < 4; ++j) { u32x2 w; w.x = pk2(v[r][j][0], v[r][j][1]); w.y = pk2(v[r][j][2], v[r][j][3]); *(u32x2*)(xb + (size_t)row * DM + 256 * j + 4 * lane) = w; }
      if (lane == 0) rs1[row] = rsqrtf(s * (1.0f / DM) + EPS);
    }
  }
}

struct ChunkSrc { int rowc, d, M, kc0; };

__device__ __forceinline__ void issue_chunk(const bf16_t* __restrict__ qkv, const ChunkSrc cs, int koff, int voff, int lane, unsigned char* slot) {
  const unsigned ck = (unsigned)(koff * 2), cv = (unsigned)(voff * 2);
#pragma unroll
  for (int i = 0; i < 4; ++i) {
    const int r = (lane >> 3) + 8 * i;
    int kc = cs.kc0 + r; kc = kc < 0 ? 0 : (kc > cs.M - 1 ? cs.M - 1 : kc);
    const unsigned row = __umul24((unsigned)cs.d, (unsigned)kc) + (unsigned)cs.rowc;
    const unsigned rb = __umul24(row, (unsigned)(INC * 2));
    const unsigned chk = (unsigned)(((lane & 7) ^ ((r >> 1) & 7)) << 4), chv = (unsigned)(((lane & 7) ^ (((r >> 1) & 3) << 1)) << 4);
    __builtin_amdgcn_global_load_lds((const __attribute__((address_space(1))) unsigned*)((const char*)qkv + (rb + (ck + chk))), (LAS unsigned*)(slot + i * 1024), 16, 0, 0);
    __builtin_amdgcn_global_load_lds((const __attribute__((address_space(1))) unsigned*)((const char*)qkv + (rb + (cv + chv))), (LAS unsigned*)(slot + 4096 + i * 1024), 16, 0, 0);
  }
}
__device__ __forceinline__ void read_vt(unsigned a0, unsigned a1, unsigned a2, unsigned a3, bf16x8 (&Vt)[4]) {
  u32x2 r00, r01, r10, r11, r20, r21, r30, r31;
  asm volatile(
      "ds_read_b64_tr_b16 %0, %8\n\tds_read_b64_tr_b16 %1, %8 offset:2048\n\t"
      "ds_read_b64_tr_b16 %2, %9\n\tds_read_b64_tr_b16 %3, %9 offset:2048\n\t"
      "ds_read_b64_tr_b16 %4, %10\n\tds_read_b64_tr_b16 %5, %10 offset:2048\n\t"
      "ds_read_b64_tr_b16 %6, %11\n\tds_read_b64_tr_b16 %7, %11 offset:2048\n\t"
      "s_waitcnt lgkmcnt(0)"
      : "=&v"(r00), "=&v"(r01), "=&v"(r10), "=&v"(r11), "=&v"(r20), "=&v"(r21), "=&v"(r30), "=&v"(r31)
      : "v"(a0), "v"(a1), "v"(a2), "v"(a3) : "memory");
  u32x4 t;
  t.x = r00.x; t.y = r00.y; t.z = r01.x; t.w = r01.y; Vt[0] = __builtin_bit_cast(bf16x8, t);
  t.x = r10.x; t.y = r10.y; t.z = r11.x; t.w = r11.y; Vt[1] = __builtin_bit_cast(bf16x8, t);
  t.x = r20.x; t.y = r20.y; t.z = r21.x; t.w = r21.y; Vt[2] = __builtin_bit_cast(bf16x8, t);
  t.x = r30.x; t.y = r30.y; t.z = r31.x; t.w = r31.y; Vt[3] = __builtin_bit_cast(bf16x8, t);
}
__device__ __forceinline__ void tile_chunk(const bf16x8 (&Kf)[2][2], const bf16x8 (&Q)[2], const bf16x8 (&Vt)[4], f32x4 (&o)[4], float& l, int kcl, int lo, unsigned span, float negm) {
  f32x4 s0 = {negm, negm, negm, negm}, s1 = s0;
  s0 = mfma16(Kf[0][0], Q[0], s0); s0 = mfma16(Kf[0][1], Q[1], s0);
  s1 = mfma16(Kf[1][0], Q[0], s1); s1 = mfma16(Kf[1][1], Q[1], s1);
  float pv[8]; float sum = 0.f;
#pragma unroll
  for (int j = 0; j < 4; ++j) {
    pv[j] = ((unsigned)(kcl + j - lo) <= span) ? __builtin_amdgcn_exp2f(s0[j]) : 0.f;
    pv[4 + j] = ((unsigned)(kcl + 16 + j - lo) <= span) ? __builtin_amdgcn_exp2f(s1[j]) : 0.f;
    sum += pv[j] + pv[4 + j];
  }
  l += sum;
  u32x4 pk; pk.x = pk2(pv[0], pv[1]); pk.y = pk2(pv[2], pv[3]); pk.z = pk2(pv[4], pv[5]); pk.w = pk2(pv[6], pv[7]);
  const bf16x8 P = __builtin_bit_cast(bf16x8, pk);
#pragma unroll
  for (int dt = 0; dt < 4; ++dt) o[dt] = mfma16(Vt[dt], P, o[dt]);
}

template <int TMASK, class DESC>
__device__ __forceinline__ void run_branch(const bf16_t* __restrict__ qkv, const DESC& desc, int& gi, const int total, const int nchunks, const int M, const int kstart, int koff, int voff,
                                           int qcb, int qstep, int hw, float negm, int lane, unsigned char* ring, const bf16x8 (&Q)[4][2], f32x4 (&o)[4][4], float (&l)[4]) {
  const int g = lane >> 4;
  int lo[4]; unsigned span[4];
#pragma unroll
  for (int t = 0; t < 4; ++t) { const int qc = qcb + t * qstep; lo[t] = qc - hw < 0 ? 0 : qc - hw; const int hi = qc + hw > M - 1 ? M - 1 : qc + hw; span[t] = (unsigned)(hi - lo[t]); }
  const int qp = (lane & 15) >> 2, pp = lane & 3, rl = 4 * g + qp, f = (rl >> 1) & 3;
  const unsigned vbase = (unsigned)(size_t)ring + 4096 + rl * 128 + pp * 8;
  const unsigned a0 = vbase + ((0 ^ f) << 5), a1 = vbase + ((1 ^ f) << 5), a2 = vbase + ((2 ^ f) << 5), a3 = vbase + ((3 ^ f) << 5);
  const int krow = lane & 15;
  const LAS unsigned char* kb0 = (const LAS unsigned char*)ring + krow * 128 + (((0 + g) ^ (krow >> 1)) << 4);
  const LAS unsigned char* kb1 = (const LAS unsigned char*)ring + krow * 128 + (((4 + g) ^ (krow >> 1)) << 4);
#pragma unroll 1
  for (int c = 0; c < nchunks; ++c, ++gi) {
    const unsigned soff = (unsigned)(gi & (ATT_SLOTS - 1)) * 8192u;
    bf16x8 Kf[2][2];
    if constexpr (ATT_LA == 1) {
      asm volatile("s_waitcnt vmcnt(0)" ::: "memory");
      Kf[0][0] = *(const LAS bf16x8*)(kb0 + soff); Kf[0][1] = *(const LAS bf16x8*)(kb1 + soff);
      Kf[1][0] = *(const LAS bf16x8*)(kb0 + soff + 2048); Kf[1][1] = *(const LAS bf16x8*)(kb1 + soff + 2048);
      if (gi + 1 < total) issue_chunk(qkv, desc(gi + 1), koff, voff, lane, ring + ((gi + 1) & 1) * 8192);
    } else {
      if (gi + ATT_LA < total) issue_chunk(qkv, desc(gi + ATT_LA), koff, voff, lane, ring + ((gi + ATT_LA) & (ATT_SLOTS - 1)) * 8192);
      const int rem = total - 1 - gi;
      if (ATT_LA >= 3 && rem >= 3) asm volatile("s_waitcnt vmcnt(24)" ::: "memory");
      else if (ATT_LA >= 2 && rem >= 2) asm volatile("s_waitcnt vmcnt(16)" ::: "memory");
      else if (rem >= 1) asm volatile("s_waitcnt vmcnt(8)" ::: "memory");
      else asm volatile("s_waitcnt vmcnt(0)" ::: "memory");
      Kf[0][0] = *(const LAS bf16x8*)(kb0 + soff); Kf[0][1] = *(const LAS bf16x8*)(kb1 + soff);
      Kf[1][0] = *(const LAS bf16x8*)(kb0 + soff + 2048); Kf[1][1] = *(const LAS bf16x8*)(kb1 + soff + 2048);
    }
    bf16x8 Vt[4];
    read_vt(a0 + soff, a1 + soff, a2 + soff, a3 + soff, Vt);
    const int kcl = kstart + 32 * c + 4 * g;
#pragma unroll
    for (int t = 0; t < 4; ++t)
      if (TMASK & (1 << t)) tile_chunk(Kf, Q[t], Vt, o[t], l[t], kcl, lo[t], span[t], negm);
  }
}

__device__ __forceinline__ float wave_max(float v) {
#pragma unroll
  for (int o = 1; o < 64; o <<= 1) v = fmaxf(v, __shfl_xor(v, o));
  return v;
}

__device__ __forceinline__ void attn_phase(const Params& p) {
  int tid = threadIdx.x; asm volatile("" : "+v"(tid));
  const int wave = __builtin_amdgcn_readfirstlane(tid >> 6), lane = tid & 63, qi = lane & 15, g = lane >> 4;
  if (wave >= ATT_NACT) return;
  const bf16_t* qkv = (const bf16_t*)(p.ws + WS_QKV);
  bf16_t* mix = (bf16_t*)(p.ws + WS_X);
  float* ssqh = (float*)(p.ws + WS_SSQH);
  unsigned char* ring = g_shm + wave * (ATT_SLOTS * 8192);
  const float mfixA = 8.0f * LOG2E * wave_max(fabsf(p.qna[lane])) * wave_max(fabsf(p.kna[lane]));
  const float mfixB = 8.0f * LOG2E * wave_max(fabsf(p.qnb[lane])) * wave_max(fabsf(p.knb[lane]));
  const int xcd = blockIdx.x & 7, wx = (blockIdx.x >> 3) * ATT_NACT + wave, nwx = (gridDim.x >> 3) * ATT_NACT;
  for (int li = wx; li < 2048; li += nwx) {
    const int kind = (li / nwx) & 1;
    const int lk = ((li / nwx) >> 1) * nwx + (li % nwx);
    const int grp = xcd * 128 + (lk & 127), sub = lk >> 7;
    const int r64 = grp * 64;
    const int S = r64 < NPROMPT ? 2048 : 4096;
    const int row0 = r64 & ~(S - 1);
    bf16x8 Q[4][2]; f32x4 o[4][4]; float l[4];
#pragma unroll
    for (int t = 0; t < 4; ++t) {
#pragma unroll
      for (int dt = 0; dt < 4; ++dt) o[t][dt] = (f32x4){0.f, 0.f, 0.f, 0.f};
    }
    int tok[4], colb[4];
    int gi = 0;
    if (kind == 0) {
      const int sidx = (r64 - row0) >> 6, c4 = sidx & 3, p0 = (sidx >> 2) * 16, h = sub;
#pragma unroll
      for (int t = 0; t < 4; ++t) {
        tok[t] = 16 * (p0 + qi) + c4 + 4 * t; colb[t] = h * 64; l[t] = 0.f;
        const bf16_t* rp = qkv + (size_t)(row0 + tok[t]) * INC + h * 64 + g * 8;
        Q[t][0] = *(const bf16x8*)rp; Q[t][1] = *(const bf16x8*)(rp + 32);
      }
      const int koff = 512 + h * 64, voff = 1024 + h * 64;
      auto desc = [=](int i) -> ChunkSrc {
        ChunkSrc r;
        if (i < 12) { r.rowc = row0; r.d = 1; r.M = S; r.kc0 = 16 * p0 - 64 + 32 * i; }
        else if (i < 18) { r.rowc = row0 + c4; r.d = 4; r.M = S >> 2; r.kc0 = 4 * p0 - 64 + 32 * (i - 12); }
        else { const int j = i - 18, t = j / 5, c = j - 5 * t; r.rowc = row0 + c4 + 4 * t; r.d = 16; r.M = S >> 4; r.kc0 = p0 - 64 + 32 * c; }
        return r;
      };
      constexpr int TOTAL = 38;
#pragma unroll
      for (int i = 0; i < ATT_LA; ++i) issue_chunk(qkv, desc(i), koff, voff, lane, ring + i * 8192);
      run_branch<15>(qkv, desc, gi, TOTAL, 12, S, 16 * p0 - 64, koff, voff, 16 * (p0 + qi) + c4, 4, 64, -mfixA, lane, ring, Q, o, l);
      run_branch<15>(qkv, desc, gi, TOTAL, 6, S >> 2, 4 * p0 - 64, koff, voff, 4 * (p0 + qi), 1, 64, -mfixA, lane, ring, Q, o, l);
      run_branch<1>(qkv, desc, gi, TOTAL, 5, S >> 4, p0 - 64, koff, voff, p0 + qi, 0, 64, -mfixA, lane, ring, Q, o, l);
      run_branch<2>(qkv, desc, gi, TOTAL, 5, S >> 4, p0 - 64, koff, voff, p0 + qi, 0, 64, -mfixA, lane, ring, Q, o, l);
      run_branch<4>(qkv, desc, gi, TOTAL, 5, S >> 4, p0 - 64, koff, voff, p0 + qi, 0, 64, -mfixA, lane, ring, Q, o, l);
      run_branch<8>(qkv, desc, gi, TOTAL, 5, S >> 4, p0 - 64, koff, voff, p0 + qi, 0, 64, -mfixA, lane, ring, Q, o, l);
    } else {
      const int kvh = sub & 1, qsub = sub >> 1, q0 = (r64 - row0) + 16 * qsub;
#pragma unroll
      for (int t = 0; t < 4; ++t) {
        const int hq = kvh * 4 + t;
        tok[t] = q0 + qi; colb[t] = 512 + hq * 64;
        l[t] = (g == 0) ? __builtin_amdgcn_exp2f(p.sink[hq] * LOG2E - mfixB) : 0.f;
        const bf16_t* rp = qkv + (size_t)(row0 + tok[t]) * INC + 1536 + hq * 64 + g * 8;
        Q[t][0] = *(const bf16x8*)rp; Q[t][1] = *(const bf16x8*)(rp + 32);
      }
      const int koff = 2048 + kvh * 64, voff = 2176 + kvh * 64;
      auto desc = [=](int i) -> ChunkSrc { ChunkSrc r; r.rowc = row0; r.d = 1; r.M = S; r.kc0 = q0 - 128 + 32 * i; return r; };
      constexpr int TOTAL = 9;
#pragma unroll
      for (int i = 0; i < ATT_LA; ++i) issue_chunk(qkv, desc(i), koff, voff, lane, ring + i * 8192);
      run_branch<15>(qkv, desc, gi, TOTAL, 9, S, q0 - 128, koff, voff, q0 + qi, 0, 128, -mfixB, lane, ring, Q, o, l);
    }
#pragma unroll
    for (int t = 0; t < 4; ++t) {
      float L = l[t]; L += __shfl_xor(L, 16); L += __shfl_xor(L, 32);
      const float inv = 1.0f / L; float ss = 0.f;
#pragma unroll
      for (int dt = 0; dt < 4; ++dt)
#pragma unroll
        for (int j = 0; j < 4; ++j) { const float x = o[t][dt][j] * inv; o[t][dt][j] = x; ss += x * x; }
      ss += __shfl_xor(ss, 16); ss += __shfl_xor(ss, 32);
      const size_t row = (size_t)(row0 + tok[t]);
      if (g == 0) ssqh[row * 16 + (colb[t] >> 6)] = ss;
      bf16_t* dst = mix + row * DM + colb[t] + 4 * g;
#pragma unroll
      for (int dt = 0; dt < 4; ++dt) { u32x2 w; w.x = pk2(o[t][dt][0], o[t][dt][1]); w.y = pk2(o[t][dt][2], o[t][dt][3]); *(u32x2*)(dst + 16 * dt) = w; }
    }
  }
}

#define XB_TMO      128
#define XB_XCNT(j)  (256  + 64 * (j))
#define XB_XSUB(j)  (1280 + 64 * (j))
#define XB_XGEN(j)  (2304 + 64 * (j))
#define XB_TOP      3328
#define XB_TOPGEN   3392
#define XCD_BAR_WORDS 3456
#define XB_SPIN_CAP (1u << 18)
__device__ __forceinline__ unsigned xb_ld(unsigned* p)              { return __hip_atomic_load(p, __ATOMIC_RELAXED, __HIP_MEMORY_SCOPE_AGENT); }
__device__ __forceinline__ unsigned xb_add(unsigned* p, unsigned v) { return __hip_atomic_fetch_add(p, v, __ATOMIC_RELAXED, __HIP_MEMORY_SCOPE_AGENT); }
__device__ __forceinline__ unsigned xb_xcc_id() { return (unsigned)__builtin_amdgcn_s_getreg((3 << 11) | 20) & 0xFu; }
#define XB_SPIN(cond, bar) do { unsigned _sp = 0; while (cond) { __builtin_amdgcn_s_sleep(1); \
    if ((++_sp & 255u) == 0u) { if (xb_ld(&(bar)[XB_TMO])) break; if (_sp > XB_SPIN_CAP) { atomicAdd(&(bar)[XB_TMO], 1u); break; } } } } while (0)
struct XcdBarrier { unsigned* bar; unsigned x; volatile LAS unsigned* st; };
__device__ __forceinline__ XcdBarrier xcd_barrier_post(unsigned* bar, volatile LAS unsigned* st) {
  XcdBarrier b; b.bar = bar; b.x = xb_xcc_id(); b.st = st;
  if (threadIdx.x == 0) (void)xb_add(&bar[XB_XCNT(b.x)], 1u);
  return b;
}
__device__ __forceinline__ void xcd_barrier_complete(unsigned* bar, unsigned x, unsigned& nloc, unsigned& nx) {
  const unsigned G = gridDim.x * gridDim.y * gridDim.z;
  unsigned sum, cnt, mine, sp = 0u;
  for (;;) {
    sum = 0u; cnt = 0u; mine = 0u;
#pragma unroll
    for (unsigned j = 0; j < 16; ++j) { const unsigned c = xb_ld(&bar[XB_XCNT(j)]); sum += c; cnt += (c > 0u) ? 1u : 0u; mine = (j == x) ? c : mine; }
    if (sum == G) break;
    __builtin_amdgcn_s_sleep(1);
    if ((++sp & 255u) == 0u) { if (xb_ld(&bar[XB_TMO])) break; if (sp > XB_SPIN_CAP) { atomicAdd(&bar[XB_TMO], 1u); break; } }
  }
  nloc = mine > 0u ? mine : 1u; nx = cnt > 0u ? cnt : 1u;
}
__device__ __forceinline__ void xcd_barrier_impl(const XcdBarrier& b) {
  asm volatile("s_waitcnt vmcnt(0)" ::: "memory");
  __syncthreads();
  if (threadIdx.x == 0) {
    unsigned* bar = b.bar;
    __builtin_amdgcn_s_waitcnt(0);
    unsigned nloc = b.st[0], nx = b.st[1];
    if (nloc == 0u) { xcd_barrier_complete(bar, b.x, nloc, nx); b.st[0] = nloc; b.st[1] = nx; }
    const unsigned old = xb_add(&bar[XB_XSUB(b.x)], 1u);
    const unsigned gen = old / nloc;
    if (old + 1u == (gen + 1u) * nloc) {
      __builtin_amdgcn_fence(__ATOMIC_RELEASE, "agent");
      asm volatile("s_waitcnt vmcnt(0)" ::: "memory");
      const unsigned og = xb_add(&bar[XB_TOP], 1u);
      const unsigned tg = og / nx;
      if (og + 1u == (tg + 1u) * nx) xb_add(&bar[XB_TOPGEN], 1u);
      else XB_SPIN(xb_ld(&bar[XB_TOPGEN]) == tg, bar);
      __builtin_amdgcn_fence(__ATOMIC_ACQUIRE, "agent");
      xb_add(&bar[XB_XGEN(b.x)], 1u);
      asm volatile("s_waitcnt vmcnt(0)" ::: "memory");
    } else {
      XB_SPIN(xb_ld(&bar[XB_XGEN(b.x)]) == gen, bar);
      __builtin_amdgcn_fence(__ATOMIC_ACQUIRE, "agent");
      asm volatile("s_waitcnt vmcnt(0)" ::: "memory");
    }
  }
  __syncthreads();
}

__device__ __forceinline__ void xcd_barrier(unsigned char* ws) {
  XcdBarrier b; b.bar = (unsigned*)(ws + WS_BAR); b.x = xb_xcc_id(); b.st = (volatile LAS unsigned*)((LAS unsigned char*)g_shm + GEMM_LDS_BYTES);
  xcd_barrier_impl(b);
}

typedef const __attribute__((address_space(4))) Params* KArgs;
__device__ __forceinline__ Params load_params() {
#if defined(__HIP_DEVICE_COMPILE__)
  KArgs kp = (KArgs)__builtin_amdgcn_kernarg_segment_ptr();
  asm volatile("" : "+s"(kp));
  Params r;
  r.xp = kp->xp; r.xs = kp->xs; r.norm_attn = kp->norm_attn; r.w_in = kp->w_in; r.qna = kp->qna; r.kna = kp->kna; r.qnb = kp->qnb; r.knb = kp->knb; r.sink = kp->sink;
  r.ona = kp->ona; r.onb = kp->onb; r.w_o = kp->w_o; r.norm_mlp = kp->norm_mlp; r.w_up = kp->w_up; r.w_down = kp->w_down; r.out = kp->out; r.ws = kp->ws;
  return r;
#else
  return Params{};
#endif
}

__global__ void __launch_bounds__(512) fwd_megakernel(Params p_unused) {
  cg::grid_group grid = cg::this_grid();
  {
    const Params p = load_params();
    volatile LAS unsigned* xst = (volatile LAS unsigned*)((LAS unsigned char*)g_shm + GEMM_LDS_BYTES);
    if (threadIdx.x == 0) { xst[0] = 0u; xst[1] = 0u; }
    (void)xcd_barrier_post((unsigned*)(p.ws + WS_BAR), xst);
    p0_prologue(p);
    if (p.ws == nullptr) grid.sync();
    xcd_barrier(p.ws);
  }
  {
    const Params p = load_params();
    EpiQKV e{(bf16_t*)(p.ws + WS_QKV), (const float*)(p.ws + WS_RS1), p.qna, p.kna, p.qnb, p.knb};
    gemm_phase<EpiQKV, GEMM_ALIGN, GEMM_SP2>((const bf16_t*)(p.ws + WS_X), (const bf16_t*)(p.ws + WS_WIN), NTOK, INC, DM, e);
    xcd_barrier(p.ws);
  }
  {
    const Params p = load_params();
    attn_phase(p);
    xcd_barrier(p.ws);
  }
  {
    const Params p = load_params();
    EpiWo e{p.xp, p.xs, (bf16_t*)(p.ws + WS_HB), (float*)(p.ws + WS_SSQ2), (const float*)(p.ws + WS_SSQH)};
    gemm_phase<EpiWo, GEMM_ALIGN, GEMM_SP2, true>((const bf16_t*)(p.ws + WS_X), (const bf16_t*)(p.ws + WS_WO), NTOK, DM, DM, e);
    xcd_barrier(p.ws);
  }
  for (int half = 0; half < 2; ++half) {
    const int rb = half * NPROMPT;
    {
      const Params p = load_params();
      EpiUp e{(bf16_t*)(p.ws + WS_U), (const float*)(p.ws + WS_SSQ2), rb};
      gemm_phase<EpiUp, GEMM_ALIGN, GEMM_SP2>((const bf16_t*)(p.ws + WS_HB) + (size_t)rb * DM, (const bf16_t*)(p.ws + WS_WUP), NPROMPT, DFF, DM, e);
      xcd_barrier(p.ws);
    }
    {
      const Params p = load_params();
      EpiDown e{(const bf16_t*)(p.ws + WS_HB), p.out, rb};
      gemm_phase<EpiDown, GEMM_ALIGN, GEMM_SP2>((const bf16_t*)(p.ws + WS_U), (const bf16_t*)(p.ws + WS_WD), NPROMPT, DM, DFF, e);
      if (half == 0) xcd_barrier(p.ws);
    }
  }
}

extern "C" void kernel_launch(void* const* d_in, const int* in_sizes, int n_in, void* d_out, int out_size, void* d_ws, size_t ws_size, hipStream_t stream) {
  static int grid_blocks = 0;
  if (!grid_blocks) {
    if (n_in != 15 || ws_size < WS_NEED) { fprintf(stderr, "kernel_launch: unexpected n_in %d / ws_size %zu\n", n_in, ws_size); grid_blocks = -1; return; }
    int dev = 0, cus = 0, per_cu = 0;
    hipGetDevice(&dev);
    hipDeviceGetAttribute(&cus, hipDeviceAttributeMultiprocessorCount, dev);
    if (hipFuncSetAttribute((const void*)fwd_megakernel, hipFuncAttributeMaxDynamicSharedMemorySize, LDS_BYTES) != hipSuccess) { fprintf(stderr, "hipFuncSetAttribute failed\n"); grid_blocks = -1; return; }
    hipOccupancyMaxActiveBlocksPerMultiprocessor(&per_cu, (const void*)fwd_megakernel, 512, LDS_BYTES);
    if (per_cu < 1) { fprintf(stderr, "occupancy query says %d blocks/CU\n", per_cu); per_cu = 1; }
    (void)hipGetLastError();
    grid_blocks = cus;
  }
  if (grid_blocks < 0) return;
  if (hipMemsetAsync((char*)d_ws + WS_BAR, 0, 16384, stream) != hipSuccess) { fprintf(stderr, "hipMemsetAsync of the barrier words failed\n"); return; }
  Params p{};
  p.xp = (const float*)d_in[0]; p.xs = (const float*)d_in[1]; p.norm_attn = (const float*)d_in[2]; p.w_in = (const float*)d_in[3];
  p.qna = (const float*)d_in[4]; p.kna = (const float*)d_in[5]; p.qnb = (const float*)d_in[6]; p.knb = (const float*)d_in[7];
  p.sink = (const float*)d_in[8]; p.ona = (const float*)d_in[9]; p.onb = (const float*)d_in[10]; p.w_o = (const float*)d_in[11];
  p.norm_mlp = (const float*)d_in[12]; p.w_up = (const float*)d_in[13]; p.w_down = (const float*)d_in[14];
  p.out = (float*)d_out; p.ws = (unsigned char*)d_ws;
  void* args[] = {&p};
  hipError_t e = hipLaunchCooperativeKernel((const void*)fwd_megakernel, dim3(grid_blocks), dim3(512), args, LDS_BYTES, stream);
  if (e != hipSuccess) fprintf(stderr, "cooperative launch failed: %s (grid %d)\n", hipGetErrorString(e), grid_blocks);
}
```

```cpp
#include <hip/hip_runtime.h>
#include <hip/hip_cooperative_groups.h>
#include <cstdio>
#include <cstdint>
namespace cg = cooperative_groups;

typedef unsigned short bf16_t;
typedef short bf16x8 __attribute__((ext_vector_type(8)));
typedef float f32x4 __attribute__((ext_vector_type(4)));
typedef unsigned u32x4 __attribute__((ext_vector_type(4)));
typedef unsigned u32x2 __attribute__((ext_vector_type(2)));

constexpr int DM = 1024, NTOK = 65536, NPROMPT = 32768, INC = 2304, DFF = 4096;
constexpr float EPS = 1e-6f;
constexpr float LOG2E = 1.4426950408889634f;
constexpr float QSCALE = 0.18033688011112042f;

constexpr size_t MiB = 1048576;
constexpr size_t WS_WIN = 0, WS_WO = 4718592, WS_WUP = 6815744, WS_WD = 15204352, WS_RS1 = 23592960, WS_SSQ2 = 440 * MiB;
constexpr size_t WS_X = 24 * MiB;
constexpr size_t WS_QKV = 152 * MiB;
constexpr size_t WS_HB = 312 * MiB;
constexpr size_t WS_U = 24 * MiB;
constexpr size_t WS_SSQH = 444 * MiB;
constexpr size_t WS_BAR = 448 * MiB;
constexpr size_t WS_NEED = 449 * MiB;

constexpr int GEMM_LDS_BYTES = 131072, LDS_BYTES = GEMM_LDS_BYTES + 64;
constexpr bool GEMM_ALIGN = true, GEMM_SP2 = true;
constexpr int ATT_NACT = 8;
constexpr int ATT_SLOTS = 16 / ATT_NACT, ATT_LA = ATT_SLOTS - 1;

struct Params {
  const float *xp, *xs, *norm_attn, *w_in, *qna, *kna, *qnb, *knb, *sink, *ona, *onb, *w_o, *norm_mlp, *w_up, *w_down;
  float* out;
  unsigned char* ws;
};

extern __shared__ __attribute__((aligned(16))) unsigned char g_shm[];

typedef __bf16 bf16v2_t __attribute__((ext_vector_type(2)));
typedef float f32v2_t __attribute__((ext_vector_type(2)));
__device__ __forceinline__ unsigned pk2(float lo, float hi) { const f32v2_t f = {lo, hi}; const bf16v2_t b = __builtin_convertvector(f, bf16v2_t); return __builtin_bit_cast(unsigned, b); }
__device__ __forceinline__ float bf2f(unsigned short b) { return __uint_as_float(((unsigned)b) << 16); }
__device__ __forceinline__ f32x4 mfma16(bf16x8 a, bf16x8 b, f32x4 c) { return __builtin_amdgcn_mfma_f32_16x16x32_bf16(a, b, c, 0, 0, 0); }

__device__ __forceinline__ int col_slot(int c, int mode) {
  if (mode == 0) return 128 * ((c >> 3) & 1) + 32 * (c >> 6) + 16 * ((c >> 2) & 1) + 4 * ((c >> 4) & 3) + (c & 3);
  if (mode == 1) return 128 * ((c >> 5) & 1) + 32 * (c >> 6) + 16 * ((c >> 2) & 1) + 4 * ((c >> 3) & 3) + (c & 3);
  return c;
}

constexpr int BM = 256, BK = 64, HALF = 128, HT = HALF * BK;
__device__ __forceinline__ int lds_byte(int r, int c) {
  int st = (r >> 4) * 2 + (c >> 5), rr = r & 15, cc = c & 31, ob = rr * 64 + cc * 2;
  return st * 1024 + (ob ^ (((ob >> 9) & 1) << 5));
}
__device__ __forceinline__ void stage_rc(int b, int& R, int& C) {
  int st = b / 1024, sb = b % 1024, swz = sb ^ (((sb >> 9) & 1) << 5);
  R = (st >> 1) * 16 + swz / 64; C = (st & 1) * 32 + (swz % 64) / 2;
}

__device__ __forceinline__ bool tile_of(int L, int nM, int nN, int& pm, int& pn) {
  const int nwg = nM * nN; if (L >= nwg) return false;
  int wgid = L; { const int q = nwg / 8, r = nwg % 8, xcd = wgid % 8, off = wgid / 8; wgid = (xcd < r ? xcd * (q + 1) : r * (q + 1) + (xcd - r) * q) + off; }
  const int nig = 8 * nN, gid = wgid / nig, fm = gid * 8, gsz = (nM - fm) < 8 ? (nM - fm) : 8;
  pm = fm + ((wgid % nig) % gsz); pn = (wgid % nig) / gsz; return true;
}
#define LAS __attribute__((address_space(3)))
template <class Epi, bool ALIGN_EPI, bool SP2, bool MID = false>
__device__ __forceinline__ void gemm_phase(const bf16_t* __restrict__ Ag, const bf16_t* __restrict__ Btg, const int M, const int N, const int K, const Epi& E) {
  LAS unsigned char* lds = (LAS unsigned char*)g_shm;
  int tid = threadIdx.x; asm volatile("" : "+v"(tid));
  const int wid = __builtin_amdgcn_readfirstlane(tid >> 6), lane = tid & 63, wr = wid >> 2, wc = wid & 3, fr = lane & 15, fq = lane >> 4;
  const int nt = K / BK, nM = M / BM, nN = N / BM, G = gridDim.x, cu = blockIdx.x;
  constexpr int HTB = HALF * BK * 2;
  unsigned voff[2];
#pragma unroll
  for (int i = 0; i < 2; ++i) { int R, C; stage_rc(tid * 16 + i * 8192, R, C); voff[i] = (unsigned)(R * K + C) * 2u; }
  const size_t kstep = (size_t)(BK * 2), hstep = (size_t)HALF * K * 2, tstep = 2 * hstep;
  const unsigned ldsw = (unsigned)wid * 1024u;
  const int aoff = lds_byte(wr * 64 + fr, fq * 8), boff = lds_byte(wc * 32 + fr, fq * 8);
#define PG8_SA(b, h) (((b) * 2 + (h)) * HTB)
#define PG8_SB(b, h) ((4 + (b) * 2 + (h)) * HTB)
#define PG8_STAGE(bufoff, gbase) do { _Pragma("unroll") for (int _i = 0; _i < 2; ++_i) \
    __builtin_amdgcn_global_load_lds((const __attribute__((address_space(1))) unsigned*)((const char*)(gbase) + voff[_i]), (LAS unsigned*)(lds + (bufoff) + ldsw + _i * 8192), 16, 0, 0); } while (0)
#define PG8_LDA(dst, b, h) do { _Pragma("unroll") for (int m = 0; m < 4; ++m) _Pragma("unroll") for (int k = 0; k < 2; ++k) dst[m][k] = *(const LAS bf16x8*)(lds + PG8_SA(b, h) + aoff + m * 2048 + k * 1024); } while (0)
#define PG8_LDB(dst, b, h) do { _Pragma("unroll") for (int n = 0; n < 2; ++n) _Pragma("unroll") for (int k = 0; k < 2; ++k) dst[n][k] = *(const LAS bf16x8*)(lds + PG8_SB(b, h) + boff + n * 2048 + k * 1024); } while (0)
#define PG8_MMA(ai, bj, At, Bt) do { __builtin_amdgcn_s_setprio(1); _Pragma("unroll") for (int m = 0; m < 4; ++m) _Pragma("unroll") for (int n = 0; n < 2; ++n) _Pragma("unroll") for (int k = 0; k < 2; ++k) \
    acc[ai][bj][m][n] = __builtin_amdgcn_mfma_f32_16x16x32_bf16(Bt[n][k], At[m][k], acc[ai][bj][m][n], 0, 0, 0); __builtin_amdgcn_s_setprio(0); } while (0)
#define PG8_WAIT_V(n) asm volatile("s_waitcnt vmcnt(" #n ")" ::: "memory")
#define PG8_WAIT_L(n) asm volatile("s_waitcnt lgkmcnt(" #n ")" ::: "memory")
#define PG8_BAR __builtin_amdgcn_s_barrier()
#define PG8_SCHED __builtin_amdgcn_sched_barrier(0)
  int cpm, cpn, npm = 0, npn = 0, ui = 0;
  if (!tile_of(cu, nM, nN, cpm, cpn)) return;
  f32x4 acc[2][2][4][2];
#pragma unroll
  for (int a = 0; a < 2; ++a)
#pragma unroll
    for (int b = 0; b < 2; ++b)
#pragma unroll
      for (int m = 0; m < 4; ++m)
#pragma unroll
        for (int n = 0; n < 2; ++n) acc[a][b][m][n] = (f32x4){0.f, 0.f, 0.f, 0.f};
  bf16x8 At[4][2], B0[2][2], B1[2][2];
  const char* cA = (const char*)Ag + (size_t)cpm * tstep; const char* cB = (const char*)Btg + (size_t)cpn * tstep;
  static_assert(SP2, "this body is the two-super-phase loop");
  PG8_STAGE(PG8_SB(0, 0), cB); PG8_STAGE(PG8_SB(0, 1), cB + hstep); PG8_STAGE(PG8_SA(0, 0), cA); PG8_STAGE(PG8_SA(0, 1), cA + hstep);
  PG8_STAGE(PG8_SB(1, 0), cB + kstep); PG8_STAGE(PG8_SA(1, 0), cA + kstep); PG8_STAGE(PG8_SB(1, 1), cB + hstep + kstep);
  if (wr == 1) PG8_BAR;
  PG8_WAIT_V(0); PG8_BAR;
  PG8_BAR;
#define K2_ITER(FIRST) do { \
      const bool last = (t == nt - 2); \
      const char* a1 = cA + (size_t)(t + 1) * kstep; \
      const char* a2 = last ? nA : cA + (size_t)(t + 2) * kstep; const char* b2 = last ? nB : cB + (size_t)(t + 2) * kstep; \
      const char* a3 = a2 + kstep; const char* b3 = b2 + kstep; \
      if constexpr (MID) { if (t == (nt >> 1)) E.mid(acc, cpm * BM); } \
      PG8_LDB(B0, 0, 0); PG8_LDB(B1, 0, 1); PG8_SCHED; PG8_LDA(At, 0, 0); PG8_STAGE(PG8_SA(1, 1), a1 + hstep); \
      if constexpr (!(FIRST)) PG8_WAIT_V(8); \
      PG8_WAIT_L(0); PG8_BAR; PG8_MMA(0, 0, At, B0); PG8_MMA(0, 1, At, B1); PG8_BAR; PG8_SCHED; \
      PG8_LDA(At, 0, 1); PG8_STAGE(PG8_SB(0, 0), b2); PG8_STAGE(PG8_SB(0, 1), b2 + hstep); PG8_STAGE(PG8_SA(0, 0), a2); \
      if constexpr (!(FIRST)) PG8_WAIT_V(8); \
      PG8_WAIT_L(0); PG8_BAR; PG8_MMA(1, 0, At, B0); PG8_MMA(1, 1, At, B1); PG8_BAR; PG8_SCHED; \
      PG8_LDB(B0, 1, 0); PG8_LDB(B1, 1, 1); PG8_SCHED; PG8_LDA(At, 1, 0); PG8_STAGE(PG8_SA(0, 1), a2 + hstep); \
      PG8_WAIT_V(8); PG8_WAIT_L(0); PG8_BAR; PG8_MMA(0, 0, At, B0); PG8_MMA(0, 1, At, B1); PG8_BAR; PG8_SCHED; \
      PG8_LDA(At, 1, 1); PG8_STAGE(PG8_SB(1, 0), b3); PG8_STAGE(PG8_SB(1, 1), b3 + hstep); PG8_STAGE(PG8_SA(1, 0), a3); \
      PG8_WAIT_V(8); PG8_WAIT_L(0); PG8_BAR; PG8_MMA(1, 0, At, B0); PG8_MMA(1, 1, At, B1); PG8_BAR; PG8_SCHED; \
    } while (0)
  for (;;) {
    const bool has_next = tile_of((ui + 1) * G + cu, nM, nN, npm, npn);
    const char* nA = has_next ? (const char*)Ag + (size_t)npm * tstep : cA; const char* nB = has_next ? (const char*)Btg + (size_t)npn * tstep : cB;
    { const int t = 0; K2_ITER(true); }
    for (int t = 2; t < nt; t += 2) K2_ITER(false);
    const typename Epi::Pre pre = E.pre(cpm * BM, cpn * BM);
    if constexpr (ALIGN_EPI) { if (wr == 0) PG8_BAR; }
    PG8_WAIT_V(0);
    E(acc, cpm * BM, cpn * BM, pre);
    if (!has_next) break;
#pragma unroll
    for (int a = 0; a < 2; ++a)
#pragma unroll
      for (int b = 0; b < 2; ++b)
#pragma unroll
        for (int m = 0; m < 4; ++m)
#pragma unroll
          for (int n = 0; n < 2; ++n) acc[a][b][m][n] = (f32x4){0.f, 0.f, 0.f, 0.f};
    cpm = npm; cpn = npn; cA = nA; cB = nB; ++ui;
    if constexpr (ALIGN_EPI) { if (wr == 1) PG8_BAR; }
  }
  PG8_WAIT_V(0);
  if constexpr (!ALIGN_EPI) { if (wr == 0) PG8_BAR; }
  PG8_BAR;
#undef K2_ITER
#undef PG8_SA
#undef PG8_SB
#undef PG8_STAGE
#undef PG8_LDA
#undef PG8_LDB
#undef PG8_MMA
}

#define EPI_IDS \
    int tid_ = threadIdx.x; asm volatile("" : "+v"(tid_));     \
    const int wid_ = tid_ >> 6, lane_ = tid_ & 63, wr = wid_ >> 2, wc = wid_ & 3, fr = lane_ & 15, fq = lane_ >> 4;
#define PACK16(v, w0, w1) \
    w0.x = pk2(v[0], v[1]); w0.y = pk2(v[2], v[3]); w0.z = pk2(v[4], v[5]); w0.w = pk2(v[6], v[7]); \
    w1.x = pk2(v[8], v[9]); w1.y = pk2(v[10], v[11]); w1.z = pk2(v[12], v[13]); w1.w = pk2(v[14], v[15]);

struct EpiQKV {
  bf16_t* qkv; const float* rs1; const float *qna, *kna, *qnb, *knb;
  struct Pre { float rs[8]; float gn[16]; };
  __device__ __forceinline__ Pre pre(int brow, int bcol) const {
    EPI_IDS
    (void)fr;
    Pre r;
    const int ct = bcol >> 8;
    const float* gp = nullptr; float extra = 1.f;
    if (ct < 2) { gp = qna; extra = QSCALE; } else if (ct < 4) gp = kna; else if (ct < 6) gp = nullptr; else if (ct < 8) { gp = qnb; extra = QSCALE; } else gp = (wc < 2) ? knb : nullptr;
#pragma unroll
    for (int i = 0; i < 16; ++i) r.gn[i] = gp ? gp[32 * (i >> 3) + 8 * fq + (i & 7)] * extra : 0.f;
#pragma unroll
    for (int k = 0; k < 8; ++k) r.rs[k] = rs1[brow + (k >> 2) * HALF + wr * 64 + (k & 3) * 16 + fr];
    return r;
  }
  __device__ __forceinline__ void operator()(const f32x4 (&acc)[2][2][4][2], int brow, int bcol, const Pre& pre) const {
    EPI_IDS
    const int ct = bcol >> 8;
    const bool gp = !(ct == 4 || ct == 5 || (ct == 8 && wc >= 2));
    const int smask = (brow < NPROMPT) ? 2047 : 4095;
#pragma unroll
    for (int ai = 0; ai < 2; ++ai)
#pragma unroll
      for (int m = 0; m < 4; ++m) {
        const int row = brow + ai * HALF + wr * 64 + m * 16 + fr;
        const float rs = pre.rs[ai * 4 + m];
        float v[16];
#pragma unroll
        for (int bj = 0; bj < 2; ++bj)
#pragma unroll
          for (int n = 0; n < 2; ++n)
#pragma unroll
            for (int j = 0; j < 4; ++j) v[8 * bj + 4 * n + j] = acc[ai][bj][m][n][j] * rs;
        if (gp) {
          float ss = 0.f;
#pragma unroll
          for (int i = 0; i < 16; ++i) ss += v[i] * v[i];
          ss += __shfl_xor(ss, 16); ss += __shfl_xor(ss, 32);
          const float inv = rsqrtf(ss * (1.0f / 64.0f) + EPS);
#pragma unroll
          for (int i = 0; i < 16; ++i) v[i] = v[i] * inv * pre.gn[i];
          {
            const float pos = (float)(row & smask);
            const float sgn = fq == 0 ? -1.0f : 1.0f;
#pragma unroll
            for (int i = 0; i < 8; ++i) {
              const float ci = i == 0 ? 1.5915494309e-01f : i == 1 ? 3.0863763405e-02f : i == 2 ? 5.9851857127e-03f : i == 3 ? 1.1606636412e-03f : i == 4 ? 2.2507907904e-04f : i == 5 ? 4.3647952793e-05f : i == 6 ? 8.4643308082e-06f : 1.6414262628e-06f;
              const float vp = __shfl_xor(v[i], 16);
              const float tr = __builtin_amdgcn_fractf(pos * ci);
              const float c = __builtin_amdgcn_cosf(tr), s = __builtin_amdgcn_sinf(tr);
              const float r = v[i] * c + sgn * (vp * s);
              v[i] = fq < 2 ? r : v[i];
            }
          }
        }
        u32x4 w0, w1; PACK16(v, w0, w1)
        bf16_t* dst = qkv + (size_t)row * INC + bcol + 64 * wc + 8 * fq;
        *(u32x4*)dst = w0; *(u32x4*)(dst + 32) = w1;
      }
  }
};

struct EpiWo {
  const float *xp, *xs; bf16_t* hb; float* ssq2p; const float* ssqh;
  __device__ __forceinline__ void scales(int row, float& sa, float& sb) const {
    const float* sp = ssqh + (size_t)row * 16;
    const f32x4 a = *(const f32x4*)sp, b = *(const f32x4*)(sp + 4), c = *(const f32x4*)(sp + 8), d = *(const f32x4*)(sp + 12);
    sa = rsqrtf((((a[0] + a[1]) + (a[2] + a[3])) + ((b[0] + b[1]) + (b[2] + b[3]))) * (1.0f / 512.0f) + EPS);
    sb = rsqrtf((((c[0] + c[1]) + (c[2] + c[3])) + ((d[0] + d[1]) + (d[2] + d[3]))) * (1.0f / 512.0f) + EPS);
  }
  __device__ __forceinline__ void mid(f32x4 (&acc)[2][2][4][2], int brow) const {
    EPI_IDS
    (void)wc; (void)fq;
#pragma unroll
    for (int ai = 0; ai < 2; ++ai)
#pragma unroll
      for (int m = 0; m < 4; ++m) {
        float sa, sb; scales(brow + ai * HALF + wr * 64 + m * 16 + fr, sa, sb);
        const float ratio = sa / sb;
#pragma unroll
        for (int bj = 0; bj < 2; ++bj)
#pragma unroll
          for (int n = 0; n < 2; ++n) acc[ai][bj][m][n] = acc[ai][bj][m][n] * ratio;
      }
  }
  struct Pre {};
  __device__ __forceinline__ Pre pre(int, int) const { return Pre{}; }
  __device__ __forceinline__ void operator()(const f32x4 (&acc)[2][2][4][2], int brow, int bcol, const Pre&) const {
    EPI_IDS
    const float* xbase = (brow < NPROMPT) ? (xp + (size_t)brow * DM) : (xs + (size_t)(brow - NPROMPT) * DM);
#pragma unroll
    for (int ai = 0; ai < 2; ++ai) {
      f32x4 xv[4][4]; float sbv[4];
#pragma unroll
      for (int m = 0; m < 4; ++m) {
        const int rl = ai * HALF + wr * 64 + m * 16 + fr;
        const float* xr = xbase + (size_t)rl * DM + bcol + 64 * wc + 8 * fq;
#pragma unroll
        for (int q = 0; q < 4; ++q) xv[m][q] = *(const f32x4*)(xr + 32 * (q >> 1) + 4 * (q & 1));
        float sa; scales(brow + rl, sa, sbv[m]);
      }
#pragma unroll
      for (int m = 0; m < 4; ++m) {
        const int rl = ai * HALF + wr * 64 + m * 16 + fr;
        float v[16]; float ss = 0.f;
#pragma unroll
        for (int bj = 0; bj < 2; ++bj)
#pragma unroll
          for (int n = 0; n < 2; ++n)
#pragma unroll
            for (int j = 0; j < 4; ++j) { const float h = xv[m][2 * bj + n][j] + acc[ai][bj][m][n][j] * sbv[m]; v[8 * bj + 4 * n + j] = h; ss += h * h; }
        ss += __shfl_xor(ss, 16); ss += __shfl_xor(ss, 32);
        if (fq == 0) ssq2p[(size_t)(brow + rl) * 16 + (bcol >> 8) * 4 + wc] = ss;
        u32x4 w0, w1; PACK16(v, w0, w1)
        bf16_t* dst = hb + (size_t)(brow + rl) * DM + bcol + 64 * wc + 8 * fq;
        *(u32x4*)dst = w0; *(u32x4*)(dst + 32) = w1;
      }
      __builtin_amdgcn_sched_barrier(0);
    }
  }
};

struct EpiUp {
  bf16_t* u; const float* s2; int row_base;
  struct Pre { float s2v[8]; };
  __device__ __forceinline__ Pre pre(int brow, int) const {
    EPI_IDS
    (void)wc; (void)fq;
    Pre r;
#pragma unroll
    for (int k = 0; k < 8; ++k) r.s2v[k] = s2[row_base + brow + (k >> 2) * HALF + wr * 64 + (k & 3) * 16 + fr];
    return r;
  }
  __device__ __forceinline__ void operator()(const f32x4 (&acc)[2][2][4][2], int brow, int bcol, const Pre& pre) const {
    EPI_IDS
#pragma unroll
    for (int ai = 0; ai < 2; ++ai)
#pragma unroll
      for (int m = 0; m < 4; ++m) {
        const int rl = brow + ai * HALF + wr * 64 + m * 16 + fr;
        const float s2r = pre.s2v[ai * 4 + m];
        float v[16];
#pragma unroll
        for (int bj = 0; bj < 2; ++bj)
#pragma unroll
          for (int n = 0; n < 2; ++n)
#pragma unroll
            for (int j = 0; j < 4; ++j) { const float z = fmaxf(acc[ai][bj][m][n][j] * s2r, 0.f); v[8 * bj + 4 * n + j] = z * z; }
        u32x4 w0, w1; PACK16(v, w0, w1)
        bf16_t* dst = u + (size_t)rl * DFF + bcol + 64 * wc + 8 * fq;
        *(u32x4*)dst = w0; *(u32x4*)(dst + 32) = w1;
      }
  }
};

struct EpiDown {
  const bf16_t* hb; float* out; int row_base;
  struct Pre {};
  __device__ __forceinline__ Pre pre(int, int) const { return Pre{}; }
  __device__ __forceinline__ void operator()(const f32x4 (&acc)[2][2][4][2], int brow, int bcol, const Pre&) const {
    EPI_IDS
#pragma unroll
    for (int ai = 0; ai < 2; ++ai) {
      u32x2 hv[4][2][2];
#pragma unroll
      for (int m = 0; m < 4; ++m) {
        const size_t off = (size_t)(row_base + brow + ai * HALF + wr * 64 + m * 16 + fr) * DM + bcol + 32 * wc + 4 * fq;
#pragma unroll
        for (int bj = 0; bj < 2; ++bj)
#pragma unroll
          for (int n = 0; n < 2; ++n) hv[m][bj][n] = *(const u32x2*)(hb + off + 128 * bj + 16 * n);
      }
#pragma unroll
      for (int m = 0; m < 4; ++m) {
        const size_t off = (size_t)(row_base + brow + ai * HALF + wr * 64 + m * 16 + fr) * DM + bcol + 32 * wc + 4 * fq;
        float* dst = out + off;
#pragma unroll
        for (int bj = 0; bj < 2; ++bj)
#pragma unroll
          for (int n = 0; n < 2; ++n) {
            const unsigned a = hv[m][bj][n].x, b = hv[m][bj][n].y;
            f32x4 o;
            o[0] = __uint_as_float(a << 16) + acc[ai][bj][m][n][0]; o[1] = __uint_as_float(a & 0xffff0000u) + acc[ai][bj][m][n][1];
            o[2] = __uint_as_float(b << 16) + acc[ai][bj][m][n][2]; o[3] = __uint_as_float(b & 0xffff0000u) + acc[ai][bj][m][n][3];
            *(f32x4*)(dst + 128 * bj + 16 * n) = o;
          }
      }
      __builtin_amdgcn_sched_barrier(0);
    }
  }
};

__device__ __forceinline__ void p0_transpose_item(const float* __restrict__ W, int K, int N, bf16_t* __restrict__ WT, const float* __restrict__ g0, const float* __restrict__ g1, float* scr, int item, int lane, int mode) {
  const int nblk = N / 32, kb = item / nblk, nb = item % nblk, k0 = 64 * kb, n0 = 32 * nb;
#pragma unroll 8
  for (int i = 0; i < 32; ++i) {
    const int kk = 2 * i + (lane >> 5), k = k0 + kk;
    float gv = 1.f; if (g0) gv = (g1 && k >= 512) ? g1[k - 512] : g0[k];
    scr[kk * 33 + (lane & 31)] = W[(size_t)k * N + n0 + (lane & 31)] * gv;
  }
  asm volatile("s_waitcnt lgkmcnt(0)" ::: "memory");
  const int c = lane & 7;
#pragma unroll
  for (int j = 0; j < 4; ++j) {
    const int n = (lane >> 3) + 8 * j; const float* s = scr + (8 * c) * 33 + n;
    u32x4 o; o.x = pk2(s[0 * 33], s[1 * 33]); o.y = pk2(s[2 * 33], s[3 * 33]); o.z = pk2(s[4 * 33], s[5 * 33]); o.w = pk2(s[6 * 33], s[7 * 33]);
    const int col = n0 + n, drow = (col & ~255) + col_slot(col & 255, mode);
    *(u32x4*)(WT + (size_t)drow * K + k0 + 8 * c) = o;
  }
  asm volatile("s_waitcnt lgkmcnt(0)" ::: "memory");
}

__device__ __forceinline__ void p0_prologue(const Params& p) {
  int tid = threadIdx.x; asm volatile("" : "+v"(tid));
  const int wave = tid >> 6, lane = tid & 63;
  const int gw = blockIdx.x * 8 + wave, NGW = gridDim.x * 8;
  float* scr = (float*)(g_shm + wave * 16384);
  bf16_t* WinT = (bf16_t*)(p.ws + WS_WIN); bf16_t* WoT = (bf16_t*)(p.ws + WS_WO); bf16_t* WupT = (bf16_t*)(p.ws + WS_WUP); bf16_t* WdT = (bf16_t*)(p.ws + WS_WD);
  constexpr int I_IN = 16 * 72, I_O = 16 * 32, I_UP = 16 * 128, I_DN = 64 * 32, NIT = I_IN + I_O + I_UP + I_DN;
  for (int it = gw; it < NIT; it += NGW) {
    int r = it;
    if (r < I_IN) { p0_transpose_item(p.w_in, DM, INC, WinT, p.norm_attn, nullptr, scr, r, lane, 1); continue; } r -= I_IN;
    if (r < I_O) { p0_transpose_item(p.w_o, DM, DM, WoT, p.ona, p.onb, scr, r, lane, 1); continue; } r -= I_O;
    if (r < I_UP) { p0_transpose_item(p.w_up, DM, DFF, WupT, p.norm_mlp, nullptr, scr, r, lane, 1); continue; } r -= I_UP;
    p0_transpose_item(p.w_down, DFF, DM, WdT, nullptr, nullptr, scr, r, lane, 2);
  }
  bf16_t* xb = (bf16_t*)(p.ws + WS_X); float* rs1 = (float*)(p.ws + WS_RS1);
  for (int row4 = gw * 4; row4 < NTOK; row4 += NGW * 4) {
    f32x4 v[4][4];
#pragma unroll
    for (int r = 0; r < 4; ++r) {
      const int row = row4 + r;
      const float* xr = (row < NPROMPT) ? (p.xp + (size_t)row * DM) : (p.xs + (size_t)(row - NPROMPT) * DM);
#pragma unroll
      for (int j = 0; j < 4; ++j) v[r][j] = *(const f32x4*)(xr + 256 * j + 4 * lane);
    }
#pragma unroll
    for (int r = 0; r < 4; ++r) {
      const int row = row4 + r; float s = 0.f;
#pragma unroll
      for (int j = 0; j < 4; ++j) s += (v[r][j][0] * v[r][j][0] + v[r][j][1] * v[r][j][1]) + (v[r][j][2] * v[r][j][2] + v[r][j][3] * v[r][j][3]);
#pragma unroll
      for (int o = 1; o < 64; o <<= 1) s += __shfl_xor(s, o);
#pragma unroll
      for (int j = 0; j < 4; ++j) { u32x2 w; w.x = pk2(v[r][j][0], v[r][j][1]); w.y = pk2(v[r][j][2], v[r][j][3]); *(u32x2*)(xb + (size_t)row * DM + 256 * j + 4 * lane) = w; }
      if (lane == 0) rs1[row] = rsqrtf(s * (1.0f / DM) + EPS);
    }
  }
}

struct ChunkSrc { int rowc, d, M, kc0; };

__device__ __forceinline__ void issue_chunk(const bf16_t* __restrict__ qkv, const ChunkSrc cs, int koff, int voff, int lane, unsigned char* slot) {
  const unsigned ck = (unsigned)(koff * 2), cv = (unsigned)(voff * 2);
#pragma unroll
  for (int i = 0; i < 4; ++i) {
    const int r = (lane >> 3) + 8 * i;
    int kc = cs.kc0 + r; kc = kc < 0 ? 0 : (kc > cs.M - 1 ? cs.M - 1 : kc);
    const unsigned row = __umul24((unsigned)cs.d, (unsigned)kc) + (unsigned)cs.rowc;
    const unsigned rb = __umul24(row, (unsigned)(INC * 2));
    const unsigned chk = (unsigned)(((lane & 7) ^ ((r >> 1) & 7)) << 4), chv = (unsigned)(((lane & 7) ^ (((r >> 1) & 3) << 1)) << 4);
    __builtin_amdgcn_global_load_lds((const __attribute__((address_space(1))) unsigned*)((const char*)qkv + (rb + (ck + chk))), (LAS unsigned*)(slot + i * 1024), 16, 0, 0);
    __builtin_amdgcn_global_load_lds((const __attribute__((address_space(1))) unsigned*)((const char*)qkv + (rb + (cv + chv))), (LAS unsigned*)(slot + 4096 + i * 1024), 16, 0, 0);
  }
}
__device__ __forceinline__ void read_vt(unsigned a0, unsigned a1, unsigned a2, unsigned a3, bf16x8 (&Vt)[4]) {
  u32x2 r00, r01, r10, r11, r20, r21, r30, r31;
  asm volatile(
      "ds_read_b64_tr_b16 %0, %8\n\tds_read_b64_tr_b16 %1, %8 offset:2048\n\t"
      "ds_read_b64_tr_b16 %2, %9\n\tds_read_b64_tr_b16 %3, %9 offset:2048\n\t"
      "ds_read_b64_tr_b16 %4, %10\n\tds_read_b64_tr_b16 %5, %10 offset:2048\n\t"
      "ds_read_b64_tr_b16 %6, %11\n\tds_read_b64_tr_b16 %7, %11 offset:2048\n\t"
      "s_waitcnt lgkmcnt(0)"
      : "=&v"(r00), "=&v"(r01), "=&v"(r10), "=&v"(r11), "=&v"(r20), "=&v"(r21), "=&v"(r30), "=&v"(r31)
      : "v"(a0), "v"(a1), "v"(a2), "v"(a3) : "memory");
  u32x4 t;
  t.x = r00.x; t.y = r00.y; t.z = r01.x; t.w = r01.y; Vt[0] = __builtin_bit_cast(bf16x8, t);
  t.x = r10.x; t.y = r10.y; t.z = r11.x; t.w = r11.y; Vt[1] = __builtin_bit_cast(bf16x8, t);
  t.x = r20.x; t.y = r20.y; t.z = r21.x; t.w = r21.y; Vt[2] = __builtin_bit_cast(bf16x8, t);
  t.x = r30.x; t.y = r30.y; t.z = r31.x; t.w = r31.y; Vt[3] = __builtin_bit_cast(bf16x8, t);
}
__device__ __forceinline__ void tile_chunk(const bf16x8 (&Kf)[2][2], const bf16x8 (&Q)[2], const bf16x8 (&Vt)[4], f32x4 (&o)[4], float& l, int kcl, int lo, unsigned span, float negm) {
  f32x4 s0 = {negm, negm, negm, negm}, s1 = s0;
  s0 = mfma16(Kf[0][0], Q[0], s0); s0 = mfma16(Kf[0][1], Q[1], s0);
  s1 = mfma16(Kf[1][0], Q[0], s1); s1 = mfma16(Kf[1][1], Q[1], s1);
  float pv[8]; float sum = 0.f;
#pragma unroll
  for (int j = 0; j < 4; ++j) {
    pv[j] = ((unsigned)(kcl + j - lo) <= span) ? __builtin_amdgcn_exp2f(s0[j]) : 0.f;
    pv[4 + j] = ((unsigned)(kcl + 16 + j - lo) <= span) ? __builtin_amdgcn_exp2f(s1[j]) : 0.f;
    sum += pv[j] + pv[4 + j];
  }
  l += sum;
  u32x4 pk; pk.x = pk2(pv[0], pv[1]); pk.y = pk2(pv[2], pv[3]); pk.z = pk2(pv[4], pv[5]); pk.w = pk2(pv[6], pv[7]);
  const bf16x8 P = __builtin_bit_cast(bf16x8, pk);
#pragma unroll
  for (int dt = 0; dt < 4; ++dt) o[dt] = mfma16(Vt[dt], P, o[dt]);
}

template <int TMASK, class DESC>
__device__ __forceinline__ void run_branch(const bf16_t* __restrict__ qkv, const DESC& desc, int& gi, const int total, const int nchunks, const int M, const int kstart, int koff, int voff,
                                           int qcb, int qstep, int hw, float negm, int lane, unsigned char* ring, const bf16x8 (&Q)[4][2], f32x4 (&o)[4][4], float (&l)[4]) {
  const int g = lane >> 4;
  int lo[4]; unsigned span[4];
#pragma unroll
  for (int t = 0; t < 4; ++t) { const int qc = qcb + t * qstep; lo[t] = qc - hw < 0 ? 0 : qc - hw; const int hi = qc + hw > M - 1 ? M - 1 : qc + hw; span[t] = (unsigned)(hi - lo[t]); }
  const int qp = (lane & 15) >> 2, pp = lane & 3, rl = 4 * g + qp, f = (rl >> 1) & 3;
  const unsigned vbase = (unsigned)(size_t)ring + 4096 + rl * 128 + pp * 8;
  const unsigned a0 = vbase + ((0 ^ f) << 5), a1 = vbase + ((1 ^ f) << 5), a2 = vbase + ((2 ^ f) << 5), a3 = vbase + ((3 ^ f) << 5);
  const int krow = lane & 15;
  const LAS unsigned char* kb0 = (const LAS unsigned char*)ring + krow * 128 + (((0 + g) ^ (krow >> 1)) << 4);
  const LAS unsigned char* kb1 = (const LAS unsigned char*)ring + krow * 128 + (((4 + g) ^ (krow >> 1)) << 4);
#pragma unroll 1
  for (int c = 0; c < nchunks; ++c, ++gi) {
    const unsigned soff = (unsigned)(gi & (ATT_SLOTS - 1)) * 8192u;
    bf16x8 Kf[2][2];
    if constexpr (ATT_LA == 1) {
      asm volatile("s_waitcnt vmcnt(0)" ::: "memory");
      Kf[0][0] = *(const LAS bf16x8*)(kb0 + soff); Kf[0][1] = *(const LAS bf16x8*)(kb1 + soff);
      Kf[1][0] = *(const LAS bf16x8*)(kb0 + soff + 2048); Kf[1][1] = *(const LAS bf16x8*)(kb1 + soff + 2048);
      if (gi + 1 < total) issue_chunk(qkv, desc(gi + 1), koff, voff, lane, ring + ((gi + 1) & 1) * 8192);
    } else {
      if (gi + ATT_LA < total) issue_chunk(qkv, desc(gi + ATT_LA), koff, voff, lane, ring + ((gi + ATT_LA) & (ATT_SLOTS - 1)) * 8192);
      const int rem = total - 1 - gi;
      if (ATT_LA >= 3 && rem >= 3) asm volatile("s_waitcnt vmcnt(24)" ::: "memory");
      else if (ATT_LA >= 2 && rem >= 2) asm volatile("s_waitcnt vmcnt(16)" ::: "memory");
      else if (rem >= 1) asm volatile("s_waitcnt vmcnt(8)" ::: "memory");
      else asm volatile("s_waitcnt vmcnt(0)" ::: "memory");
      Kf[0][0] = *(const LAS bf16x8*)(kb0 + soff); Kf[0][1] = *(const LAS bf16x8*)(kb1 + soff);
      Kf[1][0] = *(const LAS bf16x8*)(kb0 + soff + 2048); Kf[1][1] = *(const LAS bf16x8*)(kb1 + soff + 2048);
    }
    bf16x8 Vt[4];
    read_vt(a0 + soff, a1 + soff, a2 + soff, a3 + soff, Vt);
    const int kcl = kstart + 32 * c + 4 * g;
#pragma unroll
    for (int t = 0; t < 4; ++t)
      if (TMASK & (1 << t)) tile_chunk(Kf, Q[t], Vt, o[t], l[t], kcl, lo[t], span[t], negm);
  }
}

__device__ __forceinline__ float wave_max(float v) {
#pragma unroll
  for (int o = 1; o < 64; o <<= 1) v = fmaxf(v, __shfl_xor(v, o));
  return v;
}

__device__ __forceinline__ void attn_phase(const Params& p) {
  int tid = threadIdx.x; asm volatile("" : "+v"(tid));
  const int wave = __builtin_amdgcn_readfirstlane(tid >> 6), lane = tid & 63, qi = lane & 15, g = lane >> 4;
  if (wave >= ATT_NACT) return;
  const bf16_t* qkv = (const bf16_t*)(p.ws + WS_QKV);
  bf16_t* mix = (bf16_t*)(p.ws + WS_X);
  float* ssqh = (float*)(p.ws + WS_SSQH);
  unsigned char* ring = g_shm + wave * (ATT_SLOTS * 8192);
  const float mfixA = 8.0f * LOG2E * wave_max(fabsf(p.qna[lane])) * wave_max(fabsf(p.kna[lane]));
  const float mfixB = 8.0f * LOG2E * wave_max(fabsf(p.qnb[lane])) * wave_max(fabsf(p.knb[lane]));
  const int xcd = blockIdx.x & 7, wx = (blockIdx.x >> 3) * ATT_NACT + wave, nwx = (gridDim.x >> 3) * ATT_NACT;
  for (int li = wx; li < 2048; li += nwx) {
    const int kind = (li / nwx) & 1;
    const int lk = ((li / nwx) >> 1) * nwx + (li % nwx);
    const int grp = xcd * 128 + (lk & 127), sub = lk >> 7;
    const int r64 = grp * 64;
    const int S = r64 < NPROMPT ? 2048 : 4096;
    const int row0 = r64 & ~(S - 1);
    bf16x8 Q[4][2]; f32x4 o[4][4]; float l[4];
#pragma unroll
    for (int t = 0; t < 4; ++t) {
#pragma unroll
      for (int dt = 0; dt < 4; ++dt) o[t][dt] = (f32x4){0.f, 0.f, 0.f, 0.f};
    }
    int tok[4], colb[4];
    int gi = 0;
    if (kind == 0) {
      const int sidx = (r64 - row0) >> 6, c4 = sidx & 3, p0 = (sidx >> 2) * 16, h = sub;
#pragma unroll
      for (int t = 0; t < 4; ++t) {
        tok[t] = 16 * (p0 + qi) + c4 + 4 * t; colb[t] = h * 64; l[t] = 0.f;
        const bf16_t* rp = qkv + (size_t)(row0 + tok[t]) * INC + h * 64 + g * 8;
        Q[t][0] = *(const bf16x8*)rp; Q[t][1] = *(const bf16x8*)(rp + 32);
      }
      const int koff = 512 + h * 64, voff = 1024 + h * 64;
      auto desc = [=](int i) -> ChunkSrc {
        ChunkSrc r;
        if (i < 12) { r.rowc = row0; r.d = 1; r.M = S; r.kc0 = 16 * p0 - 64 + 32 * i; }
        else if (i < 18) { r.rowc = row0 + c4; r.d = 4; r.M = S >> 2; r.kc0 = 4 * p0 - 64 + 32 * (i - 12); }
        else { const int j = i - 18, t = j / 5, c = j - 5 * t; r.rowc = row0 + c4 + 4 * t; r.d = 16; r.M = S >> 4; r.kc0 = p0 - 64 + 32 * c; }
        return r;
      };
      constexpr int TOTAL = 38;
#pragma unroll
      for (int i = 0; i < ATT_LA; ++i) issue_chunk(qkv, desc(i), koff, voff, lane, ring + i * 8192);
      run_branch<15>(qkv, desc, gi, TOTAL, 12, S, 16 * p0 - 64, koff, voff, 16 * (p0 + qi) + c4, 4, 64, -mfixA, lane, ring, Q, o, l);
      run_branch<15>(qkv, desc, gi, TOTAL, 6, S >> 2, 4 * p0 - 64, koff, voff, 4 * (p0 + qi), 1, 64, -mfixA, lane, ring, Q, o, l);
      run_branch<1>(qkv, desc, gi, TOTAL, 5, S >> 4, p0 - 64, koff, voff, p0 + qi, 0, 64, -mfixA, lane, ring, Q, o, l);
      run_branch<2>(qkv, desc, gi, TOTAL, 5, S >> 4, p0 - 64, koff, voff, p0 + qi, 0, 64, -mfixA, lane, ring, Q, o, l);
      run_branch<4>(qkv, desc, gi, TOTAL, 5, S >> 4, p0 - 64, koff, voff, p0 + qi, 0, 64, -mfixA, lane, ring, Q, o, l);
      run_branch<8>(qkv, desc, gi, TOTAL, 5, S >> 4, p0 - 64, koff, voff, p0 + qi, 0, 64, -mfixA, lane, ring, Q, o, l);
    } else {
      const int kvh = sub & 1, qsub = sub >> 1, q0 = (r64 - row0) + 16 * qsub;
#pragma unroll
      for (int t = 0; t < 4; ++t) {
        const int hq = kvh * 4 + t;
        tok[t] = q0 + qi; colb[t] = 512 + hq * 64;
        l[t] = (g == 0) ? __builtin_amdgcn_exp2f(p.sink[hq] * LOG2E - mfixB) : 0.f;
        const bf16_t* rp = qkv + (size_t)(row0 + tok[t]) * INC + 1536 + hq * 64 + g * 8;
        Q[t][0] = *(const bf16x8*)rp; Q[t][1] = *(const bf16x8*)(rp + 32);
      }
      const int koff = 2048 + kvh * 64, voff = 2176 + kvh * 64;
      auto desc = [=](int i) -> ChunkSrc { ChunkSrc r; r.rowc = row0; r.d = 1; r.M = S; r.kc0 = q0 - 128 + 32 * i; return r; };
      constexpr int TOTAL = 9;
#pragma unroll
      for (int i = 0; i < ATT_LA; ++i) issue_chunk(qkv, desc(i), koff, voff, lane, ring + i * 8192);
      run_branch<15>(qkv, desc, gi, TOTAL, 9, S, q0 - 128, koff, voff, q0 + qi, 0, 128, -mfixB, lane, ring, Q, o, l);
    }
#pragma unroll
    for (int t = 0; t < 4; ++t) {
      float L = l[t]; L += __shfl_xor(L, 16); L += __shfl_xor(L, 32);
      const float inv = 1.0f / L; float ss = 0.f;
#pragma unroll
      for (int dt = 0; dt < 4; ++dt)
#pragma unroll
        for (int j = 0; j < 4; ++j) { const float x = o[t][dt][j] * inv; o[t][dt][j] = x; ss += x * x; }
      ss += __shfl_xor(ss, 16); ss += __shfl_xor(ss, 32);
      const size_t row = (size_t)(row0 + tok[t]);
      if (g == 0) ssqh[row * 16 + (colb[t] >> 6)] = ss;
      bf16_t* dst = mix + row * DM + colb[t] + 4 * g;
#pragma unroll
      for (int dt = 0; dt < 4; ++dt) { u32x2 w; w.x = pk2(o[t][dt][0], o[t][dt][1]); w.y = pk2(o[t][dt][2], o[t][dt][3]); *(u32x2*)(dst + 16 * dt) = w; }
    }
  }
}

#define XB_TMO      128
#define XB_XCNT(j)  (256  + 64 * (j))
#define XB_XSUB(j)  (1280 + 64 * (j))
#define XB_XGEN(j)  (2304 + 64 * (j))
#define XB_TOP      3328
#define XB_TOPGEN   3392
#define XCD_BAR_WORDS 3456
#define XB_SPIN_CAP (1u << 18)
__device__ __forceinline__ unsigned xb_ld(unsigned* p)              { return __hip_atomic_load(p, __ATOMIC_RELAXED, __HIP_MEMORY_SCOPE_AGENT); }
__device__ __forceinline__ unsigned xb_add(unsigned* p, unsigned v) { return __hip_atomic_fetch_add(p, v, __ATOMIC_RELAXED, __HIP_MEMORY_SCOPE_AGENT); }
__device__ __forceinline__ unsigned xb_xcc_id() { return (unsigned)__builtin_amdgcn_s_getreg((3 << 11) | 20) & 0xFu; }
#define XB_SPIN(cond, bar) do { unsigned _sp = 0; while (cond) { __builtin_amdgcn_s_sleep(1); \
    if ((++_sp & 255u) == 0u) { if (xb_ld(&(bar)[XB_TMO])) break; if (_sp > XB_SPIN_CAP) { atomicAdd(&(bar)[XB_TMO], 1u); break; } } } } while (0)
struct XcdBarrier { unsigned* bar; unsigned x; volatile LAS unsigned* st; };
__device__ __forceinline__ XcdBarrier xcd_barrier_post(unsigned* bar, volatile LAS unsigned* st) {
  XcdBarrier b; b.bar = bar; b.x = xb_xcc_id(); b.st = st;
  if (threadIdx.x == 0) (void)xb_add(&bar[XB_XCNT(b.x)], 1u);
  return b;
}
__device__ __forceinline__ void xcd_barrier_complete(unsigned* bar, unsigned x, unsigned& nloc, unsigned& nx) {
  const unsigned G = gridDim.x * gridDim.y * gridDim.z;
  unsigned sum, cnt, mine, sp = 0u;
  for (;;) {
    sum = 0u; cnt = 0u; mine = 0u;
#pragma unroll
    for (unsigned j = 0; j < 16; ++j) { const unsigned c = xb_ld(&bar[XB_XCNT(j)]); sum += c; cnt += (c > 0u) ? 1u : 0u; mine = (j == x) ? c : mine; }
    if (sum == G) break;
    __builtin_amdgcn_s_sleep(1);
    if ((++sp & 255u) == 0u) { if (xb_ld(&bar[XB_TMO])) break; if (sp > XB_SPIN_CAP) { atomicAdd(&bar[XB_TMO], 1u); break; } }
  }
  nloc = mine > 0u ? mine : 1u; nx = cnt > 0u ? cnt : 1u;
}
__device__ __forceinline__ void xcd_barrier_impl(const XcdBarrier& b) {
  asm volatile("s_waitcnt vmcnt(0)" ::: "memory");
  __syncthreads();
  if (threadIdx.x == 0) {
    unsigned* bar = b.bar;
    __builtin_amdgcn_s_waitcnt(0);
    unsigned nloc = b.st[0], nx = b.st[1];
    if (nloc == 0u) { xcd_barrier_complete(bar, b.x, nloc, nx); b.st[0] = nloc; b.st[1] = nx; }
    const unsigned old = xb_add(&bar[XB_XSUB(b.x)], 1u);
    const unsigned gen = old / nloc;
    if (old + 1u == (gen + 1u) * nloc) {
      __builtin_amdgcn_fence(__ATOMIC_RELEASE, "agent");
      asm volatile("s_waitcnt vmcnt(0)" ::: "memory");
      const unsigned og = xb_add(&bar[XB_TOP], 1u);
      const unsigned tg = og / nx;
      if (og + 1u == (tg + 1u) * nx) xb_add(&bar[XB_TOPGEN], 1u);
      else XB_SPIN(xb_ld(&bar[XB_TOPGEN]) == tg, bar);
      __builtin_amdgcn_fence(__ATOMIC_ACQUIRE, "agent");
      xb_add(&bar[XB_XGEN(b.x)], 1u);
      asm volatile("s_waitcnt vmcnt(0)" ::: "memory");
    } else {
      XB_SPIN(xb_ld(&bar[XB_XGEN(b.x)]) == gen, bar);
      __builtin_amdgcn_fence(__ATOMIC_ACQUIRE, "agent");
      asm volatile("s_waitcnt vmcnt(0)" ::: "memory");
    }
  }
  __syncthreads();
}

__device__ __forceinline__ void xcd_barrier(unsigned char* ws) {
  XcdBarrier b; b.bar = (unsigned*)(ws + WS_BAR); b.x = xb_xcc_id(); b.st = (volatile LAS unsigned*)((LAS unsigned char*)g_shm + GEMM_LDS_BYTES);
  xcd_barrier_impl(b);
}

typedef const __attribute__((address_space(4))) Params* KArgs;
__device__ __forceinline__ Params load_params() {
#if defined(__HIP_DEVICE_COMPILE__)
  KArgs kp = (KArgs)__builtin_amdgcn_kernarg_segment_ptr();
  asm volatile("" : "+s"(kp));
  Params r;
  r.xp = kp->xp; r.xs = kp->xs; r.norm_attn = kp->norm_attn; r.w_in = kp->w_in; r.qna = kp->qna; r.kna = kp->kna; r.qnb = kp->qnb; r.knb = kp->knb; r.sink = kp->sink;
  r.ona = kp->ona; r.onb = kp->onb; r.w_o = kp->w_o; r.norm_mlp = kp->norm_mlp; r.w_up = kp->w_up; r.w_down = kp->w_down; r.out = kp->out; r.ws = kp->ws;
  return r;
#else
  return Params{};
#endif
}

__global__ void __launch_bounds__(512) fwd_megakernel(Params p_unused) {
  cg::grid_group grid = cg::this_grid();
  {
    const Params p = load_params();
    volatile LAS unsigned* xst = (volatile LAS unsigned*)((LAS unsigned char*)g_shm + GEMM_LDS_BYTES);
    if (threadIdx.x == 0) { xst[0] = 0u; xst[1] = 0u; }
    (void)xcd_barrier_post((unsigned*)(p.ws + WS_BAR), xst);
    p0_prologue(p);
    if (p.ws == nullptr) grid.sync();
    xcd_barrier(p.ws);
  }
  {
    const Params p = load_params();
    EpiQKV e{(bf16_t*)(p.ws + WS_QKV), (const float*)(p.ws + WS_RS1), p.qna, p.kna, p.qnb, p.knb};
    gemm_phase<EpiQKV, GEMM_ALIGN, GEMM_SP2>((const bf16_t*)(p.ws + WS_X), (const bf16_t*)(p.ws + WS_WIN), NTOK, INC, DM, e);
    xcd_barrier(p.ws);
  }
  {
    const Params p = load_params();
    attn_phase(p);
    xcd_barrier(p.ws);
  }
  {
    const Params p = load_params();
    EpiWo e{p.xp, p.xs, (bf16_t*)(p.ws + WS_HB), (float*)(p.ws + WS_SSQ2), (const float*)(p.ws + WS_SSQH)};
    gemm_phase<EpiWo, GEMM_ALIGN, GEMM_SP2, true>((const bf16_t*)(p.ws + WS_X), (const bf16_t*)(p.ws + WS_WO), NTOK, DM, DM, e);
    xcd_barrier(p.ws);
    { const float* sp = (const float*)(p.ws + WS_SSQ2); float* s2 = (float*)(p.ws + WS_RS1);
      for (int row = blockIdx.x * 512 + threadIdx.x; row < NTOK; row += gridDim.x * 512) {
        const f32x4 a = *(const f32x4*)(sp + (size_t)row * 16), b = *(const f32x4*)(sp + (size_t)row * 16 + 4), c = *(const f32x4*)(sp + (size_t)row * 16 + 8), d = *(const f32x4*)(sp + (size_t)row * 16 + 12);
        const float tot = (((a[0] + a[1]) + (a[2] + a[3])) + ((b[0] + b[1]) + (b[2] + b[3]))) + (((c[0] + c[1]) + (c[2] + c[3])) + ((d[0] + d[1]) + (d[2] + d[3])));
        s2[row] = rsqrtf(tot * (1.0f / DM) + EPS);
      } }
    xcd_barrier(p.ws);
  }
  for (int half = 0; half < 2; ++half) {
    const int rb = half * NPROMPT;
    {
      const Params p = load_params();
      EpiUp e{(bf16_t*)(p.ws + WS_U), (const float*)(p.ws + WS_RS1), rb};
      gemm_phase<EpiUp, GEMM_ALIGN, GEMM_SP2>((const bf16_t*)(p.ws + WS_HB) + (size_t)rb * DM, (const bf16_t*)(p.ws + WS_WUP), NPROMPT, DFF, DM, e);
      xcd_barrier(p.ws);
    }
    {
      const Params p = load_params();
      EpiDown e{(const bf16_t*)(p.ws + WS_HB), p.out, rb};
      gemm_phase<EpiDown, GEMM_ALIGN, GEMM_SP2>((const bf16_t*)(p.ws + WS_U), (const bf16_t*)(p.ws + WS_WD), NPROMPT, DM, DFF, e);
      if (half == 0) xcd_barrier(p.ws);
    }
  }
}

extern "C" void kernel_launch(void* const* d_in, const int* in_sizes, int n_in, void* d_out, int out_size, void* d_ws, size_t ws_size, hipStream_t stream) {
  static int grid_blocks = 0;
  if (!grid_blocks) {
    if (n_in != 15 || ws_size < WS_NEED) { fprintf(stderr, "kernel_launch: unexpected n_in %d / ws_size %zu\n", n_in, ws_size); grid_blocks = -1; return; }
    int dev = 0, cus = 0, per_cu = 0;
    hipGetDevice(&dev);
    hipDeviceGetAttribute(&cus, hipDeviceAttributeMultiprocessorCount, dev);
    if (hipFuncSetAttribute((const void*)fwd_megakernel, hipFuncAttributeMaxDynamicSharedMemorySize, LDS_BYTES) != hipSuccess) { fprintf(stderr, "hipFuncSetAttribute failed\n"); grid_blocks = -1; return; }
    hipOccupancyMaxActiveBlocksPerMultiprocessor(&per_cu, (const void*)fwd_megakernel, 512, LDS_BYTES);
    if (per_cu < 1) { fprintf(stderr, "occupancy query says %d blocks/CU\n", per_cu); per_cu = 1; }
    (void)hipGetLastError();
    grid_blocks = cus;
  }
  if (grid_blocks < 0) return;
  if (hipMemsetAsync((char*)d_ws + WS_BAR, 0, 16384, stream) != hipSuccess) { fprintf(stderr, "hipMemsetAsync of the barrier words failed\n"); return; }
  Params p{};
  p.xp = (const float*)d_in[0]; p.xs = (const float*)d_in[1]; p.norm_attn = (const float*)d_in[2]; p.w_in = (const float*)d_in[3];
  p.qna = (const float*)d_in[4]; p.kna = (const float*)d_in[5]; p.qnb = (const float*)d_in[6]; p.knb = (const float*)d_in[7];
  p.sink = (const float*)d_in[8]; p.ona = (const float*)d_in[9]; p.onb = (const float*)d_in[10]; p.w_o = (const float*)d_in[11];
  p.norm_mlp = (const float*)d_in[12]; p.w_up = (const float*)d_in[13]; p.w_down = (const float*)d_in[14];
  p.out = (float*)d_out; p.ws = (unsigned char*)d_ws;
  void* args[] = {&p};
  hipError_t e = hipLaunchCooperativeKernel((const void*)fwd_megakernel, dim3(grid_blocks), dim3(512), args, LDS_BYTES, stream);
  if (e != hipSuccess) fprintf(stderr, "cooperative launch failed: %s (grid %d)\n", hipGetErrorString(e), grid_blocks);
}
```

```cpp
#include <hip/hip_runtime.h>
#include <hip/hip_cooperative_groups.h>
#include <cstdio>
#include <cstdint>
namespace cg = cooperative_groups;

typedef unsigned short bf16_t;
typedef short bf16x8 __attribute__((ext_vector_type(8)));
typedef float f32x4 __attribute__((ext_vector_type(4)));
typedef unsigned u32x4 __attribute__((ext_vector_type(4)));
typedef unsigned u32x2 __attribute__((ext_vector_type(2)));

constexpr int DM = 1024, NTOK = 65536, NPROMPT = 32768, INC = 2304, DFF = 4096;
constexpr float EPS = 1e-6f;
constexpr float LOG2E = 1.4426950408889634f;
constexpr float QSCALE = 0.18033688011112042f;

constexpr size_t MiB = 1048576;
constexpr size_t WS_WIN = 0, WS_WO = 4718592, WS_WUP = 6815744, WS_WD = 15204352, WS_RS1 = 23592960, WS_SSQ2 = 440 * MiB;
constexpr size_t WS_X = 24 * MiB;
constexpr size_t WS_QKV = 152 * MiB;
constexpr size_t WS_HB = 312 * MiB;
constexpr size_t WS_U = 24 * MiB;
constexpr size_t WS_SSQH = 444 * MiB;
constexpr size_t WS_BAR = 448 * MiB;
constexpr size_t WS_NEED = 449 * MiB;

constexpr int GEMM_LDS_BYTES = 131072, LDS_BYTES = GEMM_LDS_BYTES + 64;
constexpr bool GEMM_ALIGN = true, GEMM_SP2 = true;
constexpr int ATT_NACT = 8;
constexpr int ATT_SLOTS = 16 / ATT_NACT, ATT_LA = ATT_SLOTS - 1;

struct Params {
  const float *xp, *xs, *norm_attn, *w_in, *qna, *kna, *qnb, *knb, *sink, *ona, *onb, *w_o, *norm_mlp, *w_up, *w_down;
  float* out;
  unsigned char* ws;
};

extern __shared__ __attribute__((aligned(16))) unsigned char g_shm[];

typedef __bf16 bf16v2_t __attribute__((ext_vector_type(2)));
typedef float f32v2_t __attribute__((ext_vector_type(2)));
__device__ __forceinline__ unsigned pk2(float lo, float hi) { const f32v2_t f = {lo, hi}; const bf16v2_t b = __builtin_convertvector(f, bf16v2_t); return __builtin_bit_cast(unsigned, b); }
__device__ __forceinline__ float bf2f(unsigned short b) { return __uint_as_float(((unsigned)b) << 16); }
__device__ __forceinline__ f32x4 mfma16(bf16x8 a, bf16x8 b, f32x4 c) { return __builtin_amdgcn_mfma_f32_16x16x32_bf16(a, b, c, 0, 0, 0); }

__device__ __forceinline__ int col_slot(int c, int mode) {
  if (mode == 0) return 128 * ((c >> 3) & 1) + 32 * (c >> 6) + 16 * ((c >> 2) & 1) + 4 * ((c >> 4) & 3) + (c & 3);
  if (mode == 1) return 128 * ((c >> 5) & 1) + 32 * (c >> 6) + 16 * ((c >> 2) & 1) + 4 * ((c >> 3) & 3) + (c & 3);
  return c;
}

constexpr int BM = 256, BK = 64, HALF = 128, HT = HALF * BK;
__device__ __forceinline__ int lds_byte(int r, int c) {
  int st = (r >> 4) * 2 + (c >> 5), rr = r & 15, cc = c & 31, ob = rr * 64 + cc * 2;
  return st * 1024 + (ob ^ (((ob >> 9) & 1) << 5));
}
__device__ __forceinline__ void stage_rc(int b, int& R, int& C) {
  int st = b / 1024, sb = b % 1024, swz = sb ^ (((sb >> 9) & 1) << 5);
  R = (st >> 1) * 16 + swz / 64; C = (st & 1) * 32 + (swz % 64) / 2;
}

__device__ __forceinline__ bool tile_of(int L, int nM, int nN, int& pm, int& pn) {
  const int nwg = nM * nN; if (L >= nwg) return false;
  int wgid = L; { const int q = nwg / 8, r = nwg % 8, xcd = wgid % 8, off = wgid / 8; wgid = (xcd < r ? xcd * (q + 1) : r * (q + 1) + (xcd - r) * q) + off; }
  const int nig = 8 * nN, gid = wgid / nig, fm = gid * 8, gsz = (nM - fm) < 8 ? (nM - fm) : 8;
  pm = fm + ((wgid % nig) % gsz); pn = (wgid % nig) / gsz; return true;
}
#define LAS __attribute__((address_space(3)))
template <class Epi, bool ALIGN_EPI, bool SP2, bool MID = false>
__device__ __forceinline__ void gemm_phase(const bf16_t* __restrict__ Ag, const bf16_t* __restrict__ Btg, const int M, const int N, const int K, const Epi& E) {
  LAS unsigned char* lds = (LAS unsigned char*)g_shm;
  int tid = threadIdx.x; asm volatile("" : "+v"(tid));
  const int wid = __builtin_amdgcn_readfirstlane(tid >> 6), lane = tid & 63, wr = wid >> 2, wc = wid & 3, fr = lane & 15, fq = lane >> 4;
  const int nt = K / BK, nM = M / BM, nN = N / BM, G = gridDim.x, cu = blockIdx.x;
  constexpr int HTB = HALF * BK * 2;
  unsigned voff[2];
#pragma unroll
  for (int i = 0; i < 2; ++i) { int R, C; stage_rc(tid * 16 + i * 8192, R, C); voff[i] = (unsigned)(R * K + C) * 2u; }
  const size_t kstep = (size_t)(BK * 2), hstep = (size_t)HALF * K * 2, tstep = 2 * hstep;
  const unsigned ldsw = (unsigned)wid * 1024u;
  const int aoff = lds_byte(wr * 64 + fr, fq * 8), boff = lds_byte(wc * 32 + fr, fq * 8);
#define PG8_SA(b, h) (((b) * 2 + (h)) * HTB)
#define PG8_SB(b, h) ((4 + (b) * 2 + (h)) * HTB)
#define PG8_STAGE(bufoff, gbase) do { _Pragma("unroll") for (int _i = 0; _i < 2; ++_i) \
    __builtin_amdgcn_global_load_lds((const __attribute__((address_space(1))) unsigned*)((const char*)(gbase) + voff[_i]), (LAS unsigned*)(lds + (bufoff) + ldsw + _i * 8192), 16, 0, 0); } while (0)
#define PG8_LDA(dst, b, h) do { _Pragma("unroll") for (int m = 0; m < 4; ++m) _Pragma("unroll") for (int k = 0; k < 2; ++k) dst[m][k] = *(const LAS bf16x8*)(lds + PG8_SA(b, h) + aoff + m * 2048 + k * 1024); } while (0)
#define PG8_LDB(dst, b, h) do { _Pragma("unroll") for (int n = 0; n < 2; ++n) _Pragma("unroll") for (int k = 0; k < 2; ++k) dst[n][k] = *(const LAS bf16x8*)(lds + PG8_SB(b, h) + boff + n * 2048 + k * 1024); } while (0)
#define PG8_MMA(ai, bj, At, Bt) do { __builtin_amdgcn_s_setprio(1); _Pragma("unroll") for (int m = 0; m < 4; ++m) _Pragma("unroll") for (int n = 0; n < 2; ++n) _Pragma("unroll") for (int k = 0; k < 2; ++k) \
    acc[ai][bj][m][n] = __builtin_amdgcn_mfma_f32_16x16x32_bf16(Bt[n][k], At[m][k], acc[ai][bj][m][n], 0, 0, 0); __builtin_amdgcn_s_setprio(0); } while (0)
#define PG8_WAIT_V(n) asm volatile("s_waitcnt vmcnt(" #n ")" ::: "memory")
#define PG8_WAIT_L(n) asm volatile("s_waitcnt lgkmcnt(" #n ")" ::: "memory")
#define PG8_BAR __builtin_amdgcn_s_barrier()
#define PG8_SCHED __builtin_amdgcn_sched_barrier(0)
  int cpm, cpn, npm = 0, npn = 0, ui = 0;
  if (!tile_of(cu, nM, nN, cpm, cpn)) return;
  f32x4 acc[2][2][4][2];
#pragma unroll
  for (int a = 0; a < 2; ++a)
#pragma unroll
    for (int b = 0; b < 2; ++b)
#pragma unroll
      for (int m = 0; m < 4; ++m)
#pragma unroll
        for (int n = 0; n < 2; ++n) acc[a][b][m][n] = (f32x4){0.f, 0.f, 0.f, 0.f};
  bf16x8 At[4][2], B0[2][2], B1[2][2];
  const char* cA = (const char*)Ag + (size_t)cpm * tstep; const char* cB = (const char*)Btg + (size_t)cpn * tstep;
  static_assert(SP2, "this body is the two-super-phase loop");
  PG8_STAGE(PG8_SB(0, 0), cB); PG8_STAGE(PG8_SB(0, 1), cB + hstep); PG8_STAGE(PG8_SA(0, 0), cA); PG8_STAGE(PG8_SA(0, 1), cA + hstep);
  PG8_STAGE(PG8_SB(1, 0), cB + kstep); PG8_STAGE(PG8_SA(1, 0), cA + kstep); PG8_STAGE(PG8_SB(1, 1), cB + hstep + kstep);
  if (wr == 1) PG8_BAR;
  PG8_WAIT_V(0); PG8_BAR;
  PG8_BAR;
#define K2_ITER(FIRST) do { \
      const bool last = (t == nt - 2); \
      const char* a1 = cA + (size_t)(t + 1) * kstep; \
      const char* a2 = last ? nA : cA + (size_t)(t + 2) * kstep; const char* b2 = last ? nB : cB + (size_t)(t + 2) * kstep; \
      const char* a3 = a2 + kstep; const char* b3 = b2 + kstep; \
      if constexpr (MID) { if (t == (nt >> 1)) E.mid(acc, cpm * BM); } \
      PG8_LDB(B0, 0, 0); PG8_LDB(B1, 0, 1); PG8_SCHED; PG8_LDA(At, 0, 0); PG8_STAGE(PG8_SA(1, 1), a1 + hstep); \
      if constexpr (!(FIRST)) PG8_WAIT_V(8); \
      PG8_WAIT_L(0); PG8_BAR; PG8_MMA(0, 0, At, B0); PG8_MMA(0, 1, At, B1); PG8_BAR; PG8_SCHED; \
      PG8_LDA(At, 0, 1); PG8_STAGE(PG8_SB(0, 0), b2); PG8_STAGE(PG8_SB(0, 1), b2 + hstep); PG8_STAGE(PG8_SA(0, 0), a2); \
      if constexpr (!(FIRST)) PG8_WAIT_V(8); \
      PG8_WAIT_L(0); PG8_BAR; PG8_MMA(1, 0, At, B0); PG8_MMA(1, 1, At, B1); PG8_BAR; PG8_SCHED; \
      PG8_LDB(B0, 1, 0); PG8_LDB(B1, 1, 1); PG8_SCHED; PG8_LDA(At, 1, 0); PG8_STAGE(PG8_SA(0, 1), a2 + hstep); \
      PG8_WAIT_V(8); PG8_WAIT_L(0); PG8_BAR; PG8_MMA(0, 0, At, B0); PG8_MMA(0, 1, At, B1); PG8_BAR; PG8_SCHED; \
      PG8_LDA(At, 1, 1); PG8_STAGE(PG8_SB(1, 0), b3); PG8_STAGE(PG8_SB(1, 1), b3 + hstep); PG8_STAGE(PG8_SA(1, 0), a3); \
      PG8_WAIT_V(8); PG8_WAIT_L(0); PG8_BAR; PG8_MMA(1, 0, At, B0); PG8_MMA(1, 1, At, B1); PG8_BAR; PG8_SCHED; \
    } while (0)
  for (;;) {
    const bool has_next = tile_of((ui + 1) * G + cu, nM, nN, npm, npn);
    const char* nA = has_next ? (const char*)Ag + (size_t)npm * tstep : cA; const char* nB = has_next ? (const char*)Btg + (size_t)npn * tstep : cB;
    { const int t = 0; K2_ITER(true); }
    for (int t = 2; t < nt; t += 2) K2_ITER(false);
    const typename Epi::Pre pre = E.pre(cpm * BM, cpn * BM);
    if constexpr (ALIGN_EPI) { if (wr == 0) PG8_BAR; }
    PG8_WAIT_V(0);
    E(acc, cpm * BM, cpn * BM, pre);
    if (!has_next) break;
#pragma unroll
    for (int a = 0; a < 2; ++a)
#pragma unroll
      for (int b = 0; b < 2; ++b)
#pragma unroll
        for (int m = 0; m < 4; ++m)
#pragma unroll
          for (int n = 0; n < 2; ++n) acc[a][b][m][n] = (f32x4){0.f, 0.f, 0.f, 0.f};
    cpm = npm; cpn = npn; cA = nA; cB = nB; ++ui;
    if constexpr (ALIGN_EPI) { if (wr == 1) PG8_BAR; }
  }
  PG8_WAIT_V(0);
  if constexpr (!ALIGN_EPI) { if (wr == 0) PG8_BAR; }
  PG8_BAR;
#undef K2_ITER
#undef PG8_SA
#undef PG8_SB
#undef PG8_STAGE
#undef PG8_LDA
#undef PG8_LDB
#undef PG8_MMA
}

#define EPI_IDS \
    int tid_ = threadIdx.x; asm volatile("" : "+v"(tid_));     \
    const int wid_ = tid_ >> 6, lane_ = tid_ & 63, wr = wid_ >> 2, wc = wid_ & 3, fr = lane_ & 15, fq = lane_ >> 4;
#define PACK16(v, w0, w1) \
    w0.x = pk2(v[0], v[1]); w0.y = pk2(v[2], v[3]); w0.z = pk2(v[4], v[5]); w0.w = pk2(v[6], v[7]); \
    w1.x = pk2(v[8], v[9]); w1.y = pk2(v[10], v[11]); w1.z = pk2(v[12], v[13]); w1.w = pk2(v[14], v[15]);

struct EpiQKV {
  bf16_t* qkv; const float* rs1; const float *qna, *kna, *qnb, *knb;
  struct Pre { float rs[8]; float gn[16]; };
  __device__ __forceinline__ Pre pre(int brow, int bcol) const {
    EPI_IDS
    (void)fr;
    Pre r;
    const int ct = bcol >> 8;
    const float* gp = nullptr; float extra = 1.f;
    if (ct < 2) { gp = qna; extra = QSCALE; } else if (ct < 4) gp = kna; else if (ct < 6) gp = nullptr; else if (ct < 8) { gp = qnb; extra = QSCALE; } else gp = (wc < 2) ? knb : nullptr;
#pragma unroll
    for (int i = 0; i < 16; ++i) r.gn[i] = gp ? gp[32 * (i >> 3) + 8 * fq + (i & 7)] * extra : 0.f;
#pragma unroll
    for (int k = 0; k < 8; ++k) r.rs[k] = rs1[brow + (k >> 2) * HALF + wr * 64 + (k & 3) * 16 + fr];
    return r;
  }
  __device__ __forceinline__ void operator()(const f32x4 (&acc)[2][2][4][2], int brow, int bcol, const Pre& pre) const {
    EPI_IDS
    const int ct = bcol >> 8;
    const bool gp = !(ct == 4 || ct == 5 || (ct == 8 && wc >= 2));
    const int smask = (brow < NPROMPT) ? 2047 : 4095;
#pragma unroll
    for (int ai = 0; ai < 2; ++ai)
#pragma unroll
      for (int m = 0; m < 4; ++m) {
        const int row = brow + ai * HALF + wr * 64 + m * 16 + fr;
        const float rs = pre.rs[ai * 4 + m];
        float v[16];
#pragma unroll
        for (int bj = 0; bj < 2; ++bj)
#pragma unroll
          for (int n = 0; n < 2; ++n)
#pragma unroll
            for (int j = 0; j < 4; ++j) v[8 * bj + 4 * n + j] = acc[ai][bj][m][n][j] * rs;
        if (gp) {
          float ss = 0.f;
#pragma unroll
          for (int i = 0; i < 16; ++i) ss += v[i] * v[i];
          ss += __shfl_xor(ss, 16); ss += __shfl_xor(ss, 32);
          const float inv = rsqrtf(ss * (1.0f / 64.0f) + EPS);
#pragma unroll
          for (int i = 0; i < 16; ++i) v[i] = v[i] * inv * pre.gn[i];
          {
            const float pos = (float)(row & smask);
            const float sgn = fq == 0 ? -1.0f : 1.0f;
#pragma unroll
            for (int i = 0; i < 8; ++i) {
              const float ci = i == 0 ? 1.5915494309e-01f : i == 1 ? 3.0863763405e-02f : i == 2 ? 5.9851857127e-03f : i == 3 ? 1.1606636412e-03f : i == 4 ? 2.2507907904e-04f : i == 5 ? 4.3647952793e-05f : i == 6 ? 8.4643308082e-06f : 1.6414262628e-06f;
              const float vp = __shfl_xor(v[i], 16);
              const float tr = __builtin_amdgcn_fractf(pos * ci);
              const float c = __builtin_amdgcn_cosf(tr), s = __builtin_amdgcn_sinf(tr);
              const float r = v[i] * c + sgn * (vp * s);
              v[i] = fq < 2 ? r : v[i];
            }
          }
        }
        u32x4 w0, w1; PACK16(v, w0, w1)
        bf16_t* dst = qkv + (size_t)row * INC + bcol + 64 * wc + 8 * fq;
        *(u32x4*)dst = w0; *(u32x4*)(dst + 32) = w1;
      }
  }
};

struct EpiWo {
  const float *xp, *xs; bf16_t* hb; float* ssq2p; const float* ssqh;
  __device__ __forceinline__ void scales(int row, float& sa, float& sb) const {
    const float* sp = ssqh + (size_t)row * 16;
    const f32x4 a = *(const f32x4*)sp, b = *(const f32x4*)(sp + 4), c = *(const f32x4*)(sp + 8), d = *(const f32x4*)(sp + 12);
    sa = rsqrtf((((a[0] + a[1]) + (a[2] + a[3])) + ((b[0] + b[1]) + (b[2] + b[3]))) * (1.0f / 512.0f) + EPS);
    sb = rsqrtf((((c[0] + c[1]) + (c[2] + c[3])) + ((d[0] + d[1]) + (d[2] + d[3]))) * (1.0f / 512.0f) + EPS);
  }
  __device__ __forceinline__ void mid(f32x4 (&acc)[2][2][4][2], int brow) const {
    EPI_IDS
    (void)wc; (void)fq;
#pragma unroll
    for (int ai = 0; ai < 2; ++ai)
#pragma unroll
      for (int m = 0; m < 4; ++m) {
        float sa, sb; scales(brow + ai * HALF + wr * 64 + m * 16 + fr, sa, sb);
        const float ratio = sa / sb;
#pragma unroll
        for (int bj = 0; bj < 2; ++bj)
#pragma unroll
          for (int n = 0; n < 2; ++n) acc[ai][bj][m][n] = acc[ai][bj][m][n] * ratio;
      }
  }
  struct Pre { f32x4 xv0[4][4]; };
  __device__ __forceinline__ Pre pre(int brow, int bcol) const {
    EPI_IDS
    Pre r;
    const float* xbase = (brow < NPROMPT) ? (xp + (size_t)brow * DM) : (xs + (size_t)(brow - NPROMPT) * DM);
#pragma unroll
    for (int m = 0; m < 4; ++m) {
      const float* xr = xbase + (size_t)(wr * 64 + m * 16 + fr) * DM + bcol + 64 * wc + 8 * fq;
#pragma unroll
      for (int q = 0; q < 4; ++q) r.xv0[m][q] = *(const f32x4*)(xr + 32 * (q >> 1) + 4 * (q & 1));
    }
    return r;
  }
  __device__ __forceinline__ void operator()(const f32x4 (&acc)[2][2][4][2], int brow, int bcol, const Pre& pre) const {
    EPI_IDS
    const float* xbase = (brow < NPROMPT) ? (xp + (size_t)brow * DM) : (xs + (size_t)(brow - NPROMPT) * DM);
#pragma unroll
    for (int ai = 0; ai < 2; ++ai) {
      f32x4 xv[4][4]; float sbv[4];
#pragma unroll
      for (int m = 0; m < 4; ++m) {
        const int rl = ai * HALF + wr * 64 + m * 16 + fr;
        const float* xr = xbase + (size_t)rl * DM + bcol + 64 * wc + 8 * fq;
#pragma unroll
        for (int q = 0; q < 4; ++q) xv[m][q] = ai == 0 ? pre.xv0[m][q] : *(const f32x4*)(xr + 32 * (q >> 1) + 4 * (q & 1));
        float sa; scales(brow + rl, sa, sbv[m]);
      }
#pragma unroll
      for (int m = 0; m < 4; ++m) {
        const int rl = ai * HALF + wr * 64 + m * 16 + fr;
        float v[16]; float ss = 0.f;
#pragma unroll
        for (int bj = 0; bj < 2; ++bj)
#pragma unroll
          for (int n = 0; n < 2; ++n)
#pragma unroll
            for (int j = 0; j < 4; ++j) { const float h = xv[m][2 * bj + n][j] + acc[ai][bj][m][n][j] * sbv[m]; v[8 * bj + 4 * n + j] = h; ss += h * h; }
        ss += __shfl_xor(ss, 16); ss += __shfl_xor(ss, 32);
        if (fq == 0) ssq2p[(size_t)(brow + rl) * 16 + (bcol >> 8) * 4 + wc] = ss;
        u32x4 w0, w1; PACK16(v, w0, w1)
        bf16_t* dst = hb + (size_t)(brow + rl) * DM + bcol + 64 * wc + 8 * fq;
        *(u32x4*)dst = w0; *(u32x4*)(dst + 32) = w1;
      }
      __builtin_amdgcn_sched_barrier(0);
    }
  }
};

struct EpiUp {
  bf16_t* u; const float* s2; int row_base;
  struct Pre { float s2v[8]; };
  __device__ __forceinline__ Pre pre(int brow, int) const {
    EPI_IDS
    (void)wc; (void)fq;
    Pre r;
#pragma unroll
    for (int k = 0; k < 8; ++k) r.s2v[k] = s2[row_base + brow + (k >> 2) * HALF + wr * 64 + (k & 3) * 16 + fr];
    return r;
  }
  __device__ __forceinline__ void operator()(const f32x4 (&acc)[2][2][4][2], int brow, int bcol, const Pre& pre) const {
    EPI_IDS
#pragma unroll
    for (int ai = 0; ai < 2; ++ai)
#pragma unroll
      for (int m = 0; m < 4; ++m) {
        const int rl = brow + ai * HALF + wr * 64 + m * 16 + fr;
        const float s2r = pre.s2v[ai * 4 + m];
        float v[16];
#pragma unroll
        for (int bj = 0; bj < 2; ++bj)
#pragma unroll
          for (int n = 0; n < 2; ++n)
#pragma unroll
            for (int j = 0; j < 4; ++j) { const float z = fmaxf(acc[ai][bj][m][n][j] * s2r, 0.f); v[8 * bj + 4 * n + j] = z * z; }
        u32x4 w0, w1; PACK16(v, w0, w1)
        bf16_t* dst = u + (size_t)rl * DFF + bcol + 64 * wc + 8 * fq;
        *(u32x4*)dst = w0; *(u32x4*)(dst + 32) = w1;
      }
  }
};

struct EpiDown {
  const bf16_t* hb; float* out; int row_base;
  struct Pre { u32x2 hv[2][4][2][2]; };
  __device__ __forceinline__ Pre pre(int brow, int bcol) const {
    EPI_IDS
    Pre r;
#pragma unroll
    for (int ai = 0; ai < 2; ++ai)
#pragma unroll
      for (int m = 0; m < 4; ++m) {
        const size_t off = (size_t)(row_base + brow + ai * HALF + wr * 64 + m * 16 + fr) * DM + bcol + 32 * wc + 4 * fq;
#pragma unroll
        for (int bj = 0; bj < 2; ++bj)
#pragma unroll
          for (int n = 0; n < 2; ++n) r.hv[ai][m][bj][n] = *(const u32x2*)(hb + off + 128 * bj + 16 * n);
      }
    return r;
  }
  __device__ __forceinline__ void operator()(const f32x4 (&acc)[2][2][4][2], int brow, int bcol, const Pre& pre) const {
    EPI_IDS
#pragma unroll
    for (int ai = 0; ai < 2; ++ai)
#pragma unroll
      for (int m = 0; m < 4; ++m) {
        const size_t off = (size_t)(row_base + brow + ai * HALF + wr * 64 + m * 16 + fr) * DM + bcol + 32 * wc + 4 * fq;
        float* dst = out + off;
#pragma unroll
        for (int bj = 0; bj < 2; ++bj)
#pragma unroll
          for (int n = 0; n < 2; ++n) {
            const unsigned a = pre.hv[ai][m][bj][n].x, b = pre.hv[ai][m][bj][n].y;
            f32x4 o;
            o[0] = __uint_as_float(a << 16) + acc[ai][bj][m][n][0]; o[1] = __uint_as_float(a & 0xffff0000u) + acc[ai][bj][m][n][1];
            o[2] = __uint_as_float(b << 16) + acc[ai][bj][m][n][2]; o[3] = __uint_as_float(b & 0xffff0000u) + acc[ai][bj][m][n][3];
            *(f32x4*)(dst + 128 * bj + 16 * n) = o;
          }
      }
  }
};

__device__ __forceinline__ void p0_transpose_item(const float* __restrict__ W, int K, int N, bf16_t* __restrict__ WT, const float* __restrict__ g0, const float* __restrict__ g1, float* scr, int item, int lane, int mode) {
  const int nblk = N / 32, kb = item / nblk, nb = item % nblk, k0 = 64 * kb, n0 = 32 * nb;
#pragma unroll 8
  for (int i = 0; i < 32; ++i) {
    const int kk = 2 * i + (lane >> 5), k = k0 + kk;
    float gv = 1.f; if (g0) gv = (g1 && k >= 512) ? g1[k - 512] : g0[k];
    scr[kk * 33 + (lane & 31)] = W[(size_t)k * N + n0 + (lane & 31)] * gv;
  }
  asm volatile("s_waitcnt lgkmcnt(0)" ::: "memory");
  const int c = lane & 7;
#pragma unroll
  for (int j = 0; j < 4; ++j) {
    const int n = (lane >> 3) + 8 * j; const float* s = scr + (8 * c) * 33 + n;
    u32x4 o; o.x = pk2(s[0 * 33], s[1 * 33]); o.y = pk2(s[2 * 33], s[3 * 33]); o.z = pk2(s[4 * 33], s[5 * 33]); o.w = pk2(s[6 * 33], s[7 * 33]);
    const int col = n0 + n, drow = (col & ~255) + col_slot(col & 255, mode);
    *(u32x4*)(WT + (size_t)drow * K + k0 + 8 * c) = o;
  }
  asm volatile("s_waitcnt lgkmcnt(0)" ::: "memory");
}

__device__ __forceinline__ void p0_prologue(const Params& p) {
  int tid = threadIdx.x; asm volatile("" : "+v"(tid));
  const int wave = tid >> 6, lane = tid & 63;
  const int gw = blockIdx.x * 8 + wave, NGW = gridDim.x * 8;
  float* scr = (float*)(g_shm + wave * 16384);
  bf16_t* WinT = (bf16_t*)(p.ws + WS_WIN); bf16_t* WoT = (bf16_t*)(p.ws + WS_WO); bf16_t* WupT = (bf16_t*)(p.ws + WS_WUP); bf16_t* WdT = (bf16_t*)(p.ws + WS_WD);
  constexpr int I_IN = 16 * 72, I_O = 16 * 32, I_UP = 16 * 128, I_DN = 64 * 32, NIT = I_IN + I_O + I_UP + I_DN;
  for (int it = gw; it < NIT; it += NGW) {
    int r = it;
    if (r < I_IN) { p0_transpose_item(p.w_in, DM, INC, WinT, p.norm_attn, nullptr, scr, r, lane, 1); continue; } r -= I_IN;
    if (r < I_O) { p0_transpose_item(p.w_o, DM, DM, WoT, p.ona, p.onb, scr, r, lane, 1); continue; } r -= I_O;
    if (r < I_UP) { p0_transpose_item(p.w_up, DM, DFF, WupT, p.norm_mlp, nullptr, scr, r, lane, 1); continue; } r -= I_UP;
    p0_transpose_item(p.w_down, DFF, DM, WdT, nullptr, nullptr, scr, r, lane, 2);
  }
  bf16_t* xb = (bf16_t*)(p.ws + WS_X); float* rs1 = (float*)(p.ws + WS_RS1);
  for (int row4 = gw * 4; row4 < NTOK; row4 += NGW * 4) {
    f32x4 v[4][4];
#pragma unroll
    for (int r = 0; r < 4; ++r) {
      const int row = row4 + r;
      const float* xr = (row < NPROMPT) ? (p.xp + (size_t)row * DM) : (p.xs + (size_t)(row - NPROMPT) * DM);
#pragma unroll
      for (int j = 0; j < 4; ++j) v[r][j] = *(const f32x4*)(xr + 256 * j + 4 * lane);
    }
#pragma unroll
    for (int r = 0; r < 4; ++r) {
      const int row = row4 + r; float s = 0.f;
#pragma unroll
      for (int j = 0; j < 4; ++j) s += (v[r][j][0] * v[r][j][0] + v[r][j][1] * v[r][j][1]) + (v[r][j][2] * v[r][j][2] + v[r][j][3] * v[r][j][3]);
#pragma unroll
      for (int o = 1; o < 64; o <<= 1) s += __shfl_xor(s, o);
#pragma unroll
      for (int j = 0; j < 4; ++j) { u32x2 w; w.x = pk2(v[r][j][0], v[r][j][1]); w.y = pk2(v[r][j][2], v[r][j][3]); *(u32x2*)(xb + (size_t)row * DM + 256 * j + 4 * lane) = w; }
      if (lane == 0) rs1[row] = rsqrtf(s * (1.0f / DM) + EPS);
    }
  }
}

struct ChunkSrc { int rowc, d, M, kc0; };

__device__ __forceinline__ void issue_chunk(const bf16_t* __restrict__ qkv, const ChunkSrc cs, int koff, int voff, int lane, unsigned char* slot) {
  const unsigned ck = (unsigned)(koff * 2), cv = (unsigned)(voff * 2);
#pragma unroll
  for (int i = 0; i < 4; ++i) {
    const int r = (lane >> 3) + 8 * i;
    int kc = cs.kc0 + r; kc = kc < 0 ? 0 : (kc > cs.M - 1 ? cs.M - 1 : kc);
    const unsigned row = __umul24((unsigned)cs.d, (unsigned)kc) + (unsigned)cs.rowc;
    const unsigned rb = __umul24(row, (unsigned)(INC * 2));
    const unsigned chk = (unsigned)(((lane & 7) ^ ((r >> 1) & 7)) << 4), chv = (unsigned)(((lane & 7) ^ (((r >> 1) & 3) << 1)) << 4);
    __builtin_amdgcn_global_load_lds((const __attribute__((address_space(1))) unsigned*)((const char*)qkv + (rb + (ck + chk))), (LAS unsigned*)(slot + i * 1024), 16, 0, 0);
    __builtin_amdgcn_global_load_lds((const __attribute__((address_space(1))) unsigned*)((const char*)qkv + (rb + (cv + chv))), (LAS unsigned*)(slot + 4096 + i * 1024), 16, 0, 0);
  }
}
__device__ __forceinline__ void read_vt(unsigned a0, unsigned a1, unsigned a2, unsigned a3, bf16x8 (&Vt)[4]) {
  u32x2 r00, r01, r10, r11, r20, r21, r30, r31;
  asm volatile(
      "ds_read_b64_tr_b16 %0, %8\n\tds_read_b64_tr_b16 %1, %8 offset:2048\n\t"
      "ds_read_b64_tr_b16 %2, %9\n\tds_read_b64_tr_b16 %3, %9 offset:2048\n\t"
      "ds_read_b64_tr_b16 %4, %10\n\tds_read_b64_tr_b16 %5, %10 offset:2048\n\t"
      "ds_read_b64_tr_b16 %6, %11\n\tds_read_b64_tr_b16 %7, %11 offset:2048\n\t"
      "s_waitcnt lgkmcnt(0)"
      : "=&v"(r00), "=&v"(r01), "=&v"(r10), "=&v"(r11), "=&v"(r20), "=&v"(r21), "=&v"(r30), "=&v"(r31)
      : "v"(a0), "v"(a1), "v"(a2), "v"(a3) : "memory");
  u32x4 t;
  t.x = r00.x; t.y = r00.y; t.z = r01.x; t.w = r01.y; Vt[0] = __builtin_bit_cast(bf16x8, t);
  t.x = r10.x; t.y = r10.y; t.z = r11.x; t.w = r11.y; Vt[1] = __builtin_bit_cast(bf16x8, t);
  t.x = r20.x; t.y = r20.y; t.z = r21.x; t.w = r21.y; Vt[2] = __builtin_bit_cast(bf16x8, t);
  t.x = r30.x; t.y = r30.y; t.z = r31.x; t.w = r31.y; Vt[3] = __builtin_bit_cast(bf16x8, t);
}
__device__ __forceinline__ void tile_chunk(const bf16x8 (&Kf)[2][2], const bf16x8 (&Q)[2], const bf16x8 (&Vt)[4], f32x4 (&o)[4], float& l, int kcl, int lo, unsigned span, float negm) {
  f32x4 s0 = {negm, negm, negm, negm}, s1 = s0;
  s0 = mfma16(Kf[0][0], Q[0], s0); s0 = mfma16(Kf[0][1], Q[1], s0);
  s1 = mfma16(Kf[1][0], Q[0], s1); s1 = mfma16(Kf[1][1], Q[1], s1);
  float pv[8]; float sum = 0.f;
#pragma unroll
  for (int j = 0; j < 4; ++j) {
    pv[j] = ((unsigned)(kcl + j - lo) <= span) ? __builtin_amdgcn_exp2f(s0[j]) : 0.f;
    pv[4 + j] = ((unsigned)(kcl + 16 + j - lo) <= span) ? __builtin_amdgcn_exp2f(s1[j]) : 0.f;
    sum += pv[j] + pv[4 + j];
  }
  l += sum;
  u32x4 pk; pk.x = pk2(pv[0], pv[1]); pk.y = pk2(pv[2], pv[3]); pk.z = pk2(pv[4], pv[5]); pk.w = pk2(pv[6], pv[7]);
  const bf16x8 P = __builtin_bit_cast(bf16x8, pk);
#pragma unroll
  for (int dt = 0; dt < 4; ++dt) o[dt] = mfma16(Vt[dt], P, o[dt]);
}

template <int TMASK, class DESC>
__device__ __forceinline__ void run_branch(const bf16_t* __restrict__ qkv, const DESC& desc, int& gi, const int total, const int nchunks, const int M, const int kstart, int koff, int voff,
                                           int qcb, int qstep, int hw, float negm, int lane, unsigned char* ring, const bf16x8 (&Q)[4][2], f32x4 (&o)[4][4], float (&l)[4]) {
  const int g = lane >> 4;
  int lo[4]; unsigned span[4];
#pragma unroll
  for (int t = 0; t < 4; ++t) { const int qc = qcb + t * qstep; lo[t] = qc - hw < 0 ? 0 : qc - hw; const int hi = qc + hw > M - 1 ? M - 1 : qc + hw; span[t] = (unsigned)(hi - lo[t]); }
  const int qp = (lane & 15) >> 2, pp = lane & 3, rl = 4 * g + qp, f = (rl >> 1) & 3;
  const unsigned vbase = (unsigned)(size_t)ring + 4096 + rl * 128 + pp * 8;
  const unsigned a0 = vbase + ((0 ^ f) << 5), a1 = vbase + ((1 ^ f) << 5), a2 = vbase + ((2 ^ f) << 5), a3 = vbase + ((3 ^ f) << 5);
  const int krow = lane & 15;
  const LAS unsigned char* kb0 = (const LAS unsigned char*)ring + krow * 128 + (((0 + g) ^ (krow >> 1)) << 4);
  const LAS unsigned char* kb1 = (const LAS unsigned char*)ring + krow * 128 + (((4 + g) ^ (krow >> 1)) << 4);
#pragma unroll 1
  for (int c = 0; c < nchunks; ++c, ++gi) {
    const unsigned soff = (unsigned)(gi & (ATT_SLOTS - 1)) * 8192u;
    bf16x8 Kf[2][2];
    if constexpr (ATT_LA == 1) {
      asm volatile("s_waitcnt vmcnt(0)" ::: "memory");
      Kf[0][0] = *(const LAS bf16x8*)(kb0 + soff); Kf[0][1] = *(const LAS bf16x8*)(kb1 + soff);
      Kf[1][0] = *(const LAS bf16x8*)(kb0 + soff + 2048); Kf[1][1] = *(const LAS bf16x8*)(kb1 + soff + 2048);
      if (gi + 1 < total) issue_chunk(qkv, desc(gi + 1), koff, voff, lane, ring + ((gi + 1) & 1) * 8192);
    } else {
      if (gi + ATT_LA < total) issue_chunk(qkv, desc(gi + ATT_LA), koff, voff, lane, ring + ((gi + ATT_LA) & (ATT_SLOTS - 1)) * 8192);
      const int rem = total - 1 - gi;
      if (ATT_LA >= 3 && rem >= 3) asm volatile("s_waitcnt vmcnt(24)" ::: "memory");
      else if (ATT_LA >= 2 && rem >= 2) asm volatile("s_waitcnt vmcnt(16)" ::: "memory");
      else if (rem >= 1) asm volatile("s_waitcnt vmcnt(8)" ::: "memory");
      else asm volatile("s_waitcnt vmcnt(0)" ::: "memory");
      Kf[0][0] = *(const LAS bf16x8*)(kb0 + soff); Kf[0][1] = *(const LAS bf16x8*)(kb1 + soff);
      Kf[1][0] = *(const LAS bf16x8*)(kb0 + soff + 2048); Kf[1][1] = *(const LAS bf16x8*)(kb1 + soff + 2048);
    }
    bf16x8 Vt[4];
    read_vt(a0 + soff, a1 + soff, a2 + soff, a3 + soff, Vt);
    const int kcl = kstart + 32 * c + 4 * g;
#pragma unroll
    for (int t = 0; t < 4; ++t)
      if (TMASK & (1 << t)) tile_chunk(Kf, Q[t], Vt, o[t], l[t], kcl, lo[t], span[t], negm);
  }
}

__device__ __forceinline__ float wave_max(float v) {
#pragma unroll
  for (int o = 1; o < 64; o <<= 1) v = fmaxf(v, __shfl_xor(v, o));
  return v;
}

__device__ __forceinline__ void attn_phase(const Params& p) {
  int tid = threadIdx.x; asm volatile("" : "+v"(tid));
  const int wave = __builtin_amdgcn_readfirstlane(tid >> 6), lane = tid & 63, qi = lane & 15, g = lane >> 4;
  if (wave >= ATT_NACT) return;
  const bf16_t* qkv = (const bf16_t*)(p.ws + WS_QKV);
  bf16_t* mix = (bf16_t*)(p.ws + WS_X);
  float* ssqh = (float*)(p.ws + WS_SSQH);
  unsigned char* ring = g_shm + wave * (ATT_SLOTS * 8192);
  const float mfixA = 8.0f * LOG2E * wave_max(fabsf(p.qna[lane])) * wave_max(fabsf(p.kna[lane]));
  const float mfixB = 8.0f * LOG2E * wave_max(fabsf(p.qnb[lane])) * wave_max(fabsf(p.knb[lane]));
  const int xcd = blockIdx.x & 7, wx = (blockIdx.x >> 3) * ATT_NACT + wave, nwx = (gridDim.x >> 3) * ATT_NACT;
  for (int li = wx; li < 2048; li += nwx) {
    const int kind = (li / nwx) & 1;
    const int lk = ((li / nwx) >> 1) * nwx + (li % nwx);
    const int grp = xcd * 128 + (lk & 127), sub = lk >> 7;
    const int r64 = grp * 64;
    const int S = r64 < NPROMPT ? 2048 : 4096;
    const int row0 = r64 & ~(S - 1);
    bf16x8 Q[4][2]; f32x4 o[4][4]; float l[4];
#pragma unroll
    for (int t = 0; t < 4; ++t) {
#pragma unroll
      for (int dt = 0; dt < 4; ++dt) o[t][dt] = (f32x4){0.f, 0.f, 0.f, 0.f};
    }
    int tok[4], colb[4];
    int gi = 0;
    if (kind == 0) {
      const int sidx = (r64 - row0) >> 6, c4 = sidx & 3, p0 = (sidx >> 2) * 16, h = sub;
#pragma unroll
      for (int t = 0; t < 4; ++t) {
        tok[t] = 16 * (p0 + qi) + c4 + 4 * t; colb[t] = h * 64; l[t] = 0.f;
        const bf16_t* rp = qkv + (size_t)(row0 + tok[t]) * INC + h * 64 + g * 8;
        Q[t][0] = *(const bf16x8*)rp; Q[t][1] = *(const bf16x8*)(rp + 32);
      }
      const int koff = 512 + h * 64, voff = 1024 + h * 64;
      auto desc = [=](int i) -> ChunkSrc {
        ChunkSrc r;
        if (i < 12) { r.rowc = row0; r.d = 1; r.M = S; r.kc0 = 16 * p0 - 64 + 32 * i; }
        else if (i < 18) { r.rowc = row0 + c4; r.d = 4; r.M = S >> 2; r.kc0 = 4 * p0 - 64 + 32 * (i - 12); }
        else { const int j = i - 18, t = j / 5, c = j - 5 * t; r.rowc = row0 + c4 + 4 * t; r.d = 16; r.M = S >> 4; r.kc0 = p0 - 64 + 32 * c; }
        return r;
      };
      constexpr int TOTAL = 38;
#pragma unroll
      for (int i = 0; i < ATT_LA; ++i) issue_chunk(qkv, desc(i), koff, voff, lane, ring + i * 8192);
      run_branch<15>(qkv, desc, gi, TOTAL, 12, S, 16 * p0 - 64, koff, voff, 16 * (p0 + qi) + c4, 4, 64, -mfixA, lane, ring, Q, o, l);
      run_branch<15>(qkv, desc, gi, TOTAL, 6, S >> 2, 4 * p0 - 64, koff, voff, 4 * (p0 + qi), 1, 64, -mfixA, lane, ring, Q, o, l);
      run_branch<1>(qkv, desc, gi, TOTAL, 5, S >> 4, p0 - 64, koff, voff, p0 + qi, 0, 64, -mfixA, lane, ring, Q, o, l);
      run_branch<2>(qkv, desc, gi, TOTAL, 5, S >> 4, p0 - 64, koff, voff, p0 + qi, 0, 64, -mfixA, lane, ring, Q, o, l);
      run_branch<4>(qkv, desc, gi, TOTAL, 5, S >> 4, p0 - 64, koff, voff, p0 + qi, 0, 64, -mfixA, lane, ring, Q, o, l);
      run_branch<8>(qkv, desc, gi, TOTAL, 5, S >> 4, p0 - 64, koff, voff, p0 + qi, 0, 64, -mfixA, lane, ring, Q, o, l);
    } else {
      const int kvh = sub & 1, qsub = sub >> 1, q0 = (r64 - row0) + 16 * qsub;
#pragma unroll
      for (int t = 0; t < 4; ++t) {
        const int hq = kvh * 4 + t;
        tok[t] = q0 + qi; colb[t] = 512 + hq * 64;
        l[t] = (g == 0) ? __builtin_amdgcn_exp2f(p.sink[hq] * LOG2E - mfixB) : 0.f;
        const bf16_t* rp = qkv + (size_t)(row0 + tok[t]) * INC + 1536 + hq * 64 + g * 8;
        Q[t][0] = *(const bf16x8*)rp; Q[t][1] = *(const bf16x8*)(rp + 32);
      }
      const int koff = 2048 + kvh * 64, voff = 2176 + kvh * 64;
      auto desc = [=](int i) -> ChunkSrc { ChunkSrc r; r.rowc = row0; r.d = 1; r.M = S; r.kc0 = q0 - 128 + 32 * i; return r; };
      constexpr int TOTAL = 9;
#pragma unroll
      for (int i = 0; i < ATT_LA; ++i) issue_chunk(qkv, desc(i), koff, voff, lane, ring + i * 8192);
      run_branch<15>(qkv, desc, gi, TOTAL, 9, S, q0 - 128, koff, voff, q0 + qi, 0, 128, -mfixB, lane, ring, Q, o, l);
    }
#pragma unroll
    for (int t = 0; t < 4; ++t) {
      float L = l[t]; L += __shfl_xor(L, 16); L += __shfl_xor(L, 32);
      const float inv = 1.0f / L; float ss = 0.f;
#pragma unroll
      for (int dt = 0; dt < 4; ++dt)
#pragma unroll
        for (int j = 0; j < 4; ++j) { const float x = o[t][dt][j] * inv; o[t][dt][j] = x; ss += x * x; }
      ss += __shfl_xor(ss, 16); ss += __shfl_xor(ss, 32);
      const size_t row = (size_t)(row0 + tok[t]);
      if (g == 0) ssqh[row * 16 + (colb[t] >> 6)] = ss;
      bf16_t* dst = mix + row * DM + colb[t] + 4 * g;
#pragma unroll
      for (int dt = 0; dt < 4; ++dt) { u32x2 w; w.x = pk2(o[t][dt][0], o[t][dt][1]); w.y = pk2(o[t][dt][2], o[t][dt][3]); *(u32x2*)(dst + 16 * dt) = w; }
    }
  }
}

#define XB_TMO      128
#define XB_XCNT(j)  (256  + 64 * (j))
#define XB_XSUB(j)  (1280 + 64 * (j))
#define XB_XGEN(j)  (2304 + 64 * (j))
#define XB_TOP      3328
#define XB_TOPGEN   3392
#define XCD_BAR_WORDS 3456
#define XB_SPIN_CAP (1u << 18)
__device__ __forceinline__ unsigned xb_ld(unsigned* p)              { return __hip_atomic_load(p, __ATOMIC_RELAXED, __HIP_MEMORY_SCOPE_AGENT); }
__device__ __forceinline__ unsigned xb_add(unsigned* p, unsigned v) { return __hip_atomic_fetch_add(p, v, __ATOMIC_RELAXED, __HIP_MEMORY_SCOPE_AGENT); }
__device__ __forceinline__ unsigned xb_xcc_id() { return (unsigned)__builtin_amdgcn_s_getreg((3 << 11) | 20) & 0xFu; }
#define XB_SPIN(cond, bar) do { unsigned _sp = 0; while (cond) { __builtin_amdgcn_s_sleep(1); \
    if ((++_sp & 255u) == 0u) { if (xb_ld(&(bar)[XB_TMO])) break; if (_sp > XB_SPIN_CAP) { atomicAdd(&(bar)[XB_TMO], 1u); break; } } } } while (0)
struct XcdBarrier { unsigned* bar; unsigned x; volatile LAS unsigned* st; };
__device__ __forceinline__ XcdBarrier xcd_barrier_post(unsigned* bar, volatile LAS unsigned* st) {
  XcdBarrier b; b.bar = bar; b.x = xb_xcc_id(); b.st = st;
  if (threadIdx.x == 0) (void)xb_add(&bar[XB_XCNT(b.x)], 1u);
  return b;
}
__device__ __forceinline__ void xcd_barrier_complete(unsigned* bar, unsigned x, unsigned& nloc, unsigned& nx) {
  const unsigned G = gridDim.x * gridDim.y * gridDim.z;
  unsigned sum, cnt, mine, sp = 0u;
  for (;;) {
    sum = 0u; cnt = 0u; mine = 0u;
#pragma unroll
    for (unsigned j = 0; j < 16; ++j) { const unsigned c = xb_ld(&bar[XB_XCNT(j)]); sum += c; cnt += (c > 0u) ? 1u : 0u; mine = (j == x) ? c : mine; }
    if (sum == G) break;
    __builtin_amdgcn_s_sleep(1);
    if ((++sp & 255u) == 0u) { if (xb_ld(&bar[XB_TMO])) break; if (sp > XB_SPIN_CAP) { atomicAdd(&bar[XB_TMO], 1u); break; } }
  }
  nloc = mine > 0u ? mine : 1u; nx = cnt > 0u ? cnt : 1u;
}
__device__ __forceinline__ void xcd_barrier_impl(const XcdBarrier& b) {
  asm volatile("s_waitcnt vmcnt(0)" ::: "memory");
  __syncthreads();
  if (threadIdx.x == 0) {
    unsigned* bar = b.bar;
    __builtin_amdgcn_s_waitcnt(0);
    unsigned nloc = b.st[0], nx = b.st[1];
    if (nloc == 0u) { xcd_barrier_complete(bar, b.x, nloc, nx); b.st[0] = nloc; b.st[1] = nx; }
    const unsigned old = xb_add(&bar[XB_XSUB(b.x)], 1u);
    const unsigned gen = old / nloc;
    if (old + 1u == (gen + 1u) * nloc) {
      __builtin_amdgcn_fence(__ATOMIC_RELEASE, "agent");
      asm volatile("s_waitcnt vmcnt(0)" ::: "memory");
      const unsigned og = xb_add(&bar[XB_TOP], 1u);
      const unsigned tg = og / nx;
      if (og + 1u == (tg + 1u) * nx) xb_add(&bar[XB_TOPGEN], 1u);
      else XB_SPIN(xb_ld(&bar[XB_TOPGEN]) == tg, bar);
      __builtin_amdgcn_fence(__ATOMIC_ACQUIRE, "agent");
      xb_add(&bar[XB_XGEN(b.x)], 1u);
      asm volatile("s_waitcnt vmcnt(0)" ::: "memory");
    } else {
      XB_SPIN(xb_ld(&bar[XB_XGEN(b.x)]) == gen, bar);
      __builtin_amdgcn_fence(__ATOMIC_ACQUIRE, "agent");
      asm volatile("s_waitcnt vmcnt(0)" ::: "memory");
    }
  }
  __syncthreads();
}

__device__ __forceinline__ void xcd_barrier(unsigned char* ws) {
  XcdBarrier b; b.bar = (unsigned*)(ws + WS_BAR); b.x = xb_xcc_id(); b.st = (volatile LAS unsigned*)((LAS unsigned char*)g_shm + GEMM_LDS_BYTES);
  xcd_barrier_impl(b);
}

typedef const __attribute__((address_space(4))) Params* KArgs;
__device__ __forceinline__ Params load_params() {
#if defined(__HIP_DEVICE_COMPILE__)
  KArgs kp = (KArgs)__builtin_amdgcn_kernarg_segment_ptr();
  asm volatile("" : "+s"(kp));
  Params r;
  r.xp = kp->xp; r.xs = kp->xs; r.norm_attn = kp->norm_attn; r.w_in = kp->w_in; r.qna = kp->qna; r.kna = kp->kna; r.qnb = kp->qnb; r.knb = kp->knb; r.sink = kp->sink;
  r.ona = kp->ona; r.onb = kp->onb; r.w_o = kp->w_o; r.norm_mlp = kp->norm_mlp; r.w_up = kp->w_up; r.w_down = kp->w_down; r.out = kp->out; r.ws = kp->ws;
  return r;
#else
  return Params{};
#endif
}

__global__ void __launch_bounds__(512) fwd_megakernel(Params p_unused) {
  cg::grid_group grid = cg::this_grid();
  {
    const Params p = load_params();
    volatile LAS unsigned* xst = (volatile LAS unsigned*)((LAS unsigned char*)g_shm + GEMM_LDS_BYTES);
    if (threadIdx.x == 0) { xst[0] = 0u; xst[1] = 0u; }
    (void)xcd_barrier_post((unsigned*)(p.ws + WS_BAR), xst);
    p0_prologue(p);
    if (p.ws == nullptr) grid.sync();
    xcd_barrier(p.ws);
  }
  {
    const Params p = load_params();
    EpiQKV e{(bf16_t*)(p.ws + WS_QKV), (const float*)(p.ws + WS_RS1), p.qna, p.kna, p.qnb, p.knb};
    gemm_phase<EpiQKV, GEMM_ALIGN, GEMM_SP2>((const bf16_t*)(p.ws + WS_X), (const bf16_t*)(p.ws + WS_WIN), NTOK, INC, DM, e);
    xcd_barrier(p.ws);
  }
  {
    const Params p = load_params();
    attn_phase(p);
    xcd_barrier(p.ws);
  }
  {
    const Params p = load_params();
    EpiWo e{p.xp, p.xs, (bf16_t*)(p.ws + WS_HB), (float*)(p.ws + WS_SSQ2), (const float*)(p.ws + WS_SSQH)};
    gemm_phase<EpiWo, GEMM_ALIGN, GEMM_SP2, true>((const bf16_t*)(p.ws + WS_X), (const bf16_t*)(p.ws + WS_WO), NTOK, DM, DM, e);
    xcd_barrier(p.ws);
    { const float* sp = (const float*)(p.ws + WS_SSQ2); float* s2 = (float*)(p.ws + WS_RS1);
      for (int row = blockIdx.x * 512 + threadIdx.x; row < NTOK; row += gridDim.x * 512) {
        const f32x4 a = *(const f32x4*)(sp + (size_t)row * 16), b = *(const f32x4*)(sp + (size_t)row * 16 + 4), c = *(const f32x4*)(sp + (size_t)row * 16 + 8), d = *(const f32x4*)(sp + (size_t)row * 16 + 12);
        const float tot = (((a[0] + a[1]) + (a[2] + a[3])) + ((b[0] + b[1]) + (b[2] + b[3]))) + (((c[0] + c[1]) + (c[2] + c[3])) + ((d[0] + d[1]) + (d[2] + d[3])));
        s2[row] = rsqrtf(tot * (1.0f / DM) + EPS);
      } }
    xcd_barrier(p.ws);
  }
  for (int half = 0; half < 2; ++half) {
    const int rb = half * NPROMPT;
    {
      const Params p = load_params();
      EpiUp e{(bf16_t*)(p.ws + WS_U), (const float*)(p.ws + WS_RS1), rb};
      gemm_phase<EpiUp, GEMM_ALIGN, GEMM_SP2>((const bf16_t*)(p.ws + WS_HB) + (size_t)rb * DM, (const bf16_t*)(p.ws + WS_WUP), NPROMPT, DFF, DM, e);
      xcd_barrier(p.ws);
    }
    {
      const Params p = load_params();
      EpiDown e{(const bf16_t*)(p.ws + WS_HB), p.out, rb};
      gemm_phase<EpiDown, GEMM_ALIGN, GEMM_SP2>((const bf16_t*)(p.ws + WS_U), (const bf16_t*)(p.ws + WS_WD), NPROMPT, DM, DFF, e);
      if (half == 0) xcd_barrier(p.ws);
    }
  }
}

extern "C" void kernel_launch(void* const* d_in, const int* in_sizes, int n_in, void* d_out, int out_size, void* d_ws, size_t ws_size, hipStream_t stream) {
  static int grid_blocks = 0;
  if (!grid_blocks) {
    if (n_in != 15 || ws_size < WS_NEED) { fprintf(stderr, "kernel_launch: unexpected n_in %d / ws_size %zu\n", n_in, ws_size); grid_blocks = -1; return; }
    int dev = 0, cus = 0, per_cu = 0;
    hipGetDevice(&dev);
    hipDeviceGetAttribute(&cus, hipDeviceAttributeMultiprocessorCount, dev);
    if (hipFuncSetAttribute((const void*)fwd_megakernel, hipFuncAttributeMaxDynamicSharedMemorySize, LDS_BYTES) != hipSuccess) { fprintf(stderr, "hipFuncSetAttribute failed\n"); grid_blocks = -1; return; }
    hipOccupancyMaxActiveBlocksPerMultiprocessor(&per_cu, (const void*)fwd_megakernel, 512, LDS_BYTES);
    if (per_cu < 1) { fprintf(stderr, "occupancy query says %d blocks/CU\n", per_cu); per_cu = 1; }
    (void)hipGetLastError();
    grid_blocks = cus;
  }
  if (grid_blocks < 0) return;
  if (hipMemsetAsync((char*)d_ws + WS_BAR, 0, 16384, stream) != hipSuccess) { fprintf(stderr, "hipMemsetAsync of the barrier words failed\n"); return; }
  Params p{};
  p.xp = (const float*)d_in[0]; p.xs = (const float*)d_in[1]; p.norm_attn = (const float*)d_in[2]; p.w_in = (const float*)d_in[3];
  p.qna = (const float*)d_in[4]; p.kna = (const float*)d_in[5]; p.qnb = (const float*)d_in[6]; p.knb = (const float*)d_in[7];
  p.sink = (const float*)d_in[8]; p.ona = (const float*)d_in[9]; p.onb = (const float*)d_in[10]; p.w_o = (const float*)d_in[11];
  p.norm_mlp = (const float*)d_in[12]; p.w_up = (const float*)d_in[13]; p.w_down = (const float*)d_in[14];
  p.out = (float*)d_out; p.ws = (unsigned char*)d_ws;
  void* args[] = {&p};
  hipError_t e = hipLaunchCooperativeKernel((const void*)fwd_megakernel, dim3(grid_blocks), dim3(512), args, LDS_BYTES, stream);
  if (e != hipSuccess) fprintf(stderr, "cooperative launch failed: %s (grid %d)\n", hipGetErrorString(e), grid_blocks);
}
```

```cpp
#include <hip/hip_runtime.h>
#include <hip/hip_cooperative_groups.h>
#include <cstdio>
#include <cstdint>
namespace cg = cooperative_groups;

typedef unsigned short bf16_t;
typedef short bf16x8 __attribute__((ext_vector_type(8)));
typedef float f32x4 __attribute__((ext_vector_type(4)));
typedef unsigned u32x4 __attribute__((ext_vector_type(4)));
typedef unsigned u32x2 __attribute__((ext_vector_type(2)));

constexpr int DM = 1024, NTOK = 65536, NPROMPT = 32768, INC = 2304, DFF = 4096;
constexpr float EPS = 1e-6f;
constexpr float LOG2E = 1.4426950408889634f;
constexpr float QSCALE = 0.18033688011112042f;

constexpr size_t MiB = 1048576;
constexpr size_t WS_WIN = 0, WS_WO = 4718592, WS_WUP = 6815744, WS_WD = 15204352, WS_RS1 = 23592960, WS_SSQ2 = 440 * MiB;
constexpr size_t WS_X = 24 * MiB;
constexpr size_t WS_QKV = 152 * MiB;
constexpr size_t WS_HB = 312 * MiB;
constexpr size_t WS_U = 24 * MiB;
constexpr size_t WS_SSQH = 444 * MiB;
constexpr size_t WS_BAR = 448 * MiB;
constexpr size_t WS_NEED = 449 * MiB;

constexpr int GEMM_LDS_BYTES = 131072, LDS_BYTES = GEMM_LDS_BYTES + 64;
constexpr bool GEMM_ALIGN = true, GEMM_SP2 = true;
constexpr int ATT_NACT = 8;
constexpr int ATT_SLOTS = 16 / ATT_NACT, ATT_LA = ATT_SLOTS - 1;

struct Params {
  const float *xp, *xs, *norm_attn, *w_in, *qna, *kna, *qnb, *knb, *sink, *ona, *onb, *w_o, *norm_mlp, *w_up, *w_down;
  float* out;
  unsigned char* ws;
};

extern __shared__ __attribute__((aligned(16))) unsigned char g_shm[];

typedef __bf16 bf16v2_t __attribute__((ext_vector_type(2)));
typedef float f32v2_t __attribute__((ext_vector_type(2)));
__device__ __forceinline__ unsigned pk2(float lo, float hi) { const f32v2_t f = {lo, hi}; const bf16v2_t b = __builtin_convertvector(f, bf16v2_t); return __builtin_bit_cast(unsigned, b); }
__device__ __forceinline__ float bf2f(unsigned short b) { return __uint_as_float(((unsigned)b) << 16); }
__device__ __forceinline__ f32x4 mfma16(bf16x8 a, bf16x8 b, f32x4 c) { return __builtin_amdgcn_mfma_f32_16x16x32_bf16(a, b, c, 0, 0, 0); }

__device__ __forceinline__ int col_slot(int c, int mode) {
  if (mode == 0) return 128 * ((c >> 3) & 1) + 32 * (c >> 6) + 16 * ((c >> 2) & 1) + 4 * ((c >> 4) & 3) + (c & 3);
  if (mode == 1) return 128 * ((c >> 5) & 1) + 32 * (c >> 6) + 16 * ((c >> 2) & 1) + 4 * ((c >> 3) & 3) + (c & 3);
  return c;
}

constexpr int BM = 256, BK = 64, HALF = 128, HT = HALF * BK;
__device__ __forceinline__ int lds_byte(int r, int c) {
  int st = (r >> 4) * 2 + (c >> 5), rr = r & 15, cc = c & 31, ob = rr * 64 + cc * 2;
  return st * 1024 + (ob ^ (((ob >> 9) & 1) << 5));
}
__device__ __forceinline__ void stage_rc(int b, int& R, int& C) {
  int st = b / 1024, sb = b % 1024, swz = sb ^ (((sb >> 9) & 1) << 5);
  R = (st >> 1) * 16 + swz / 64; C = (st & 1) * 32 + (swz % 64) / 2;
}

__device__ __forceinline__ bool tile_of(int L, int nM, int nN, int& pm, int& pn) {
  const int nwg = nM * nN; if (L >= nwg) return false;
  int wgid = L; { const int q = nwg / 8, r = nwg % 8, xcd = wgid % 8, off = wgid / 8; wgid = (xcd < r ? xcd * (q + 1) : r * (q + 1) + (xcd - r) * q) + off; }
  const int nig = 8 * nN, gid = wgid / nig, fm = gid * 8, gsz = (nM - fm) < 8 ? (nM - fm) : 8;
  pm = fm + ((wgid % nig) % gsz); pn = (wgid % nig) / gsz; return true;
}
#define LAS __attribute__((address_space(3)))
template <class Epi, bool ALIGN_EPI, bool SP2, bool MID = false>
__device__ __forceinline__ void gemm_phase(const bf16_t* __restrict__ Ag, const bf16_t* __restrict__ Btg, const int M, const int N, const int K, const Epi& E) {
  LAS unsigned char* lds = (LAS unsigned char*)g_shm;
  int tid = threadIdx.x; asm volatile("" : "+v"(tid));
  const int wid = __builtin_amdgcn_readfirstlane(tid >> 6), lane = tid & 63, wr = wid >> 2, wc = wid & 3, fr = lane & 15, fq = lane >> 4;
  const int nt = K / BK, nM = M / BM, nN = N / BM, G = gridDim.x, cu = blockIdx.x;
  constexpr int HTB = HALF * BK * 2;
  unsigned voff[2];
#pragma unroll
  for (int i = 0; i < 2; ++i) { int R, C; stage_rc(tid * 16 + i * 8192, R, C); voff[i] = (unsigned)(R * K + C) * 2u; }
  const size_t kstep = (size_t)(BK * 2), hstep = (size_t)HALF * K * 2, tstep = 2 * hstep;
  const unsigned ldsw = (unsigned)wid * 1024u;
  const int aoff = lds_byte(wr * 64 + fr, fq * 8), boff = lds_byte(wc * 32 + fr, fq * 8);
#define PG8_SA(b, h) (((b) * 2 + (h)) * HTB)
#define PG8_SB(b, h) ((4 + (b) * 2 + (h)) * HTB)
#define PG8_STAGE(bufoff, gbase) do { _Pragma("unroll") for (int _i = 0; _i < 2; ++_i) \
    __builtin_amdgcn_global_load_lds((const __attribute__((address_space(1))) unsigned*)((const char*)(gbase) + voff[_i]), (LAS unsigned*)(lds + (bufoff) + ldsw + _i * 8192), 16, 0, 0); } while (0)
#define PG8_LDA(dst, b, h) do { _Pragma("unroll") for (int m = 0; m < 4; ++m) _Pragma("unroll") for (int k = 0; k < 2; ++k) dst[m][k] = *(const LAS bf16x8*)(lds + PG8_SA(b, h) + aoff + m * 2048 + k * 1024); } while (0)
#define PG8_LDB(dst, b, h) do { _Pragma("unroll") for (int n = 0; n < 2; ++n) _Pragma("unroll") for (int k = 0; k < 2; ++k) dst[n][k] = *(const LAS bf16x8*)(lds + PG8_SB(b, h) + boff + n * 2048 + k * 1024); } while (0)
#define PG8_MMA(ai, bj, At, Bt) do { __builtin_amdgcn_s_setprio(1); _Pragma("unroll") for (int m = 0; m < 4; ++m) _Pragma("unroll") for (int n = 0; n < 2; ++n) _Pragma("unroll") for (int k = 0; k < 2; ++k) \
    acc[ai][bj][m][n] = __builtin_amdgcn_mfma_f32_16x16x32_bf16(Bt[n][k], At[m][k], acc[ai][bj][m][n], 0, 0, 0); __builtin_amdgcn_s_setprio(0); } while (0)
#define PG8_WAIT_V(n) asm volatile("s_waitcnt vmcnt(" #n ")" ::: "memory")
#define PG8_WAIT_L(n) asm volatile("s_waitcnt lgkmcnt(" #n ")" ::: "memory")
#define PG8_BAR __builtin_amdgcn_s_barrier()
#define PG8_SCHED __builtin_amdgcn_sched_barrier(0)
  int cpm, cpn, npm = 0, npn = 0, ui = 0;
  if (!tile_of(cu, nM, nN, cpm, cpn)) return;
  f32x4 acc[2][2][4][2];
#pragma unroll
  for (int a = 0; a < 2; ++a)
#pragma unroll
    for (int b = 0; b < 2; ++b)
#pragma unroll
      for (int m = 0; m < 4; ++m)
#pragma unroll
        for (int n = 0; n < 2; ++n) acc[a][b][m][n] = (f32x4){0.f, 0.f, 0.f, 0.f};
  bf16x8 At[4][2], B0[2][2], B1[2][2];
  const char* cA = (const char*)Ag + (size_t)cpm * tstep; const char* cB = (const char*)Btg + (size_t)cpn * tstep;
  static_assert(SP2, "this body is the two-super-phase loop");
  PG8_STAGE(PG8_SB(0, 0), cB); PG8_STAGE(PG8_SB(0, 1), cB + hstep); PG8_STAGE(PG8_SA(0, 0), cA); PG8_STAGE(PG8_SA(0, 1), cA + hstep);
  PG8_STAGE(PG8_SB(1, 0), cB + kstep); PG8_STAGE(PG8_SA(1, 0), cA + kstep); PG8_STAGE(PG8_SB(1, 1), cB + hstep + kstep);
  if (wr == 1) PG8_BAR;
  PG8_WAIT_V(0); PG8_BAR;
  PG8_BAR;
#define K2_ITER(FIRST) do { \
      const bool last = (t == nt - 2); \
      const char* a1 = cA + (size_t)(t + 1) * kstep; \
      const char* a2 = last ? nA : cA + (size_t)(t + 2) * kstep; const char* b2 = last ? nB : cB + (size_t)(t + 2) * kstep; \
      const char* a3 = a2 + kstep; const char* b3 = b2 + kstep; \
      if constexpr (MID) { if (t == (nt >> 1)) E.mid(acc, cpm * BM); } \
      PG8_LDB(B0, 0, 0); PG8_LDB(B1, 0, 1); PG8_SCHED; PG8_LDA(At, 0, 0); PG8_STAGE(PG8_SA(1, 1), a1 + hstep); \
      if constexpr (!(FIRST)) PG8_WAIT_V(8); \
      PG8_WAIT_L(0); PG8_BAR; PG8_MMA(0, 0, At, B0); PG8_MMA(0, 1, At, B1); PG8_BAR; PG8_SCHED; \
      PG8_LDA(At, 0, 1); PG8_STAGE(PG8_SB(0, 0), b2); PG8_STAGE(PG8_SB(0, 1), b2 + hstep); PG8_STAGE(PG8_SA(0, 0), a2); \
      if constexpr (!(FIRST)) PG8_WAIT_V(8); \
      PG8_WAIT_L(0); PG8_BAR; PG8_MMA(1, 0, At, B0); PG8_MMA(1, 1, At, B1); PG8_BAR; PG8_SCHED; \
      PG8_LDB(B0, 1, 0); PG8_LDB(B1, 1, 1); PG8_SCHED; PG8_LDA(At, 1, 0); PG8_STAGE(PG8_SA(0, 1), a2 + hstep); \
      PG8_WAIT_V(8); PG8_WAIT_L(0); PG8_BAR; PG8_MMA(0, 0, At, B0); PG8_MMA(0, 1, At, B1); PG8_BAR; PG8_SCHED; \
      PG8_LDA(At, 1, 1); PG8_STAGE(PG8_SB(1, 0), b3); PG8_STAGE(PG8_SB(1, 1), b3 + hstep); PG8_STAGE(PG8_SA(1, 0), a3); \
      PG8_WAIT_V(8); PG8_WAIT_L(0); PG8_BAR; PG8_MMA(1, 0, At, B0); PG8_MMA(1, 1, At, B1); PG8_BAR; PG8_SCHED; \
    } while (0)
  for (;;) {
    const bool has_next = tile_of((ui + 1) * G + cu, nM, nN, npm, npn);
    const char* nA = has_next ? (const char*)Ag + (size_t)npm * tstep : cA; const char* nB = has_next ? (const char*)Btg + (size_t)npn * tstep : cB;
    { const int t = 0; K2_ITER(true); }
    for (int t = 2; t < nt; t += 2) K2_ITER(false);
    const typename Epi::Pre pre = E.pre(cpm * BM, cpn * BM);
    if constexpr (ALIGN_EPI) { if (wr == 0) PG8_BAR; }
    PG8_WAIT_V(0);
    E(acc, cpm * BM, cpn * BM, pre);
    if (!has_next) break;
#pragma unroll
    for (int a = 0; a < 2; ++a)
#pragma unroll
      for (int b = 0; b < 2; ++b)
#pragma unroll
        for (int m = 0; m < 4; ++m)
#pragma unroll
          for (int n = 0; n < 2; ++n) acc[a][b][m][n] = (f32x4){0.f, 0.f, 0.f, 0.f};
    cpm = npm; cpn = npn; cA = nA; cB = nB; ++ui;
    if constexpr (ALIGN_EPI) { if (wr == 1) PG8_BAR; }
  }
  PG8_WAIT_V(0);
  if constexpr (!ALIGN_EPI) { if (wr == 0) PG8_BAR; }
  PG8_BAR;
#undef K2_ITER
#undef PG8_SA
#undef PG8_SB
#undef PG8_STAGE
#undef PG8_LDA
#undef PG8_LDB
#undef PG8_MMA
}

#define EPI_IDS \
    int tid_ = threadIdx.x; asm volatile("" : "+v"(tid_));     \
    const int wid_ = tid_ >> 6, lane_ = tid_ & 63, wr = wid_ >> 2, wc = wid_ & 3, fr = lane_ & 15, fq = lane_ >> 4;
#define PACK16(v, w0, w1) \
    w0.x = pk2(v[0], v[1]); w0.y = pk2(v[2], v[3]); w0.z = pk2(v[4], v[5]); w0.w = pk2(v[6], v[7]); \
    w1.x = pk2(v[8], v[9]); w1.y = pk2(v[10], v[11]); w1.z = pk2(v[12], v[13]); w1.w = pk2(v[14], v[15]);

struct EpiQKV {
  bf16_t* qkv; const float* rs1; const float *qna, *kna, *qnb, *knb;
  struct Pre { float rs[8]; float gn[16]; };
  __device__ __forceinline__ Pre pre(int brow, int bcol) const {
    EPI_IDS
    (void)fr;
    Pre r;
    const int ct = bcol >> 8;
    const float* gp = nullptr; float extra = 1.f;
    if (ct < 2) { gp = qna; extra = QSCALE; } else if (ct < 4) gp = kna; else if (ct < 6) gp = nullptr; else if (ct < 8) { gp = qnb; extra = QSCALE; } else gp = (wc < 2) ? knb : nullptr;
#pragma unroll
    for (int i = 0; i < 16; ++i) r.gn[i] = gp ? gp[32 * (i >> 3) + 8 * fq + (i & 7)] * extra : 0.f;
#pragma unroll
    for (int k = 0; k < 8; ++k) r.rs[k] = rs1[brow + (k >> 2) * HALF + wr * 64 + (k & 3) * 16 + fr];
    return r;
  }
  __device__ __forceinline__ void operator()(const f32x4 (&acc)[2][2][4][2], int brow, int bcol, const Pre& pre) const {
    EPI_IDS
    const int ct = bcol >> 8;
    const bool gp = !(ct == 4 || ct == 5 || (ct == 8 && wc >= 2));
    const int smask = (brow < NPROMPT) ? 2047 : 4095;
#pragma unroll
    for (int ai = 0; ai < 2; ++ai)
#pragma unroll
      for (int m = 0; m < 4; ++m) {
        const int row = brow + ai * HALF + wr * 64 + m * 16 + fr;
        const float rs = pre.rs[ai * 4 + m];
        float v[16];
#pragma unroll
        for (int bj = 0; bj < 2; ++bj)
#pragma unroll
          for (int n = 0; n < 2; ++n)
#pragma unroll
            for (int j = 0; j < 4; ++j) v[8 * bj + 4 * n + j] = acc[ai][bj][m][n][j] * rs;
        if (gp) {
          float ss = 0.f;
#pragma unroll
          for (int i = 0; i < 16; ++i) ss += v[i] * v[i];
          ss += __shfl_xor(ss, 16); ss += __shfl_xor(ss, 32);
          const float inv = rsqrtf(ss * (1.0f / 64.0f) + EPS);
#pragma unroll
          for (int i = 0; i < 16; ++i) v[i] = v[i] * inv * pre.gn[i];
          {
            const float pos = (float)(row & smask);
            const float sgn = fq == 0 ? -1.0f : 1.0f;
#pragma unroll
            for (int i = 0; i < 8; ++i) {
              const float ci = i == 0 ? 1.5915494309e-01f : i == 1 ? 3.0863763405e-02f : i == 2 ? 5.9851857127e-03f : i == 3 ? 1.1606636412e-03f : i == 4 ? 2.2507907904e-04f : i == 5 ? 4.3647952793e-05f : i == 6 ? 8.4643308082e-06f : 1.6414262628e-06f;
              const float vp = __shfl_xor(v[i], 16);
              const float tr = __builtin_amdgcn_fractf(pos * ci);
              const float c = __builtin_amdgcn_cosf(tr), s = __builtin_amdgcn_sinf(tr);
              const float r = v[i] * c + sgn * (vp * s);
              v[i] = fq < 2 ? r : v[i];
            }
          }
        }
        u32x4 w0, w1; PACK16(v, w0, w1)
        bf16_t* dst = qkv + (size_t)row * INC + bcol + 64 * wc + 8 * fq;
        *(u32x4*)dst = w0; *(u32x4*)(dst + 32) = w1;
      }
  }
};

struct EpiWo {
  const float *xp, *xs; bf16_t* hb; float* ssq2p; const float* ssqh;
  __device__ __forceinline__ void scales(int row, float& sa, float& sb) const {
    const float* sp = ssqh + (size_t)row * 16;
    const f32x4 a = *(const f32x4*)sp, b = *(const f32x4*)(sp + 4), c = *(const f32x4*)(sp + 8), d = *(const f32x4*)(sp + 12);
    sa = rsqrtf((((a[0] + a[1]) + (a[2] + a[3])) + ((b[0] + b[1]) + (b[2] + b[3]))) * (1.0f / 512.0f) + EPS);
    sb = rsqrtf((((c[0] + c[1]) + (c[2] + c[3])) + ((d[0] + d[1]) + (d[2] + d[3]))) * (1.0f / 512.0f) + EPS);
  }
  __device__ __forceinline__ void mid(f32x4 (&acc)[2][2][4][2], int brow) const {
    EPI_IDS
    (void)wc; (void)fq;
#pragma unroll
    for (int ai = 0; ai < 2; ++ai)
#pragma unroll
      for (int m = 0; m < 4; ++m) {
        float sa, sb; scales(brow + ai * HALF + wr * 64 + m * 16 + fr, sa, sb);
        const float ratio = sa / sb;
#pragma unroll
        for (int bj = 0; bj < 2; ++bj)
#pragma unroll
          for (int n = 0; n < 2; ++n) acc[ai][bj][m][n] = acc[ai][bj][m][n] * ratio;
      }
  }
  struct Pre { f32x4 xv0[4][4]; };
  __device__ __forceinline__ Pre pre(int brow, int bcol) const {
    EPI_IDS
    Pre r;
    const float* xbase = (brow < NPROMPT) ? (xp + (size_t)brow * DM) : (xs + (size_t)(brow - NPROMPT) * DM);
#pragma unroll
    for (int m = 0; m < 4; ++m) {
      const float* xr = xbase + (size_t)(wr * 64 + m * 16 + fr) * DM + bcol + 64 * wc + 8 * fq;
#pragma unroll
      for (int q = 0; q < 4; ++q) r.xv0[m][q] = *(const f32x4*)(xr + 32 * (q >> 1) + 4 * (q & 1));
    }
    return r;
  }
  __device__ __forceinline__ void operator()(const f32x4 (&acc)[2][2][4][2], int brow, int bcol, const Pre& pre) const {
    EPI_IDS
    const float* xbase = (brow < NPROMPT) ? (xp + (size_t)brow * DM) : (xs + (size_t)(brow - NPROMPT) * DM);
#pragma unroll
    for (int ai = 0; ai < 2; ++ai) {
      f32x4 xv[4][4]; float sbv[4];
#pragma unroll
      for (int m = 0; m < 4; ++m) {
        const int rl = ai * HALF + wr * 64 + m * 16 + fr;
        const float* xr = xbase + (size_t)rl * DM + bcol + 64 * wc + 8 * fq;
#pragma unroll
        for (int q = 0; q < 4; ++q) xv[m][q] = ai == 0 ? pre.xv0[m][q] : *(const f32x4*)(xr + 32 * (q >> 1) + 4 * (q & 1));
        float sa; scales(brow + rl, sa, sbv[m]);
      }
#pragma unroll
      for (int m = 0; m < 4; ++m) {
        const int rl = ai * HALF + wr * 64 + m * 16 + fr;
        float v[16]; float ss = 0.f;
#pragma unroll
        for (int bj = 0; bj < 2; ++bj)
#pragma unroll
          for (int n = 0; n < 2; ++n)
#pragma unroll
            for (int j = 0; j < 4; ++j) { const float h = xv[m][2 * bj + n][j] + acc[ai][bj][m][n][j] * sbv[m]; v[8 * bj + 4 * n + j] = h; ss += h * h; }
        ss += __shfl_xor(ss, 16); ss += __shfl_xor(ss, 32);
        if (fq == 0) ssq2p[(size_t)(brow + rl) * 16 + (bcol >> 8) * 4 + wc] = ss;
        u32x4 w0, w1; PACK16(v, w0, w1)
        bf16_t* dst = hb + (size_t)(brow + rl) * DM + bcol + 64 * wc + 8 * fq;
        *(u32x4*)dst = w0; *(u32x4*)(dst + 32) = w1;
      }
      __builtin_amdgcn_sched_barrier(0);
    }
  }
};

struct EpiUp {
  bf16_t* u;
  struct Pre {};
  __device__ __forceinline__ Pre pre(int, int) const { return Pre{}; }
  __device__ __forceinline__ void operator()(const f32x4 (&acc)[2][2][4][2], int brow, int bcol, const Pre&) const {
    EPI_IDS
#pragma unroll
    for (int ai = 0; ai < 2; ++ai)
#pragma unroll
      for (int m = 0; m < 4; ++m) {
        const int rl = brow + ai * HALF + wr * 64 + m * 16 + fr;
        float v[16];
#pragma unroll
        for (int bj = 0; bj < 2; ++bj)
#pragma unroll
          for (int n = 0; n < 2; ++n) {
            f32x4 z = acc[ai][bj][m][n];
#pragma unroll
            for (int j = 0; j < 4; ++j) z[j] = fmaxf(z[j], 0.f);
            z = z * z;
#pragma unroll
            for (int j = 0; j < 4; ++j) v[8 * bj + 4 * n + j] = z[j];
          }
        u32x4 w0, w1; PACK16(v, w0, w1)
        bf16_t* dst = u + (size_t)rl * DFF + bcol + 64 * wc + 8 * fq;
        *(u32x4*)dst = w0; *(u32x4*)(dst + 32) = w1;
      }
  }
};

struct EpiDown {
  const bf16_t* hb; float* out; const float* s2; int row_base;
  struct Pre { u32x2 hv[2][4][2][2]; float sq[8]; };
  __device__ __forceinline__ Pre pre(int brow, int bcol) const {
    EPI_IDS
    Pre r;
#pragma unroll
    for (int ai = 0; ai < 2; ++ai)
#pragma unroll
      for (int m = 0; m < 4; ++m) {
        const size_t off = (size_t)(row_base + brow + ai * HALF + wr * 64 + m * 16 + fr) * DM + bcol + 32 * wc + 4 * fq;
#pragma unroll
        for (int bj = 0; bj < 2; ++bj)
#pragma unroll
          for (int n = 0; n < 2; ++n) r.hv[ai][m][bj][n] = *(const u32x2*)(hb + off + 128 * bj + 16 * n);
        const float s = s2[row_base + brow + ai * HALF + wr * 64 + m * 16 + fr]; r.sq[ai * 4 + m] = s * s;
      }
    return r;
  }
  __device__ __forceinline__ void operator()(const f32x4 (&acc)[2][2][4][2], int brow, int bcol, const Pre& pre) const {
    EPI_IDS
#pragma unroll
    for (int ai = 0; ai < 2; ++ai)
#pragma unroll
      for (int m = 0; m < 4; ++m) {
        const size_t off = (size_t)(row_base + brow + ai * HALF + wr * 64 + m * 16 + fr) * DM + bcol + 32 * wc + 4 * fq;
        float* dst = out + off; const float sq = pre.sq[ai * 4 + m];
#pragma unroll
        for (int bj = 0; bj < 2; ++bj)
#pragma unroll
          for (int n = 0; n < 2; ++n) {
            const unsigned a = pre.hv[ai][m][bj][n].x, b = pre.hv[ai][m][bj][n].y;
            f32x4 o;
            o[0] = __uint_as_float(a << 16) + acc[ai][bj][m][n][0] * sq; o[1] = __uint_as_float(a & 0xffff0000u) + acc[ai][bj][m][n][1] * sq;
            o[2] = __uint_as_float(b << 16) + acc[ai][bj][m][n][2] * sq; o[3] = __uint_as_float(b & 0xffff0000u) + acc[ai][bj][m][n][3] * sq;
            *(f32x4*)(dst + 128 * bj + 16 * n) = o;
          }
      }
  }
};

__device__ __forceinline__ void p0_transpose_item(const float* __restrict__ W, int K, int N, bf16_t* __restrict__ WT, const float* __restrict__ g0, const float* __restrict__ g1, float* scr, int item, int lane, int mode) {
  const int nblk = N / 32, kb = item / nblk, nb = item % nblk, k0 = 64 * kb, n0 = 32 * nb;
#pragma unroll 8
  for (int i = 0; i < 32; ++i) {
    const int kk = 2 * i + (lane >> 5), k = k0 + kk;
    float gv = 1.f; if (g0) gv = (g1 && k >= 512) ? g1[k - 512] : g0[k];
    scr[kk * 33 + (lane & 31)] = W[(size_t)k * N + n0 + (lane & 31)] * gv;
  }
  asm volatile("s_waitcnt lgkmcnt(0)" ::: "memory");
  const int c = lane & 7;
#pragma unroll
  for (int j = 0; j < 4; ++j) {
    const int n = (lane >> 3) + 8 * j; const float* s = scr + (8 * c) * 33 + n;
    u32x4 o; o.x = pk2(s[0 * 33], s[1 * 33]); o.y = pk2(s[2 * 33], s[3 * 33]); o.z = pk2(s[4 * 33], s[5 * 33]); o.w = pk2(s[6 * 33], s[7 * 33]);
    const int col = n0 + n, drow = (col & ~255) + col_slot(col & 255, mode);
    *(u32x4*)(WT + (size_t)drow * K + k0 + 8 * c) = o;
  }
  asm volatile("s_waitcnt lgkmcnt(0)" ::: "memory");
}

__device__ __forceinline__ void p0_prologue(const Params& p) {
  int tid = threadIdx.x; asm volatile("" : "+v"(tid));
  const int wave = tid >> 6, lane = tid & 63;
  const int gw = blockIdx.x * 8 + wave, NGW = gridDim.x * 8;
  float* scr = (float*)(g_shm + wave * 16384);
  bf16_t* WinT = (bf16_t*)(p.ws + WS_WIN); bf16_t* WoT = (bf16_t*)(p.ws + WS_WO); bf16_t* WupT = (bf16_t*)(p.ws + WS_WUP); bf16_t* WdT = (bf16_t*)(p.ws + WS_WD);
  constexpr int I_IN = 16 * 72, I_O = 16 * 32, I_UP = 16 * 128, I_DN = 64 * 32, NIT = I_IN + I_O + I_UP + I_DN;
  for (int it = gw; it < NIT; it += NGW) {
    int r = it;
    if (r < I_IN) { p0_transpose_item(p.w_in, DM, INC, WinT, p.norm_attn, nullptr, scr, r, lane, 1); continue; } r -= I_IN;
    if (r < I_O) { p0_transpose_item(p.w_o, DM, DM, WoT, p.ona, p.onb, scr, r, lane, 1); continue; } r -= I_O;
    if (r < I_UP) { p0_transpose_item(p.w_up, DM, DFF, WupT, p.norm_mlp, nullptr, scr, r, lane, 1); continue; } r -= I_UP;
    p0_transpose_item(p.w_down, DFF, DM, WdT, nullptr, nullptr, scr, r, lane, 2);
  }
  bf16_t* xb = (bf16_t*)(p.ws + WS_X); float* rs1 = (float*)(p.ws + WS_RS1);
  for (int row4 = gw * 4; row4 < NTOK; row4 += NGW * 4) {
    f32x4 v[4][4];
#pragma unroll
    for (int r = 0; r < 4; ++r) {
      const int row = row4 + r;
      const float* xr = (row < NPROMPT) ? (p.xp + (size_t)row * DM) : (p.xs + (size_t)(row - NPROMPT) * DM);
#pragma unroll
      for (int j = 0; j < 4; ++j) v[r][j] = *(const f32x4*)(xr + 256 * j + 4 * lane);
    }
#pragma unroll
    for (int r = 0; r < 4; ++r) {
      const int row = row4 + r; float s = 0.f;
#pragma unroll
      for (int j = 0; j < 4; ++j) s += (v[r][j][0] * v[r][j][0] + v[r][j][1] * v[r][j][1]) + (v[r][j][2] * v[r][j][2] + v[r][j][3] * v[r][j][3]);
#pragma unroll
      for (int o = 1; o < 64; o <<= 1) s += __shfl_xor(s, o);
#pragma unroll
      for (int j = 0; j < 4; ++j) { u32x2 w; w.x = pk2(v[r][j][0], v[r][j][1]); w.y = pk2(v[r][j][2], v[r][j][3]); *(u32x2*)(xb + (size_t)row * DM + 256 * j + 4 * lane) = w; }
      if (lane == 0) rs1[row] = rsqrtf(s * (1.0f / DM) + EPS);
    }
  }
}

struct ChunkSrc { int rowc, d, M, kc0; };

__device__ __forceinline__ void issue_chunk(const bf16_t* __restrict__ qkv, const ChunkSrc cs, int koff, int voff, int lane, unsigned char* slot) {
  const unsigned ck = (unsigned)(koff * 2), cv = (unsigned)(voff * 2);
#pragma unroll
  for (int i = 0; i < 4; ++i) {
    const int r = (lane >> 3) + 8 * i;
    int kc = cs.kc0 + r; kc = kc < 0 ? 0 : (kc > cs.M - 1 ? cs.M - 1 : kc);
    const unsigned row = __umul24((unsigned)cs.d, (unsigned)kc) + (unsigned)cs.rowc;
    const unsigned rb = __umul24(row, (unsigned)(INC * 2));
    const unsigned chk = (unsigned)(((lane & 7) ^ ((r >> 1) & 7)) << 4), chv = (unsigned)(((lane & 7) ^ (((r >> 1) & 3) << 1)) << 4);
    __builtin_amdgcn_global_load_lds((const __attribute__((address_space(1))) unsigned*)((const char*)qkv + (rb + (ck + chk))), (LAS unsigned*)(slot + i * 1024), 16, 0, 0);
    __builtin_amdgcn_global_load_lds((const __attribute__((address_space(1))) unsigned*)((const char*)qkv + (rb + (cv + chv))), (LAS unsigned*)(slot + 4096 + i * 1024), 16, 0, 0);
  }
}
__device__ __forceinline__ void read_vt(unsigned a0, unsigned a1, unsigned a2, unsigned a3, bf16x8 (&Vt)[4]) {
  u32x2 r00, r01, r10, r11, r20, r21, r30, r31;
  asm volatile(
      "ds_read_b64_tr_b16 %0, %8\n\tds_read_b64_tr_b16 %1, %8 offset:2048\n\t"
      "ds_read_b64_tr_b16 %2, %9\n\tds_read_b64_tr_b16 %3, %9 offset:2048\n\t"
      "ds_read_b64_tr_b16 %4, %10\n\tds_read_b64_tr_b16 %5, %10 offset:2048\n\t"
      "ds_read_b64_tr_b16 %6, %11\n\tds_read_b64_tr_b16 %7, %11 offset:2048\n\t"
      "s_waitcnt lgkmcnt(0)"
      : "=&v"(r00), "=&v"(r01), "=&v"(r10), "=&v"(r11), "=&v"(r20), "=&v"(r21), "=&v"(r30), "=&v"(r31)
      : "v"(a0), "v"(a1), "v"(a2), "v"(a3) : "memory");
  u32x4 t;
  t.x = r00.x; t.y = r00.y; t.z = r01.x; t.w = r01.y; Vt[0] = __builtin_bit_cast(bf16x8, t);
  t.x = r10.x; t.y = r10.y; t.z = r11.x; t.w = r11.y; Vt[1] = __builtin_bit_cast(bf16x8, t);
  t.x = r20.x; t.y = r20.y; t.z = r21.x; t.w = r21.y; Vt[2] = __builtin_bit_cast(bf16x8, t);
  t.x = r30.x; t.y = r30.y; t.z = r31.x; t.w = r31.y; Vt[3] = __builtin_bit_cast(bf16x8, t);
}
__device__ __forceinline__ void tile_chunk(const bf16x8 (&Kf)[2][2], const bf16x8 (&Q)[2], const bf16x8 (&Vt)[4], f32x4 (&o)[4], f32x4& l, int kcl, int lo, unsigned span, float negm) {
  f32x4 s0 = {negm, negm, negm, negm}, s1 = s0;
  s0 = mfma16(Kf[0][0], Q[0], s0); s0 = mfma16(Kf[0][1], Q[1], s0);
  s1 = mfma16(Kf[1][0], Q[0], s1); s1 = mfma16(Kf[1][1], Q[1], s1);
  float pv[8];
#pragma unroll
  for (int j = 0; j < 4; ++j) {
    pv[j] = ((unsigned)(kcl + j - lo) <= span) ? __builtin_amdgcn_exp2f(s0[j]) : 0.f;
    pv[4 + j] = ((unsigned)(kcl + 16 + j - lo) <= span) ? __builtin_amdgcn_exp2f(s1[j]) : 0.f;
  }
  u32x4 pk; pk.x = pk2(pv[0], pv[1]); pk.y = pk2(pv[2], pv[3]); pk.z = pk2(pv[4], pv[5]); pk.w = pk2(pv[6], pv[7]);
  const bf16x8 P = __builtin_bit_cast(bf16x8, pk);
#pragma unroll
  for (int dt = 0; dt < 4; ++dt) o[dt] = mfma16(Vt[dt], P, o[dt]);
  const bf16x8 ones = {(short)0x3F80, (short)0x3F80, (short)0x3F80, (short)0x3F80, (short)0x3F80, (short)0x3F80, (short)0x3F80, (short)0x3F80};
  l = mfma16(ones, P, l);
}

template <int TMASK, class DESC>
__device__ __forceinline__ void run_branch(const bf16_t* __restrict__ qkv, const DESC& desc, int& gi, const int total, const int nchunks, const int M, const int kstart, int koff, int voff,
                                           int qcb, int qstep, int hw, float negm, int lane, unsigned char* ring, const bf16x8 (&Q)[4][2], f32x4 (&o)[4][4], f32x4 (&l)[4]) {
  const int g = lane >> 4;
  int lo[4]; unsigned span[4];
#pragma unroll
  for (int t = 0; t < 4; ++t) { const int qc = qcb + t * qstep; lo[t] = qc - hw < 0 ? 0 : qc - hw; const int hi = qc + hw > M - 1 ? M - 1 : qc + hw; span[t] = (unsigned)(hi - lo[t]); }
  const int qp = (lane & 15) >> 2, pp = lane & 3, rl = 4 * g + qp, f = (rl >> 1) & 3;
  const unsigned vbase = (unsigned)(size_t)ring + 4096 + rl * 128 + pp * 8;
  const unsigned a0 = vbase + ((0 ^ f) << 5), a1 = vbase + ((1 ^ f) << 5), a2 = vbase + ((2 ^ f) << 5), a3 = vbase + ((3 ^ f) << 5);
  const int krow = lane & 15;
  const LAS unsigned char* kb0 = (const LAS unsigned char*)ring + krow * 128 + (((0 + g) ^ (krow >> 1)) << 4);
  const LAS unsigned char* kb1 = (const LAS unsigned char*)ring + krow * 128 + (((4 + g) ^ (krow >> 1)) << 4);
#pragma unroll 1
  for (int c = 0; c < nchunks; ++c, ++gi) {
    const unsigned soff = (unsigned)(gi & (ATT_SLOTS - 1)) * 8192u;
    bf16x8 Kf[2][2];
    if constexpr (ATT_LA == 1) {
      asm volatile("s_waitcnt vmcnt(0)" ::: "memory");
      Kf[0][0] = *(const LAS bf16x8*)(kb0 + soff); Kf[0][1] = *(const LAS bf16x8*)(kb1 + soff);
      Kf[1][0] = *(const LAS bf16x8*)(kb0 + soff + 2048); Kf[1][1] = *(const LAS bf16x8*)(kb1 + soff + 2048);
      if (gi + 1 < total) issue_chunk(qkv, desc(gi + 1), koff, voff, lane, ring + ((gi + 1) & 1) * 8192);
    } else {
      if (gi + ATT_LA < total) issue_chunk(qkv, desc(gi + ATT_LA), koff, voff, lane, ring + ((gi + ATT_LA) & (ATT_SLOTS - 1)) * 8192);
      const int rem = total - 1 - gi;
      if (ATT_LA >= 3 && rem >= 3) asm volatile("s_waitcnt vmcnt(24)" ::: "memory");
      else if (ATT_LA >= 2 && rem >= 2) asm volatile("s_waitcnt vmcnt(16)" ::: "memory");
      else if (rem >= 1) asm volatile("s_waitcnt vmcnt(8)" ::: "memory");
      else asm volatile("s_waitcnt vmcnt(0)" ::: "memory");
      Kf[0][0] = *(const LAS bf16x8*)(kb0 + soff); Kf[0][1] = *(const LAS bf16x8*)(kb1 + soff);
      Kf[1][0] = *(const LAS bf16x8*)(kb0 + soff + 2048); Kf[1][1] = *(const LAS bf16x8*)(kb1 + soff + 2048);
    }
    bf16x8 Vt[4];
    read_vt(a0 + soff, a1 + soff, a2 + soff, a3 + soff, Vt);
    const int kcl = kstart + 32 * c + 4 * g;
#pragma unroll
    for (int t = 0; t < 4; ++t)
      if (TMASK & (1 << t)) tile_chunk(Kf, Q[t], Vt, o[t], l[t], kcl, lo[t], span[t], negm);
  }
}

__device__ __forceinline__ float wave_max(float v) {
#pragma unroll
  for (int o = 1; o < 64; o <<= 1) v = fmaxf(v, __shfl_xor(v, o));
  return v;
}

__device__ __forceinline__ void attn_phase(const Params& p) {
  int tid = threadIdx.x; asm volatile("" : "+v"(tid));
  const int wave = __builtin_amdgcn_readfirstlane(tid >> 6), lane = tid & 63, qi = lane & 15, g = lane >> 4;
  if (wave >= ATT_NACT) return;
  const bf16_t* qkv = (const bf16_t*)(p.ws + WS_QKV);
  bf16_t* mix = (bf16_t*)(p.ws + WS_X);
  float* ssqh = (float*)(p.ws + WS_SSQH);
  unsigned char* ring = g_shm + wave * (ATT_SLOTS * 8192);
  const float mfixA = 8.0f * LOG2E * wave_max(fabsf(p.qna[lane])) * wave_max(fabsf(p.kna[lane]));
  const float mfixB = 8.0f * LOG2E * wave_max(fabsf(p.qnb[lane])) * wave_max(fabsf(p.knb[lane]));
  const int xcd = blockIdx.x & 7, wx = (blockIdx.x >> 3) * ATT_NACT + wave, nwx = (gridDim.x >> 3) * ATT_NACT;
  for (int li = wx; li < 2048; li += nwx) {
    const int kind = (li / nwx) & 1;
    const int lk = ((li / nwx) >> 1) * nwx + (li % nwx);
    const int grp = xcd * 128 + (lk & 127), sub = lk >> 7;
    const int r64 = grp * 64;
    const int S = r64 < NPROMPT ? 2048 : 4096;
    const int row0 = r64 & ~(S - 1);
    bf16x8 Q[4][2]; f32x4 o[4][4]; f32x4 l[4];
#pragma unroll
    for (int t = 0; t < 4; ++t) {
#pragma unroll
      for (int dt = 0; dt < 4; ++dt) o[t][dt] = (f32x4){0.f, 0.f, 0.f, 0.f};
    }
    int tok[4], colb[4];
    int gi = 0;
    if (kind == 0) {
      const int sidx = (r64 - row0) >> 6, c4 = sidx & 3, p0 = (sidx >> 2) * 16, h = sub;
#pragma unroll
      for (int t = 0; t < 4; ++t) {
        tok[t] = 16 * (p0 + qi) + c4 + 4 * t; colb[t] = h * 64; l[t] = (f32x4){0.f, 0.f, 0.f, 0.f};
        const bf16_t* rp = qkv + (size_t)(row0 + tok[t]) * INC + h * 64 + g * 8;
        Q[t][0] = *(const bf16x8*)rp; Q[t][1] = *(const bf16x8*)(rp + 32);
      }
      const int koff = 512 + h * 64, voff = 1024 + h * 64;
      auto desc = [=](int i) -> ChunkSrc {
        ChunkSrc r;
        if (i < 12) { r.rowc = row0; r.d = 1; r.M = S; r.kc0 = 16 * p0 - 64 + 32 * i; }
        else if (i < 18) { r.rowc = row0 + c4; r.d = 4; r.M = S >> 2; r.kc0 = 4 * p0 - 64 + 32 * (i - 12); }
        else { const int j = i - 18, t = j / 5, c = j - 5 * t; r.rowc = row0 + c4 + 4 * t; r.d = 16; r.M = S >> 4; r.kc0 = p0 - 64 + 32 * c; }
        return r;
      };
      constexpr int TOTAL = 38;
#pragma unroll
      for (int i = 0; i < ATT_LA; ++i) issue_chunk(qkv, desc(i), koff, voff, lane, ring + i * 8192);
      run_branch<15>(qkv, desc, gi, TOTAL, 12, S, 16 * p0 - 64, koff, voff, 16 * (p0 + qi) + c4, 4, 64, -mfixA, lane, ring, Q, o, l);
      run_branch<15>(qkv, desc, gi, TOTAL, 6, S >> 2, 4 * p0 - 64, koff, voff, 4 * (p0 + qi), 1, 64, -mfixA, lane, ring, Q, o, l);
      run_branch<1>(qkv, desc, gi, TOTAL, 5, S >> 4, p0 - 64, koff, voff, p0 + qi, 0, 64, -mfixA, lane, ring, Q, o, l);
      run_branch<2>(qkv, desc, gi, TOTAL, 5, S >> 4, p0 - 64, koff, voff, p0 + qi, 0, 64, -mfixA, lane, ring, Q, o, l);
      run_branch<4>(qkv, desc, gi, TOTAL, 5, S >> 4, p0 - 64, koff, voff, p0 + qi, 0, 64, -mfixA, lane, ring, Q, o, l);
      run_branch<8>(qkv, desc, gi, TOTAL, 5, S >> 4, p0 - 64, koff, voff, p0 + qi, 0, 64, -mfixA, lane, ring, Q, o, l);
    } else {
      const int kvh = sub & 1, qsub = sub >> 1, q0 = (r64 - row0) + 16 * qsub;
#pragma unroll
      for (int t = 0; t < 4; ++t) {
        const int hq = kvh * 4 + t;
        tok[t] = q0 + qi; colb[t] = 512 + hq * 64;
        { const float sk = __builtin_amdgcn_exp2f(p.sink[hq] * LOG2E - mfixB); l[t] = (f32x4){sk, sk, sk, sk}; }
        const bf16_t* rp = qkv + (size_t)(row0 + tok[t]) * INC + 1536 + hq * 64 + g * 8;
        Q[t][0] = *(const bf16x8*)rp; Q[t][1] = *(const bf16x8*)(rp + 32);
      }
      const int koff = 2048 + kvh * 64, voff = 2176 + kvh * 64;
      auto desc = [=](int i) -> ChunkSrc { ChunkSrc r; r.rowc = row0; r.d = 1; r.M = S; r.kc0 = q0 - 128 + 32 * i; return r; };
      constexpr int TOTAL = 9;
#pragma unroll
      for (int i = 0; i < ATT_LA; ++i) issue_chunk(qkv, desc(i), koff, voff, lane, ring + i * 8192);
      run_branch<15>(qkv, desc, gi, TOTAL, 9, S, q0 - 128, koff, voff, q0 + qi, 0, 128, -mfixB, lane, ring, Q, o, l);
    }
#pragma unroll
    for (int t = 0; t < 4; ++t) {
      const float L = l[t][0];
      const float inv = 1.0f / L; float ss = 0.f;
#pragma unroll
      for (int dt = 0; dt < 4; ++dt)
#pragma unroll
        for (int j = 0; j < 4; ++j) { const float x = o[t][dt][j] * inv; o[t][dt][j] = x; ss += x * x; }
      ss += __shfl_xor(ss, 16); ss += __shfl_xor(ss, 32);
      const size_t row = (size_t)(row0 + tok[t]);
      if (g == 0) ssqh[row * 16 + (colb[t] >> 6)] = ss;
      bf16_t* dst = mix + row * DM + colb[t] + 4 * g;
#pragma unroll
      for (int dt = 0; dt < 4; ++dt) { u32x2 w; w.x = pk2(o[t][dt][0], o[t][dt][1]); w.y = pk2(o[t][dt][2], o[t][dt][3]); *(u32x2*)(dst + 16 * dt) = w; }
    }
  }
}

#define XB_TMO      128
#define XB_XCNT(j)  (256  + 64 * (j))
#define XB_XSUB(j)  (1280 + 64 * (j))
#define XB_XGEN(j)  (2304 + 64 * (j))
#define XB_TOP      3328
#define XB_TOPGEN   3392
#define XCD_BAR_WORDS 3456
#define XB_SPIN_CAP (1u << 18)
__device__ __forceinline__ unsigned xb_ld(unsigned* p)              { return __hip_atomic_load(p, __ATOMIC_RELAXED, __HIP_MEMORY_SCOPE_AGENT); }
__device__ __forceinline__ unsigned xb_add(unsigned* p, unsigned v) { return __hip_atomic_fetch_add(p, v, __ATOMIC_RELAXED, __HIP_MEMORY_SCOPE_AGENT); }
__device__ __forceinline__ unsigned xb_xcc_id() { return (unsigned)__builtin_amdgcn_s_getreg((3 << 11) | 20) & 0xFu; }
#define XB_SPIN(cond, bar) do { unsigned _sp = 0; while (cond) { __builtin_amdgcn_s_sleep(1); \
    if ((++_sp & 255u) == 0u) { if (xb_ld(&(bar)[XB_TMO])) break; if (_sp > XB_SPIN_CAP) { atomicAdd(&(bar)[XB_TMO], 1u); break; } } } } while (0)
struct XcdBarrier { unsigned* bar; unsigned x; volatile LAS unsigned* st; };
__device__ __forceinline__ XcdBarrier xcd_barrier_post(unsigned* bar, volatile LAS unsigned* st) {
  XcdBarrier b; b.bar = bar; b.x = xb_xcc_id(); b.st = st;
  if (threadIdx.x == 0) (void)xb_add(&bar[XB_XCNT(b.x)], 1u);
  return b;
}
__device__ __forceinline__ void xcd_barrier_complete(unsigned* bar, unsigned x, unsigned& nloc, unsigned& nx) {
  const unsigned G = gridDim.x * gridDim.y * gridDim.z;
  unsigned sum, cnt, mine, sp = 0u;
  for (;;) {
    sum = 0u; cnt = 0u; mine = 0u;
#pragma unroll
    for (unsigned j = 0; j < 16; ++j) { const unsigned c = xb_ld(&bar[XB_XCNT(j)]); sum += c; cnt += (c > 0u) ? 1u : 0u; mine = (j == x) ? c : mine; }
    if (sum == G) break;
    __builtin_amdgcn_s_sleep(1);
    if ((++sp & 255u) == 0u) { if (xb_ld(&bar[XB_TMO])) break; if (sp > XB_SPIN_CAP) { atomicAdd(&bar[XB_TMO], 1u); break; } }
  }
  nloc = mine > 0u ? mine : 1u; nx = cnt > 0u ? cnt : 1u;
}
__device__ __forceinline__ void xcd_barrier_impl(const XcdBarrier& b) {
  asm volatile("s_waitcnt vmcnt(0)" ::: "memory");
  __syncthreads();
  if (threadIdx.x == 0) {
    unsigned* bar = b.bar;
    __builtin_amdgcn_s_waitcnt(0);
    unsigned nloc = b.st[0], nx = b.st[1];
    if (nloc == 0u) { xcd_barrier_complete(bar, b.x, nloc, nx); b.st[0] = nloc; b.st[1] = nx; }
    const unsigned old = xb_add(&bar[XB_XSUB(b.x)], 1u);
    const unsigned gen = old / nloc;
    if (old + 1u == (gen + 1u) * nloc) {
      __builtin_amdgcn_fence(__ATOMIC_RELEASE, "agent");
      asm volatile("s_waitcnt vmcnt(0)" ::: "memory");
      const unsigned og = xb_add(&bar[XB_TOP], 1u);
      const unsigned tg = og / nx;
      if (og + 1u == (tg + 1u) * nx) xb_add(&bar[XB_TOPGEN], 1u);
      else XB_SPIN(xb_ld(&bar[XB_TOPGEN]) == tg, bar);
      __builtin_amdgcn_fence(__ATOMIC_ACQUIRE, "agent");
      xb_add(&bar[XB_XGEN(b.x)], 1u);
      asm volatile("s_waitcnt vmcnt(0)" ::: "memory");
    } else {
      XB_SPIN(xb_ld(&bar[XB_XGEN(b.x)]) == gen, bar);
      __builtin_amdgcn_fence(__ATOMIC_ACQUIRE, "agent");
      asm volatile("s_waitcnt vmcnt(0)" ::: "memory");
    }
  }
  __syncthreads();
}

__device__ __forceinline__ void xcd_barrier(unsigned char* ws) {
  XcdBarrier b; b.bar = (unsigned*)(ws + WS_BAR); b.x = xb_xcc_id(); b.st = (volatile LAS unsigned*)((LAS unsigned char*)g_shm + GEMM_LDS_BYTES);
  xcd_barrier_impl(b);
}

typedef const __attribute__((address_space(4))) Params* KArgs;
__device__ __forceinline__ Params load_params() {
#if defined(__HIP_DEVICE_COMPILE__)
  KArgs kp = (KArgs)__builtin_amdgcn_kernarg_segment_ptr();
  asm volatile("" : "+s"(kp));
  Params r;
  r.xp = kp->xp; r.xs = kp->xs; r.norm_attn = kp->norm_attn; r.w_in = kp->w_in; r.qna = kp->qna; r.kna = kp->kna; r.qnb = kp->qnb; r.knb = kp->knb; r.sink = kp->sink;
  r.ona = kp->ona; r.onb = kp->onb; r.w_o = kp->w_o; r.norm_mlp = kp->norm_mlp; r.w_up = kp->w_up; r.w_down = kp->w_down; r.out = kp->out; r.ws = kp->ws;
  return r;
#else
  return Params{};
#endif
}

__global__ void __launch_bounds__(512) fwd_megakernel(Params p_unused) {
  cg::grid_group grid = cg::this_grid();
  {
    const Params p = load_params();
    volatile LAS unsigned* xst = (volatile LAS unsigned*)((LAS unsigned char*)g_shm + GEMM_LDS_BYTES);
    if (threadIdx.x == 0) { xst[0] = 0u; xst[1] = 0u; }
    (void)xcd_barrier_post((unsigned*)(p.ws + WS_BAR), xst);
    p0_prologue(p);
    if (p.ws == nullptr) grid.sync();
    xcd_barrier(p.ws);
  }
  {
    const Params p = load_params();
    EpiQKV e{(bf16_t*)(p.ws + WS_QKV), (const float*)(p.ws + WS_RS1), p.qna, p.kna, p.qnb, p.knb};
    gemm_phase<EpiQKV, GEMM_ALIGN, GEMM_SP2>((const bf16_t*)(p.ws + WS_X), (const bf16_t*)(p.ws + WS_WIN), NTOK, INC, DM, e);
    xcd_barrier(p.ws);
  }
  {
    const Params p = load_params();
    attn_phase(p);
    xcd_barrier(p.ws);
  }
  {
    const Params p = load_params();
    EpiWo e{p.xp, p.xs, (bf16_t*)(p.ws + WS_HB), (float*)(p.ws + WS_SSQ2), (const float*)(p.ws + WS_SSQH)};
    gemm_phase<EpiWo, GEMM_ALIGN, GEMM_SP2, true>((const bf16_t*)(p.ws + WS_X), (const bf16_t*)(p.ws + WS_WO), NTOK, DM, DM, e);
    xcd_barrier(p.ws);
    { const float* sp = (const float*)(p.ws + WS_SSQ2); float* s2 = (float*)(p.ws + WS_RS1);
      for (int row = blockIdx.x * 512 + threadIdx.x; row < NTOK; row += gridDim.x * 512) {
        const f32x4 a = *(const f32x4*)(sp + (size_t)row * 16), b = *(const f32x4*)(sp + (size_t)row * 16 + 4), c = *(const f32x4*)(sp + (size_t)row * 16 + 8), d = *(const f32x4*)(sp + (size_t)row * 16 + 12);
        const float tot = (((a[0] + a[1]) + (a[2] + a[3])) + ((b[0] + b[1]) + (b[2] + b[3]))) + (((c[0] + c[1]) + (c[2] + c[3])) + ((d[0] + d[1]) + (d[2] + d[3])));
        s2[row] = rsqrtf(tot * (1.0f / DM) + EPS);
      } }
    xcd_barrier(p.ws);
  }
  for (int half = 0; half < 2; ++half) {
    const int rb = half * NPROMPT;
    {
      const Params p = load_params();
      EpiUp e{(bf16_t*)(p.ws + WS_U)};
      gemm_phase<EpiUp, GEMM_ALIGN, GEMM_SP2>((const bf16_t*)(p.ws + WS_HB) + (size_t)rb * DM, (const bf16_t*)(p.ws + WS_WUP), NPROMPT, DFF, DM, e);
      xcd_barrier(p.ws);
    }
    {
      const Params p = load_params();
      EpiDown e{(const bf16_t*)(p.ws + WS_HB), p.out, (const float*)(p.ws + WS_RS1), rb};
      gemm_phase<EpiDown, GEMM_ALIGN, GEMM_SP2>((const bf16_t*)(p.ws + WS_U), (const bf16_t*)(p.ws + WS_WD), NPROMPT, DM, DFF, e);
      if (half == 0) xcd_barrier(p.ws);
    }
  }
}

extern "C" void kernel_launch(void* const* d_in, const int* in_sizes, int n_in, void* d_out, int out_size, void* d_ws, size_t ws_size, hipStream_t stream) {
  static int grid_blocks = 0;
  if (!grid_blocks) {
    if (n_in != 15 || ws_size < WS_NEED) { fprintf(stderr, "kernel_launch: unexpected n_in %d / ws_size %zu\n", n_in, ws_size); grid_blocks = -1; return; }
    int dev = 0, cus = 0, per_cu = 0;
    hipGetDevice(&dev);
    hipDeviceGetAttribute(&cus, hipDeviceAttributeMultiprocessorCount, dev);
    if (hipFuncSetAttribute((const void*)fwd_megakernel, hipFuncAttributeMaxDynamicSharedMemorySize, LDS_BYTES) != hipSuccess) { fprintf(stderr, "hipFuncSetAttribute failed\n"); grid_blocks = -1; return; }
    hipOccupancyMaxActiveBlocksPerMultiprocessor(&per_cu, (const void*)fwd_megakernel, 512, LDS_BYTES);
    if (per_cu < 1) { fprintf(stderr, "occupancy query says %d blocks/CU\n", per_cu); per_cu = 1; }
    (void)hipGetLastError();
    grid_blocks = cus;
  }
  if (grid_blocks < 0) return;
  if (hipMemsetAsync((char*)d_ws + WS_BAR, 0, 16384, stream) != hipSuccess) { fprintf(stderr, "hipMemsetAsync of the barrier words failed\n"); return; }
  Params p{};
  p.xp = (const float*)d_in[0]; p.xs = (const float*)d_in[1]; p.norm_attn = (const float*)d_in[2]; p.w_in = (const float*)d_in[3];
  p.qna = (const float*)d_in[4]; p.kna = (const float*)d_in[5]; p.qnb = (const float*)d_in[6]; p.knb = (const float*)d_in[7];
  p.sink = (const float*)d_in[8]; p.ona = (const float*)d_in[9]; p.onb = (const float*)d_in[10]; p.w_o = (const float*)d_in[11];
  p.norm_mlp = (const float*)d_in[12]; p.w_up = (const float*)d_in[13]; p.w_down = (const float*)d_in[14];
  p.out = (float*)d_out; p.ws = (unsigned char*)d_ws;
  void* args[] = {&p};
  hipError_t e = hipLaunchCooperativeKernel((const void*)fwd_megakernel, dim3(grid_blocks), dim3(512), args, LDS_BYTES, stream);
  if (e != hipSuccess) fprintf(stderr, "cooperative launch failed: %s (grid %d)\n", hipGetErrorString(e), grid_blocks);
}
```

```cpp
#include <hip/hip_runtime.h>
#include <hip/hip_cooperative_groups.h>
#include <cstdio>
#include <cstdint>
namespace cg = cooperative_groups;

typedef unsigned short bf16_t;
typedef short bf16x8 __attribute__((ext_vector_type(8)));
typedef float f32x4 __attribute__((ext_vector_type(4)));
typedef unsigned u32x4 __attribute__((ext_vector_type(4)));
typedef unsigned u32x2 __attribute__((ext_vector_type(2)));

constexpr int DM = 1024, NTOK = 65536, NPROMPT = 32768, INC = 2304, DFF = 4096;
constexpr float EPS = 1e-6f;
constexpr float LOG2E = 1.4426950408889634f;
constexpr float QSCALE = 0.18033688011112042f;

constexpr size_t MiB = 1048576;
constexpr size_t WS_WIN = 0, WS_WO = 4718592, WS_WUP = 6815744, WS_WD = 15204352, WS_RS1 = 23592960, WS_SSQ2 = 440 * MiB;
constexpr size_t WS_X = 24 * MiB;
constexpr size_t WS_QKV = 152 * MiB;
constexpr size_t WS_HB = 312 * MiB;
constexpr size_t WS_U = 24 * MiB;
constexpr size_t WS_SSQH = 444 * MiB;
constexpr size_t WS_BAR = 448 * MiB;
constexpr size_t WS_NEED = 449 * MiB;

constexpr int GEMM_LDS_BYTES = 131072, LDS_BYTES = GEMM_LDS_BYTES + 64;
constexpr bool GEMM_ALIGN = true, GEMM_SP2 = true;
constexpr int ATT_NACT = 8;
constexpr int ATT_SLOTS = 16 / ATT_NACT, ATT_LA = ATT_SLOTS - 1;

struct Params {
  const float *xp, *xs, *norm_attn, *w_in, *qna, *kna, *qnb, *knb, *sink, *ona, *onb, *w_o, *norm_mlp, *w_up, *w_down;
  float* out;
  unsigned char* ws;
};

extern __shared__ __attribute__((aligned(16))) unsigned char g_shm[];

typedef __bf16 bf16v2_t __attribute__((ext_vector_type(2)));
typedef float f32v2_t __attribute__((ext_vector_type(2)));
__device__ __forceinline__ unsigned pk2(float lo, float hi) { const f32v2_t f = {lo, hi}; const bf16v2_t b = __builtin_convertvector(f, bf16v2_t); return __builtin_bit_cast(unsigned, b); }
__device__ __forceinline__ float bf2f(unsigned short b) { return __uint_as_float(((unsigned)b) << 16); }
__device__ __forceinline__ f32x4 mfma16(bf16x8 a, bf16x8 b, f32x4 c) { return __builtin_amdgcn_mfma_f32_16x16x32_bf16(a, b, c, 0, 0, 0); }

__device__ __forceinline__ int col_slot(int c, int mode) {
  if (mode == 0) return 128 * ((c >> 3) & 1) + 32 * (c >> 6) + 16 * ((c >> 2) & 1) + 4 * ((c >> 4) & 3) + (c & 3);
  if (mode == 1) return 128 * ((c >> 5) & 1) + 32 * (c >> 6) + 16 * ((c >> 2) & 1) + 4 * ((c >> 3) & 3) + (c & 3);
  return c;
}

constexpr int BM = 256, BK = 64, HALF = 128, HT = HALF * BK;
__device__ __forceinline__ int lds_byte(int r, int c) {
  int st = (r >> 4) * 2 + (c >> 5), rr = r & 15, cc = c & 31, ob = rr * 64 + cc * 2;
  return st * 1024 + (ob ^ (((ob >> 9) & 1) << 5));
}
__device__ __forceinline__ void stage_rc(int b, int& R, int& C) {
  int st = b / 1024, sb = b % 1024, swz = sb ^ (((sb >> 9) & 1) << 5);
  R = (st >> 1) * 16 + swz / 64; C = (st & 1) * 32 + (swz % 64) / 2;
}

__device__ __forceinline__ bool tile_of(int L, int nM, int nN, int& pm, int& pn) {
  const int nwg = nM * nN; if (L >= nwg) return false;
  int wgid = L; { const int q = nwg / 8, r = nwg % 8, xcd = wgid % 8, off = wgid / 8; wgid = (xcd < r ? xcd * (q + 1) : r * (q + 1) + (xcd - r) * q) + off; }
  const int nig = 8 * nN, gid = wgid / nig, fm = gid * 8, gsz = (nM - fm) < 8 ? (nM - fm) : 8;
  pm = fm + ((wgid % nig) % gsz); pn = (wgid % nig) / gsz; return true;
}
#define LAS __attribute__((address_space(3)))
template <class Epi, bool ALIGN_EPI, bool SP2, bool MID = false>
__device__ __forceinline__ void gemm_phase(const bf16_t* __restrict__ Ag, const bf16_t* __restrict__ Btg, const int M, const int N, const int K, const Epi& E) {
  LAS unsigned char* lds = (LAS unsigned char*)g_shm;
  int tid = threadIdx.x; asm volatile("" : "+v"(tid));
  const int wid = __builtin_amdgcn_readfirstlane(tid >> 6), lane = tid & 63, wr = wid >> 2, wc = wid & 3, fr = lane & 15, fq = lane >> 4;
  const int nt = K / BK, nM = M / BM, nN = N / BM, G = gridDim.x, cu = blockIdx.x;
  constexpr int HTB = HALF * BK * 2;
  unsigned voff[2];
#pragma unroll
  for (int i = 0; i < 2; ++i) { int R, C; stage_rc(tid * 16 + i * 8192, R, C); voff[i] = (unsigned)(R * K + C) * 2u; }
  const size_t kstep = (size_t)(BK * 2), hstep = (size_t)HALF * K * 2, tstep = 2 * hstep;
  const unsigned ldsw = (unsigned)wid * 1024u;
  const int aoff = lds_byte(wr * 64 + fr, fq * 8), boff = lds_byte(wc * 32 + fr, fq * 8);
#define PG8_SA(b, h) (((b) * 2 + (h)) * HTB)
#define PG8_SB(b, h) ((4 + (b) * 2 + (h)) * HTB)
#define PG8_STAGE(bufoff, gbase) do { _Pragma("unroll") for (int _i = 0; _i < 2; ++_i) \
    __builtin_amdgcn_global_load_lds((const __attribute__((address_space(1))) unsigned*)((const char*)(gbase) + voff[_i]), (LAS unsigned*)(lds + (bufoff) + ldsw + _i * 8192), 16, 0, 0); } while (0)
#define PG8_LDA(dst, b, h) do { _Pragma("unroll") for (int m = 0; m < 4; ++m) _Pragma("unroll") for (int k = 0; k < 2; ++k) dst[m][k] = *(const LAS bf16x8*)(lds + PG8_SA(b, h) + aoff + m * 2048 + k * 1024); } while (0)
#define PG8_LDB(dst, b, h) do { _Pragma("unroll") for (int n = 0; n < 2; ++n) _Pragma("unroll") for (int k = 0; k < 2; ++k) dst[n][k] = *(const LAS bf16x8*)(lds + PG8_SB(b, h) + boff + n * 2048 + k * 1024); } while (0)
#define PG8_MMA(ai, bj, At, Bt) do { __builtin_amdgcn_s_setprio(1); _Pragma("unroll") for (int m = 0; m < 4; ++m) _Pragma("unroll") for (int n = 0; n < 2; ++n) _Pragma("unroll") for (int k = 0; k < 2; ++k) \
    acc[ai][bj][m][n] = __builtin_amdgcn_mfma_f32_16x16x32_bf16(Bt[n][k], At[m][k], acc[ai][bj][m][n], 0, 0, 0); __builtin_amdgcn_s_setprio(0); } while (0)
#define PG8_WAIT_V(n) asm volatile("s_waitcnt vmcnt(" #n ")" ::: "memory")
#define PG8_WAIT_L(n) asm volatile("s_waitcnt lgkmcnt(" #n ")" ::: "memory")
#define PG8_BAR __builtin_amdgcn_s_barrier()
#define PG8_SCHED __builtin_amdgcn_sched_barrier(0)
  int cpm, cpn, npm = 0, npn = 0, ui = 0;
  if (!tile_of(cu, nM, nN, cpm, cpn)) return;
  f32x4 acc[2][2][4][2];
#pragma unroll
  for (int a = 0; a < 2; ++a)
#pragma unroll
    for (int b = 0; b < 2; ++b)
#pragma unroll
      for (int m = 0; m < 4; ++m)
#pragma unroll
        for (int n = 0; n < 2; ++n) acc[a][b][m][n] = (f32x4){0.f, 0.f, 0.f, 0.f};
  bf16x8 At[4][2], B0[2][2], B1[2][2];
  const char* cA = (const char*)Ag + (size_t)cpm * tstep; const char* cB = (const char*)Btg + (size_t)cpn * tstep;
  static_assert(SP2, "this body is the two-super-phase loop");
  PG8_STAGE(PG8_SB(0, 0), cB); PG8_STAGE(PG8_SB(0, 1), cB + hstep); PG8_STAGE(PG8_SA(0, 0), cA); PG8_STAGE(PG8_SA(0, 1), cA + hstep);
  PG8_STAGE(PG8_SB(1, 0), cB + kstep); PG8_STAGE(PG8_SA(1, 0), cA + kstep); PG8_STAGE(PG8_SB(1, 1), cB + hstep + kstep);
  if (wr == 1) PG8_BAR;
  PG8_WAIT_V(0); PG8_BAR;
  PG8_BAR;
#define K2_ITER(FIRST) do { \
      const bool last = (t == nt - 2); \
      const char* a1 = cA + (size_t)(t + 1) * kstep; \
      const char* a2 = last ? nA : cA + (size_t)(t + 2) * kstep; const char* b2 = last ? nB : cB + (size_t)(t + 2) * kstep; \
      const char* a3 = a2 + kstep; const char* b3 = b2 + kstep; \
      if constexpr (MID) { if (t == (nt >> 1)) E.mid(acc, cpm * BM); } \
      PG8_LDB(B0, 0, 0); PG8_LDB(B1, 0, 1); PG8_SCHED; PG8_LDA(At, 0, 0); PG8_STAGE(PG8_SA(1, 1), a1 + hstep); \
      if constexpr (!(FIRST)) PG8_WAIT_V(8); \
      PG8_WAIT_L(0); PG8_BAR; PG8_MMA(0, 0, At, B0); PG8_MMA(0, 1, At, B1); PG8_BAR; PG8_SCHED; \
      PG8_LDA(At, 0, 1); PG8_STAGE(PG8_SB(0, 0), b2); PG8_STAGE(PG8_SB(0, 1), b2 + hstep); PG8_STAGE(PG8_SA(0, 0), a2); \
      if constexpr (!(FIRST)) PG8_WAIT_V(8); \
      PG8_WAIT_L(0); PG8_BAR; PG8_MMA(1, 0, At, B0); PG8_MMA(1, 1, At, B1); PG8_BAR; PG8_SCHED; \
      PG8_LDB(B0, 1, 0); PG8_LDB(B1, 1, 1); PG8_SCHED; PG8_LDA(At, 1, 0); PG8_STAGE(PG8_SA(0, 1), a2 + hstep); \
      PG8_WAIT_V(8); PG8_WAIT_L(0); PG8_BAR; PG8_MMA(0, 0, At, B0); PG8_MMA(0, 1, At, B1); PG8_BAR; PG8_SCHED; \
      PG8_LDA(At, 1, 1); PG8_STAGE(PG8_SB(1, 0), b3); PG8_STAGE(PG8_SB(1, 1), b3 + hstep); PG8_STAGE(PG8_SA(1, 0), a3); \
      PG8_WAIT_V(8); PG8_WAIT_L(0); PG8_BAR; PG8_MMA(1, 0, At, B0); PG8_MMA(1, 1, At, B1); PG8_BAR; PG8_SCHED; \
    } while (0)
  for (;;) {
    const bool has_next = tile_of((ui + 1) * G + cu, nM, nN, npm, npn);
    const char* nA = has_next ? (const char*)Ag + (size_t)npm * tstep : cA; const char* nB = has_next ? (const char*)Btg + (size_t)npn * tstep : cB;
    { const int t = 0; K2_ITER(true); }
    for (int t = 2; t < nt; t += 2) K2_ITER(false);
    const typename Epi::Pre pre = E.pre(cpm * BM, cpn * BM);
    if constexpr (ALIGN_EPI) { if (wr == 0) PG8_BAR; }
    PG8_WAIT_V(0);
    E(acc, cpm * BM, cpn * BM, pre);
    if (!has_next) break;
#pragma unroll
    for (int a = 0; a < 2; ++a)
#pragma unroll
      for (int b = 0; b < 2; ++b)
#pragma unroll
        for (int m = 0; m < 4; ++m)
#pragma unroll
          for (int n = 0; n < 2; ++n) acc[a][b][m][n] = (f32x4){0.f, 0.f, 0.f, 0.f};
    cpm = npm; cpn = npn; cA = nA; cB = nB; ++ui;
    if constexpr (ALIGN_EPI) { if (wr == 1) PG8_BAR; }
  }
  PG8_WAIT_V(0);
  if constexpr (!ALIGN_EPI) { if (wr == 0) PG8_BAR; }
  PG8_BAR;
#undef K2_ITER
#undef PG8_SA
#undef PG8_SB
#undef PG8_STAGE
#undef PG8_LDA
#undef PG8_LDB
#undef PG8_MMA
}

#define EPI_IDS \
    int tid_ = threadIdx.x; asm volatile("" : "+v"(tid_));     \
    const int wid_ = tid_ >> 6, lane_ = tid_ & 63, wr = wid_ >> 2, wc = wid_ & 3, fr = lane_ & 15, fq = lane_ >> 4;
#define PACK16(v, w0, w1) \
    w0.x = pk2(v[0], v[1]); w0.y = pk2(v[2], v[3]); w0.z = pk2(v[4], v[5]); w0.w = pk2(v[6], v[7]); \
    w1.x = pk2(v[8], v[9]); w1.y = pk2(v[10], v[11]); w1.z = pk2(v[12], v[13]); w1.w = pk2(v[14], v[15]);

struct EpiQKV {
  bf16_t* qkv; const float* rs1; const float *qna, *kna, *qnb, *knb;
  struct Pre { float rs[8]; float gn[16]; };
  __device__ __forceinline__ Pre pre(int brow, int bcol) const {
    EPI_IDS
    (void)fr;
    Pre r;
    const int ct = bcol >> 8;
    const float* gp = nullptr; float extra = 1.f;
    if (ct < 2) { gp = qna; extra = QSCALE; } else if (ct < 4) gp = kna; else if (ct < 6) gp = nullptr; else if (ct < 8) { gp = qnb; extra = QSCALE; } else gp = (wc < 2) ? knb : nullptr;
#pragma unroll
    for (int i = 0; i < 16; ++i) r.gn[i] = gp ? gp[32 * (i >> 3) + 8 * fq + (i & 7)] * extra : 0.f;
#pragma unroll
    for (int k = 0; k < 8; ++k) r.rs[k] = rs1[brow + (k >> 2) * HALF + wr * 64 + (k & 3) * 16 + fr];
    return r;
  }
  __device__ __forceinline__ void operator()(const f32x4 (&acc)[2][2][4][2], int brow, int bcol, const Pre& pre) const {
    EPI_IDS
    const int ct = bcol >> 8;
    const bool gp = !(ct == 4 || ct == 5 || (ct == 8 && wc >= 2));
    const int smask = (brow < NPROMPT) ? 2047 : 4095;
#pragma unroll
    for (int ai = 0; ai < 2; ++ai)
#pragma unroll
      for (int m = 0; m < 4; ++m) {
        const int row = brow + ai * HALF + wr * 64 + m * 16 + fr;
        const float rs = pre.rs[ai * 4 + m];
        float v[16];
#pragma unroll
        for (int bj = 0; bj < 2; ++bj)
#pragma unroll
          for (int n = 0; n < 2; ++n)
#pragma unroll
            for (int j = 0; j < 4; ++j) v[8 * bj + 4 * n + j] = acc[ai][bj][m][n][j] * rs;
        if (gp) {
          float ss = 0.f;
#pragma unroll
          for (int i = 0; i < 16; ++i) ss += v[i] * v[i];
          ss += __shfl_xor(ss, 16); ss += __shfl_xor(ss, 32);
          const float inv = rsqrtf(ss * (1.0f / 64.0f) + EPS);
#pragma unroll
          for (int i = 0; i < 16; ++i) v[i] = v[i] * inv * pre.gn[i];
          {
            const float pos = (float)(row & smask);
            const float sgn = fq == 0 ? -1.0f : 1.0f;
#pragma unroll
            for (int i = 0; i < 8; ++i) {
              const float ci = i == 0 ? 1.5915494309e-01f : i == 1 ? 3.0863763405e-02f : i == 2 ? 5.9851857127e-03f : i == 3 ? 1.1606636412e-03f : i == 4 ? 2.2507907904e-04f : i == 5 ? 4.3647952793e-05f : i == 6 ? 8.4643308082e-06f : 1.6414262628e-06f;
              const float vp = __shfl_xor(v[i], 16);
              const float tr = __builtin_amdgcn_fractf(pos * ci);
              const float c = __builtin_amdgcn_cosf(tr), s = __builtin_amdgcn_sinf(tr);
              const float r = v[i] * c + sgn * (vp * s);
              v[i] = fq < 2 ? r : v[i];
            }
          }
        }
        u32x4 w0, w1; PACK16(v, w0, w1)
        bf16_t* dst = qkv + (size_t)row * INC + bcol + 64 * wc + 8 * fq;
        *(u32x4*)dst = w0; *(u32x4*)(dst + 32) = w1;
      }
  }
};

struct EpiWo {
  const float *xp, *xs; bf16_t* hb; float* ssq2p; const float* ssqh;
  __device__ __forceinline__ void scales(int row, float& sa, float& sb) const {
    const float* sp = ssqh + (size_t)row * 16;
    const f32x4 a = *(const f32x4*)sp, b = *(const f32x4*)(sp + 4), c = *(const f32x4*)(sp + 8), d = *(const f32x4*)(sp + 12);
    sa = rsqrtf((((a[0] + a[1]) + (a[2] + a[3])) + ((b[0] + b[1]) + (b[2] + b[3]))) * (1.0f / 512.0f) + EPS);
    sb = rsqrtf((((c[0] + c[1]) + (c[2] + c[3])) + ((d[0] + d[1]) + (d[2] + d[3]))) * (1.0f / 512.0f) + EPS);
  }
  __device__ __forceinline__ void mid(f32x4 (&acc)[2][2][4][2], int brow) const {
    EPI_IDS
    (void)wc; (void)fq;
#pragma unroll
    for (int ai = 0; ai < 2; ++ai)
#pragma unroll
      for (int m = 0; m < 4; ++m) {
        float sa, sb; scales(brow + ai * HALF + wr * 64 + m * 16 + fr, sa, sb);
        const float ratio = sa / sb;
#pragma unroll
        for (int bj = 0; bj < 2; ++bj)
#pragma unroll
          for (int n = 0; n < 2; ++n) acc[ai][bj][m][n] = acc[ai][bj][m][n] * ratio;
      }
  }
  struct Pre { f32x4 xv0[4][4]; };
  __device__ __forceinline__ Pre pre(int brow, int bcol) const {
    EPI_IDS
    Pre r;
    const float* xbase = (brow < NPROMPT) ? (xp + (size_t)brow * DM) : (xs + (size_t)(brow - NPROMPT) * DM);
#pragma unroll
    for (int m = 0; m < 4; ++m) {
      const float* xr = xbase + (size_t)(wr * 64 + m * 16 + fr) * DM + bcol + 64 * wc + 8 * fq;
#pragma unroll
      for (int q = 0; q < 4; ++q) r.xv0[m][q] = *(const f32x4*)(xr + 32 * (q >> 1) + 4 * (q & 1));
    }
    return r;
  }
  __device__ __forceinline__ void operator()(const f32x4 (&acc)[2][2][4][2], int brow, int bcol, const Pre& pre) const {
    EPI_IDS
    const float* xbase = (brow < NPROMPT) ? (xp + (size_t)brow * DM) : (xs + (size_t)(brow - NPROMPT) * DM);
#pragma unroll
    for (int ai = 0; ai < 2; ++ai) {
      f32x4 xv[4][4]; float sbv[4];
#pragma unroll
      for (int m = 0; m < 4; ++m) {
        const int rl = ai * HALF + wr * 64 + m * 16 + fr;
        const float* xr = xbase + (size_t)rl * DM + bcol + 64 * wc + 8 * fq;
#pragma unroll
        for (int q = 0; q < 4; ++q) xv[m][q] = ai == 0 ? pre.xv0[m][q] : *(const f32x4*)(xr + 32 * (q >> 1) + 4 * (q & 1));
        float sa; scales(brow + rl, sa, sbv[m]);
      }
#pragma unroll
      for (int m = 0; m < 4; ++m) {
        const int rl = ai * HALF + wr * 64 + m * 16 + fr;
        float v[16]; float ss = 0.f;
#pragma unroll
        for (int bj = 0; bj < 2; ++bj)
#pragma unroll
          for (int n = 0; n < 2; ++n)
#pragma unroll
            for (int j = 0; j < 4; ++j) { const float h = xv[m][2 * bj + n][j] + acc[ai][bj][m][n][j] * sbv[m]; v[8 * bj + 4 * n + j] = h; ss += h * h; }
        ss += __shfl_xor(ss, 16); ss += __shfl_xor(ss, 32);
        if (fq == 0) ssq2p[(size_t)(brow + rl) * 16 + (bcol >> 8) * 4 + wc] = ss;
        u32x4 w0, w1; PACK16(v, w0, w1)
        bf16_t* dst = hb + (size_t)(brow + rl) * DM + bcol + 64 * wc + 8 * fq;
        *(u32x4*)dst = w0; *(u32x4*)(dst + 32) = w1;
      }
      __builtin_amdgcn_sched_barrier(0);
    }
  }
};

struct EpiUp {
  bf16_t* u;
  struct Pre {};
  __device__ __forceinline__ Pre pre(int, int) const { return Pre{}; }
  __device__ __forceinline__ void operator()(const f32x4 (&acc)[2][2][4][2], int brow, int bcol, const Pre&) const {
    EPI_IDS
#pragma unroll
    for (int ai = 0; ai < 2; ++ai)
#pragma unroll
      for (int m = 0; m < 4; ++m) {
        const int rl = brow + ai * HALF + wr * 64 + m * 16 + fr;
        float v[16];
#pragma unroll
        for (int bj = 0; bj < 2; ++bj)
#pragma unroll
          for (int n = 0; n < 2; ++n) {
            f32x4 z = acc[ai][bj][m][n];
#pragma unroll
            for (int j = 0; j < 4; ++j) z[j] = fmaxf(z[j], 0.f);
            z = z * z;
#pragma unroll
            for (int j = 0; j < 4; ++j) v[8 * bj + 4 * n + j] = z[j];
          }
        u32x4 w0, w1; PACK16(v, w0, w1)
        bf16_t* dst = u + (size_t)rl * DFF + bcol + 64 * wc + 8 * fq;
        *(u32x4*)dst = w0; *(u32x4*)(dst + 32) = w1;
      }
  }
};

struct EpiDown {
  const bf16_t* hb; float* out; const float* s2; int row_base;
  struct Pre { u32x2 hv[2][4][2][2]; float sq[8]; };
  __device__ __forceinline__ Pre pre(int brow, int bcol) const {
    EPI_IDS
    Pre r;
#pragma unroll
    for (int ai = 0; ai < 2; ++ai)
#pragma unroll
      for (int m = 0; m < 4; ++m) {
        const size_t off = (size_t)(row_base + brow + ai * HALF + wr * 64 + m * 16 + fr) * DM + bcol + 32 * wc + 4 * fq;
#pragma unroll
        for (int bj = 0; bj < 2; ++bj)
#pragma unroll
          for (int n = 0; n < 2; ++n) r.hv[ai][m][bj][n] = *(const u32x2*)(hb + off + 128 * bj + 16 * n);
        const float s = s2[row_base + brow + ai * HALF + wr * 64 + m * 16 + fr]; r.sq[ai * 4 + m] = s * s;
      }
    return r;
  }
  __device__ __forceinline__ void operator()(const f32x4 (&acc)[2][2][4][2], int brow, int bcol, const Pre& pre) const {
    EPI_IDS
#pragma unroll
    for (int ai = 0; ai < 2; ++ai)
#pragma unroll
      for (int m = 0; m < 4; ++m) {
        const size_t off = (size_t)(row_base + brow + ai * HALF + wr * 64 + m * 16 + fr) * DM + bcol + 32 * wc + 4 * fq;
        float* dst = out + off; const float sq = pre.sq[ai * 4 + m];
#pragma unroll
        for (int bj = 0; bj < 2; ++bj)
#pragma unroll
          for (int n = 0; n < 2; ++n) {
            const unsigned a = pre.hv[ai][m][bj][n].x, b = pre.hv[ai][m][bj][n].y;
            f32x4 o;
            o[0] = __uint_as_float(a << 16) + acc[ai][bj][m][n][0] * sq; o[1] = __uint_as_float(a & 0xffff0000u) + acc[ai][bj][m][n][1] * sq;
            o[2] = __uint_as_float(b << 16) + acc[ai][bj][m][n][2] * sq; o[3] = __uint_as_float(b & 0xffff0000u) + acc[ai][bj][m][n][3] * sq;
            *(f32x4*)(dst + 128 * bj + 16 * n) = o;
          }
      }
  }
};

__device__ __forceinline__ void p0_transpose_item(const float* __restrict__ W, int K, int N, bf16_t* __restrict__ WT, const float* __restrict__ g0, const float* __restrict__ g1, float* scr, int item, int lane, int mode) {
  const int nblk = N / 32, kb = item / nblk, nb = item % nblk, k0 = 64 * kb, n0 = 32 * nb;
#pragma unroll 8
  for (int i = 0; i < 32; ++i) {
    const int kk = 2 * i + (lane >> 5), k = k0 + kk;
    float gv = 1.f; if (g0) gv = (g1 && k >= 512) ? g1[k - 512] : g0[k];
    scr[kk * 33 + (lane & 31)] = W[(size_t)k * N + n0 + (lane & 31)] * gv;
  }
  asm volatile("s_waitcnt lgkmcnt(0)" ::: "memory");
  const int c = lane & 7;
#pragma unroll
  for (int j = 0; j < 4; ++j) {
    const int n = (lane >> 3) + 8 * j; const float* s = scr + (8 * c) * 33 + n;
    u32x4 o; o.x = pk2(s[0 * 33], s[1 * 33]); o.y = pk2(s[2 * 33], s[3 * 33]); o.z = pk2(s[4 * 33], s[5 * 33]); o.w = pk2(s[6 * 33], s[7 * 33]);
    const int col = n0 + n, drow = (col & ~255) + col_slot(col & 255, mode);
    *(u32x4*)(WT + (size_t)drow * K + k0 + 8 * c) = o;
  }
  asm volatile("s_waitcnt lgkmcnt(0)" ::: "memory");
}

__device__ __forceinline__ void p0_prologue(const Params& p) {
  int tid = threadIdx.x; asm volatile("" : "+v"(tid));
  const int wave = tid >> 6, lane = tid & 63;
  const int gw = blockIdx.x * 8 + wave, NGW = gridDim.x * 8;
  float* scr = (float*)(g_shm + wave * 16384);
  bf16_t* WinT = (bf16_t*)(p.ws + WS_WIN); bf16_t* WoT = (bf16_t*)(p.ws + WS_WO); bf16_t* WupT = (bf16_t*)(p.ws + WS_WUP); bf16_t* WdT = (bf16_t*)(p.ws + WS_WD);
  constexpr int I_IN = 16 * 72, I_O = 16 * 32, I_UP = 16 * 128, I_DN = 64 * 32, NIT = I_IN + I_O + I_UP + I_DN;
  for (int it = gw; it < NIT; it += NGW) {
    int r = it;
    if (r < I_IN) { p0_transpose_item(p.w_in, DM, INC, WinT, p.norm_attn, nullptr, scr, r, lane, 1); continue; } r -= I_IN;
    if (r < I_O) { p0_transpose_item(p.w_o, DM, DM, WoT, p.ona, p.onb, scr, r, lane, 1); continue; } r -= I_O;
    if (r < I_UP) { p0_transpose_item(p.w_up, DM, DFF, WupT, p.norm_mlp, nullptr, scr, r, lane, 1); continue; } r -= I_UP;
    p0_transpose_item(p.w_down, DFF, DM, WdT, nullptr, nullptr, scr, r, lane, 2);
  }
  bf16_t* xb = (bf16_t*)(p.ws + WS_X); float* rs1 = (float*)(p.ws + WS_RS1);
  for (int row4 = gw * 4; row4 < NTOK; row4 += NGW * 4) {
    f32x4 v[4][4];
#pragma unroll
    for (int r = 0; r < 4; ++r) {
      const int row = row4 + r;
      const float* xr = (row < NPROMPT) ? (p.xp + (size_t)row * DM) : (p.xs + (size_t)(row - NPROMPT) * DM);
#pragma unroll
      for (int j = 0; j < 4; ++j) v[r][j] = __builtin_nontemporal_load((const f32x4*)(xr + 256 * j + 4 * lane));
    }
#pragma unroll
    for (int r = 0; r < 4; ++r) {
      const int row = row4 + r; float s = 0.f;
#pragma unroll
      for (int j = 0; j < 4; ++j) s += (v[r][j][0] * v[r][j][0] + v[r][j][1] * v[r][j][1]) + (v[r][j][2] * v[r][j][2] + v[r][j][3] * v[r][j][3]);
#pragma unroll
      for (int o = 1; o < 64; o <<= 1) s += __shfl_xor(s, o);
#pragma unroll
      for (int j = 0; j < 4; ++j) { u32x2 w; w.x = pk2(v[r][j][0], v[r][j][1]); w.y = pk2(v[r][j][2], v[r][j][3]); *(u32x2*)(xb + (size_t)row * DM + 256 * j + 4 * lane) = w; }
      if (lane == 0) rs1[row] = rsqrtf(s * (1.0f / DM) + EPS);
    }
  }
}

struct ChunkSrc { int rowc, d, M, kc0; };

__device__ __forceinline__ void issue_chunk(const bf16_t* __restrict__ qkv, const ChunkSrc cs, int koff, int voff, int lane, unsigned char* slot) {
  const unsigned ck = (unsigned)(koff * 2), cv = (unsigned)(voff * 2);
#pragma unroll
  for (int i = 0; i < 4; ++i) {
    const int r = (lane >> 3) + 8 * i;
    int kc = cs.kc0 + r; kc = kc < 0 ? 0 : (kc > cs.M - 1 ? cs.M - 1 : kc);
    const unsigned row = __umul24((unsigned)cs.d, (unsigned)kc) + (unsigned)cs.rowc;
    const unsigned rb = __umul24(row, (unsigned)(INC * 2));
    const unsigned chk = (unsigned)(((lane & 7) ^ ((r >> 1) & 7)) << 4), chv = (unsigned)(((lane & 7) ^ (((r >> 1) & 3) << 1)) << 4);
    __builtin_amdgcn_global_load_lds((const __attribute__((address_space(1))) unsigned*)((const char*)qkv + (rb + (ck + chk))), (LAS unsigned*)(slot + i * 1024), 16, 0, 0);
    __builtin_amdgcn_global_load_lds((const __attribute__((address_space(1))) unsigned*)((const char*)qkv + (rb + (cv + chv))), (LAS unsigned*)(slot + 4096 + i * 1024), 16, 0, 0);
  }
}
__device__ __forceinline__ void read_vt(unsigned a0, unsigned a1, unsigned a2, unsigned a3, bf16x8 (&Vt)[4]) {
  u32x2 r00, r01, r10, r11, r20, r21, r30, r31;
  asm volatile(
      "ds_read_b64_tr_b16 %0, %8\n\tds_read_b64_tr_b16 %1, %8 offset:2048\n\t"
      "ds_read_b64_tr_b16 %2, %9\n\tds_read_b64_tr_b16 %3, %9 offset:2048\n\t"
      "ds_read_b64_tr_b16 %4, %10\n\tds_read_b64_tr_b16 %5, %10 offset:2048\n\t"
      "ds_read_b64_tr_b16 %6, %11\n\tds_read_b64_tr_b16 %7, %11 offset:2048\n\t"
      "s_waitcnt lgkmcnt(0)"
      : "=&v"(r00), "=&v"(r01), "=&v"(r10), "=&v"(r11), "=&v"(r20), "=&v"(r21), "=&v"(r30), "=&v"(r31)
      : "v"(a0), "v"(a1), "v"(a2), "v"(a3) : "memory");
  u32x4 t;
  t.x = r00.x; t.y = r00.y; t.z = r01.x; t.w = r01.y; Vt[0] = __builtin_bit_cast(bf16x8, t);
  t.x = r10.x; t.y = r10.y; t.z = r11.x; t.w = r11.y; Vt[1] = __builtin_bit_cast(bf16x8, t);
  t.x = r20.x; t.y = r20.y; t.z = r21.x; t.w = r21.y; Vt[2] = __builtin_bit_cast(bf16x8, t);
  t.x = r30.x; t.y = r30.y; t.z = r31.x; t.w = r31.y; Vt[3] = __builtin_bit_cast(bf16x8, t);
}
__device__ __forceinline__ void tile_chunk(const bf16x8 (&Kf)[2][2], const bf16x8 (&Q)[2], const bf16x8 (&Vt)[4], f32x4 (&o)[4], f32x4& l, int kcl, int lo, unsigned span, float negm) {
  f32x4 s0 = {negm, negm, negm, negm}, s1 = s0;
  s0 = mfma16(Kf[0][0], Q[0], s0); s0 = mfma16(Kf[0][1], Q[1], s0);
  s1 = mfma16(Kf[1][0], Q[0], s1); s1 = mfma16(Kf[1][1], Q[1], s1);
  float pv[8];
#pragma unroll
  for (int j = 0; j < 4; ++j) {
    pv[j] = ((unsigned)(kcl + j - lo) <= span) ? __builtin_amdgcn_exp2f(s0[j]) : 0.f;
    pv[4 + j] = ((unsigned)(kcl + 16 + j - lo) <= span) ? __builtin_amdgcn_exp2f(s1[j]) : 0.f;
  }
  u32x4 pk; pk.x = pk2(pv[0], pv[1]); pk.y = pk2(pv[2], pv[3]); pk.z = pk2(pv[4], pv[5]); pk.w = pk2(pv[6], pv[7]);
  const bf16x8 P = __builtin_bit_cast(bf16x8, pk);
#pragma unroll
  for (int dt = 0; dt < 4; ++dt) o[dt] = mfma16(Vt[dt], P, o[dt]);
  const bf16x8 ones = {(short)0x3F80, (short)0x3F80, (short)0x3F80, (short)0x3F80, (short)0x3F80, (short)0x3F80, (short)0x3F80, (short)0x3F80};
  l = mfma16(ones, P, l);
}

template <int TMASK, class DESC>
__device__ __forceinline__ void run_branch(const bf16_t* __restrict__ qkv, const DESC& desc, int& gi, const int total, const int nchunks, const int M, const int kstart, int koff, int voff,
                                           int qcb, int qstep, int hw, float negm, int lane, unsigned char* ring, const bf16x8 (&Q)[4][2], f32x4 (&o)[4][4], f32x4 (&l)[4]) {
  const int g = lane >> 4;
  int lo[4]; unsigned span[4];
#pragma unroll
  for (int t = 0; t < 4; ++t) { const int qc = qcb + t * qstep; lo[t] = qc - hw < 0 ? 0 : qc - hw; const int hi = qc + hw > M - 1 ? M - 1 : qc + hw; span[t] = (unsigned)(hi - lo[t]); }
  const int qp = (lane & 15) >> 2, pp = lane & 3, rl = 4 * g + qp, f = (rl >> 1) & 3;
  const unsigned vbase = (unsigned)(size_t)ring + 4096 + rl * 128 + pp * 8;
  const unsigned a0 = vbase + ((0 ^ f) << 5), a1 = vbase + ((1 ^ f) << 5), a2 = vbase + ((2 ^ f) << 5), a3 = vbase + ((3 ^ f) << 5);
  const int krow = lane & 15;
  const LAS unsigned char* kb0 = (const LAS unsigned char*)ring + krow * 128 + (((0 + g) ^ (krow >> 1)) << 4);
  const LAS unsigned char* kb1 = (const LAS unsigned char*)ring + krow * 128 + (((4 + g) ^ (krow >> 1)) << 4);
#pragma unroll 1
  for (int c = 0; c < nchunks; ++c, ++gi) {
    const unsigned soff = (unsigned)(gi & (ATT_SLOTS - 1)) * 8192u;
    bf16x8 Kf[2][2];
    if constexpr (ATT_LA == 1) {
      asm volatile("s_waitcnt vmcnt(0)" ::: "memory");
      Kf[0][0] = *(const LAS bf16x8*)(kb0 + soff); Kf[0][1] = *(const LAS bf16x8*)(kb1 + soff);
      Kf[1][0] = *(const LAS bf16x8*)(kb0 + soff + 2048); Kf[1][1] = *(const LAS bf16x8*)(kb1 + soff + 2048);
      if (gi + 1 < total) issue_chunk(qkv, desc(gi + 1), koff, voff, lane, ring + ((gi + 1) & 1) * 8192);
    } else {
      if (gi + ATT_LA < total) issue_chunk(qkv, desc(gi + ATT_LA), koff, voff, lane, ring + ((gi + ATT_LA) & (ATT_SLOTS - 1)) * 8192);
      const int rem = total - 1 - gi;
      if (ATT_LA >= 3 && rem >= 3) asm volatile("s_waitcnt vmcnt(24)" ::: "memory");
      else if (ATT_LA >= 2 && rem >= 2) asm volatile("s_waitcnt vmcnt(16)" ::: "memory");
      else if (rem >= 1) asm volatile("s_waitcnt vmcnt(8)" ::: "memory");
      else asm volatile("s_waitcnt vmcnt(0)" ::: "memory");
      Kf[0][0] = *(const LAS bf16x8*)(kb0 + soff); Kf[0][1] = *(const LAS bf16x8*)(kb1 + soff);
      Kf[1][0] = *(const LAS bf16x8*)(kb0 + soff + 2048); Kf[1][1] = *(const LAS bf16x8*)(kb1 + soff + 2048);
    }
    bf16x8 Vt[4];
    read_vt(a0 + soff, a1 + soff, a2 + soff, a3 + soff, Vt);
    const int kcl = kstart + 32 * c + 4 * g;
#pragma unroll
    for (int t = 0; t < 4; ++t)
      if (TMASK & (1 << t)) tile_chunk(Kf, Q[t], Vt, o[t], l[t], kcl, lo[t], span[t], negm);
  }
}

__device__ __forceinline__ float wave_max(float v) {
#pragma unroll
  for (int o = 1; o < 64; o <<= 1) v = fmaxf(v, __shfl_xor(v, o));
  return v;
}

__device__ __forceinline__ void attn_phase(const Params& p) {
  int tid = threadIdx.x; asm volatile("" : "+v"(tid));
  const int wave = __builtin_amdgcn_readfirstlane(tid >> 6), lane = tid & 63, qi = lane & 15, g = lane >> 4;
  if (wave >= ATT_NACT) return;
  const bf16_t* qkv = (const bf16_t*)(p.ws + WS_QKV);
  bf16_t* mix = (bf16_t*)(p.ws + WS_X);
  float* ssqh = (float*)(p.ws + WS_SSQH);
  unsigned char* ring = g_shm + wave * (ATT_SLOTS * 8192);
  const float mfixA = 8.0f * LOG2E * wave_max(fabsf(p.qna[lane])) * wave_max(fabsf(p.kna[lane]));
  const float mfixB = 8.0f * LOG2E * wave_max(fabsf(p.qnb[lane])) * wave_max(fabsf(p.knb[lane]));
  const int xcd = blockIdx.x & 7, wx = (blockIdx.x >> 3) * ATT_NACT + wave, nwx = (gridDim.x >> 3) * ATT_NACT;
  for (int li = wx; li < 2048; li += nwx) {
    const int kind = (li / nwx) & 1;
    const int lk = ((li / nwx) >> 1) * nwx + (li % nwx);
    const int grp = xcd * 128 + (lk & 127), sub = lk >> 7;
    const int r64 = grp * 64;
    const int S = r64 < NPROMPT ? 2048 : 4096;
    const int row0 = r64 & ~(S - 1);
    bf16x8 Q[4][2]; f32x4 o[4][4]; f32x4 l[4];
#pragma unroll
    for (int t = 0; t < 4; ++t) {
#pragma unroll
      for (int dt = 0; dt < 4; ++dt) o[t][dt] = (f32x4){0.f, 0.f, 0.f, 0.f};
    }
    int tok[4], colb[4];
    int gi = 0;
    if (kind == 0) {
      const int sidx = (r64 - row0) >> 6, c4 = sidx & 3, p0 = (sidx >> 2) * 16, h = sub;
#pragma unroll
      for (int t = 0; t < 4; ++t) {
        tok[t] = 16 * (p0 + qi) + c4 + 4 * t; colb[t] = h * 64; l[t] = (f32x4){0.f, 0.f, 0.f, 0.f};
        const bf16_t* rp = qkv + (size_t)(row0 + tok[t]) * INC + h * 64 + g * 8;
        Q[t][0] = *(const bf16x8*)rp; Q[t][1] = *(const bf16x8*)(rp + 32);
      }
      const int koff = 512 + h * 64, voff = 1024 + h * 64;
      auto desc = [=](int i) -> ChunkSrc {
        ChunkSrc r;
        if (i < 12) { r.rowc = row0; r.d = 1; r.M = S; r.kc0 = 16 * p0 - 64 + 32 * i; }
        else if (i < 18) { r.rowc = row0 + c4; r.d = 4; r.M = S >> 2; r.kc0 = 4 * p0 - 64 + 32 * (i - 12); }
        else { const int j = i - 18, t = j / 5, c = j - 5 * t; r.rowc = row0 + c4 + 4 * t; r.d = 16; r.M = S >> 4; r.kc0 = p0 - 64 + 32 * c; }
        return r;
      };
      constexpr int TOTAL = 38;
#pragma unroll
      for (int i = 0; i < ATT_LA; ++i) issue_chunk(qkv, desc(i), koff, voff, lane, ring + i * 8192);
      run_branch<15>(qkv, desc, gi, TOTAL, 12, S, 16 * p0 - 64, koff, voff, 16 * (p0 + qi) + c4, 4, 64, -mfixA, lane, ring, Q, o, l);
      run_branch<15>(qkv, desc, gi, TOTAL, 6, S >> 2, 4 * p0 - 64, koff, voff, 4 * (p0 + qi), 1, 64, -mfixA, lane, ring, Q, o, l);
      run_branch<1>(qkv, desc, gi, TOTAL, 5, S >> 4, p0 - 64, koff, voff, p0 + qi, 0, 64, -mfixA, lane, ring, Q, o, l);
      run_branch<2>(qkv, desc, gi, TOTAL, 5, S >> 4, p0 - 64, koff, voff, p0 + qi, 0, 64, -mfixA, lane, ring, Q, o, l);
      run_branch<4>(qkv, desc, gi, TOTAL, 5, S >> 4, p0 - 64, koff, voff, p0 + qi, 0, 64, -mfixA, lane, ring, Q, o, l);
      run_branch<8>(qkv, desc, gi, TOTAL, 5, S >> 4, p0 - 64, koff, voff, p0 + qi, 0, 64, -mfixA, lane, ring, Q, o, l);
    } else {
      const int kvh = sub & 1, qsub = sub >> 1, q0 = (r64 - row0) + 16 * qsub;
#pragma unroll
      for (int t = 0; t < 4; ++t) {
        const int hq = kvh * 4 + t;
        tok[t] = q0 + qi; colb[t] = 512 + hq * 64;
        { const float sk = __builtin_amdgcn_exp2f(p.sink[hq] * LOG2E - mfixB); l[t] = (f32x4){sk, sk, sk, sk}; }
        const bf16_t* rp = qkv + (size_t)(row0 + tok[t]) * INC + 1536 + hq * 64 + g * 8;
        Q[t][0] = *(const bf16x8*)rp; Q[t][1] = *(const bf16x8*)(rp + 32);
      }
      const int koff = 2048 + kvh * 64, voff = 2176 + kvh * 64;
      auto desc = [=](int i) -> ChunkSrc { ChunkSrc r; r.rowc = row0; r.d = 1; r.M = S; r.kc0 = q0 - 128 + 32 * i; return r; };
      constexpr int TOTAL = 9;
#pragma unroll
      for (int i = 0; i < ATT_LA; ++i) issue_chunk(qkv, desc(i), koff, voff, lane, ring + i * 8192);
      run_branch<15>(qkv, desc, gi, TOTAL, 9, S, q0 - 128, koff, voff, q0 + qi, 0, 128, -mfixB, lane, ring, Q, o, l);
    }
#pragma unroll
    for (int t = 0; t < 4; ++t) {
      const float L = l[t][0];
      const float inv = 1.0f / L; float ss = 0.f;
#pragma unroll
      for (int dt = 0; dt < 4; ++dt)
#pragma unroll
        for (int j = 0; j < 4; ++j) { const float x = o[t][dt][j] * inv; o[t][dt][j] = x; ss += x * x; }
      ss += __shfl_xor(ss, 16); ss += __shfl_xor(ss, 32);
      const size_t row = (size_t)(row0 + tok[t]);
      if (g == 0) ssqh[row * 16 + (colb[t] >> 6)] = ss;
      bf16_t* dst = mix + row * DM + colb[t] + 4 * g;
#pragma unroll
      for (int dt = 0; dt < 4; ++dt) { u32x2 w; w.x = pk2(o[t][dt][0], o[t][dt][1]); w.y = pk2(o[t][dt][2], o[t][dt][3]); *(u32x2*)(dst + 16 * dt) = w; }
    }
  }
}

#define XB_TMO      128
#define XB_XCNT(j)  (256  + 64 * (j))
#define XB_XSUB(j)  (1280 + 64 * (j))
#define XB_XGEN(j)  (2304 + 64 * (j))
#define XB_TOP      3328
#define XB_TOPGEN   3392
#define XCD_BAR_WORDS 3456
#define XB_SPIN_CAP (1u << 18)
__device__ __forceinline__ unsigned xb_ld(unsigned* p)              { return __hip_atomic_load(p, __ATOMIC_RELAXED, __HIP_MEMORY_SCOPE_AGENT); }
__device__ __forceinline__ unsigned xb_add(unsigned* p, unsigned v) { return __hip_atomic_fetch_add(p, v, __ATOMIC_RELAXED, __HIP_MEMORY_SCOPE_AGENT); }
__device__ __forceinline__ unsigned xb_xcc_id() { return (unsigned)__builtin_amdgcn_s_getreg((3 << 11) | 20) & 0xFu; }
#define XB_SPIN(cond, bar) do { unsigned _sp = 0; while (cond) { __builtin_amdgcn_s_sleep(1); \
    if ((++_sp & 255u) == 0u) { if (xb_ld(&(bar)[XB_TMO])) break; if (_sp > XB_SPIN_CAP) { atomicAdd(&(bar)[XB_TMO], 1u); break; } } } } while (0)
struct XcdBarrier { unsigned* bar; unsigned x; volatile LAS unsigned* st; };
__device__ __forceinline__ XcdBarrier xcd_barrier_post(unsigned* bar, volatile LAS unsigned* st) {
  XcdBarrier b; b.bar = bar; b.x = xb_xcc_id(); b.st = st;
  if (threadIdx.x == 0) (void)xb_add(&bar[XB_XCNT(b.x)], 1u);
  return b;
}
__device__ __forceinline__ void xcd_barrier_complete(unsigned* bar, unsigned x, unsigned& nloc, unsigned& nx) {
  const unsigned G = gridDim.x * gridDim.y * gridDim.z;
  unsigned sum, cnt, mine, sp = 0u;
  for (;;) {
    sum = 0u; cnt = 0u; mine = 0u;
#pragma unroll
    for (unsigned j = 0; j < 16; ++j) { const unsigned c = xb_ld(&bar[XB_XCNT(j)]); sum += c; cnt += (c > 0u) ? 1u : 0u; mine = (j == x) ? c : mine; }
    if (sum == G) break;
    __builtin_amdgcn_s_sleep(1);
    if ((++sp & 255u) == 0u) { if (xb_ld(&bar[XB_TMO])) break; if (sp > XB_SPIN_CAP) { atomicAdd(&bar[XB_TMO], 1u); break; } }
  }
  nloc = mine > 0u ? mine : 1u; nx = cnt > 0u ? cnt : 1u;
}
__device__ __forceinline__ void xcd_barrier_impl(const XcdBarrier& b) {
  asm volatile("s_waitcnt vmcnt(0)" ::: "memory");
  __syncthreads();
  if (threadIdx.x == 0) {
    unsigned* bar = b.bar;
    __builtin_amdgcn_s_waitcnt(0);
    unsigned nloc = b.st[0], nx = b.st[1];
    if (nloc == 0u) { xcd_barrier_complete(bar, b.x, nloc, nx); b.st[0] = nloc; b.st[1] = nx; }
    const unsigned old = xb_add(&bar[XB_XSUB(b.x)], 1u);
    const unsigned gen = old / nloc;
    if (old + 1u == (gen + 1u) * nloc) {
      __builtin_amdgcn_fence(__ATOMIC_RELEASE, "agent");
      asm volatile("s_waitcnt vmcnt(0)" ::: "memory");
      const unsigned og = xb_add(&bar[XB_TOP], 1u);
      const unsigned tg = og / nx;
      if (og + 1u == (tg + 1u) * nx) xb_add(&bar[XB_TOPGEN], 1u);
      else XB_SPIN(xb_ld(&bar[XB_TOPGEN]) == tg, bar);
      __builtin_amdgcn_fence(__ATOMIC_ACQUIRE, "agent");
      xb_add(&bar[XB_XGEN(b.x)], 1u);
      asm volatile("s_waitcnt vmcnt(0)" ::: "memory");
    } else {
      XB_SPIN(xb_ld(&bar[XB_XGEN(b.x)]) == gen, bar);
      __builtin_amdgcn_fence(__ATOMIC_ACQUIRE, "agent");
      asm volatile("s_waitcnt vmcnt(0)" ::: "memory");
    }
  }
  __syncthreads();
}

__device__ __forceinline__ void xcd_barrier(unsigned char* ws) {
  XcdBarrier b; b.bar = (unsigned*)(ws + WS_BAR); b.x = xb_xcc_id(); b.st = (volatile LAS unsigned*)((LAS unsigned char*)g_shm + GEMM_LDS_BYTES);
  xcd_barrier_impl(b);
}

typedef const __attribute__((address_space(4))) Params* KArgs;
__device__ __forceinline__ Params load_params() {
#if defined(__HIP_DEVICE_COMPILE__)
  KArgs kp = (KArgs)__builtin_amdgcn_kernarg_segment_ptr();
  asm volatile("" : "+s"(kp));
  Params r;
  r.xp = kp->xp; r.xs = kp->xs; r.norm_attn = kp->norm_attn; r.w_in = kp->w_in; r.qna = kp->qna; r.kna = kp->kna; r.qnb = kp->qnb; r.knb = kp->knb; r.sink = kp->sink;
  r.ona = kp->ona; r.onb = kp->onb; r.w_o = kp->w_o; r.norm_mlp = kp->norm_mlp; r.w_up = kp->w_up; r.w_down = kp->w_down; r.out = kp->out; r.ws = kp->ws;
  return r;
#else
  return Params{};
#endif
}

__global__ void __launch_bounds__(512) fwd_megakernel(Params p_unused) {
  cg::grid_group grid = cg::this_grid();
  {
    const Params p = load_params();
    volatile LAS unsigned* xst = (volatile LAS unsigned*)((LAS unsigned char*)g_shm + GEMM_LDS_BYTES);
    if (threadIdx.x == 0) { xst[0] = 0u; xst[1] = 0u; }
    (void)xcd_barrier_post((unsigned*)(p.ws + WS_BAR), xst);
    p0_prologue(p);
    if (p.ws == nullptr) grid.sync();
    xcd_barrier(p.ws);
  }
  {
    const Params p = load_params();
    EpiQKV e{(bf16_t*)(p.ws + WS_QKV), (const float*)(p.ws + WS_RS1), p.qna, p.kna, p.qnb, p.knb};
    gemm_phase<EpiQKV, GEMM_ALIGN, GEMM_SP2>((const bf16_t*)(p.ws + WS_X), (const bf16_t*)(p.ws + WS_WIN), NTOK, INC, DM, e);
    xcd_barrier(p.ws);
  }
  {
    const Params p = load_params();
    attn_phase(p);
    xcd_barrier(p.ws);
  }
  {
    const Params p = load_params();
    EpiWo e{p.xp, p.xs, (bf16_t*)(p.ws + WS_HB), (float*)(p.ws + WS_SSQ2), (const float*)(p.ws + WS_SSQH)};
    gemm_phase<EpiWo, GEMM_ALIGN, GEMM_SP2, true>((const bf16_t*)(p.ws + WS_X), (const bf16_t*)(p.ws + WS_WO), NTOK, DM, DM, e);
    xcd_barrier(p.ws);
    { const float* sp = (const float*)(p.ws + WS_SSQ2); float* s2 = (float*)(p.ws + WS_RS1);
      for (int row = blockIdx.x * 512 + threadIdx.x; row < NTOK; row += gridDim.x * 512) {
        const f32x4 a = *(const f32x4*)(sp + (size_t)row * 16), b = *(const f32x4*)(sp + (size_t)row * 16 + 4), c = *(const f32x4*)(sp + (size_t)row * 16 + 8), d = *(const f32x4*)(sp + (size_t)row * 16 + 12);
        const float tot = (((a[0] + a[1]) + (a[2] + a[3])) + ((b[0] + b[1]) + (b[2] + b[3]))) + (((c[0] + c[1]) + (c[2] + c[3])) + ((d[0] + d[1]) + (d[2] + d[3])));
        s2[row] = rsqrtf(tot * (1.0f / DM) + EPS);
      } }
    xcd_barrier(p.ws);
  }
  for (int half = 0; half < 2; ++half) {
    const int rb = half * NPROMPT;
    {
      const Params p = load_params();
      EpiUp e{(bf16_t*)(p.ws + WS_U)};
      gemm_phase<EpiUp, GEMM_ALIGN, GEMM_SP2>((const bf16_t*)(p.ws + WS_HB) + (size_t)rb * DM, (const bf16_t*)(p.ws + WS_WUP), NPROMPT, DFF, DM, e);
      xcd_barrier(p.ws);
    }
    {
      const Params p = load_params();
      EpiDown e{(const bf16_t*)(p.ws + WS_HB), p.out, (const float*)(p.ws + WS_RS1), rb};
      gemm_phase<EpiDown, GEMM_ALIGN, GEMM_SP2>((const bf16_t*)(p.ws + WS_U), (const bf16_t*)(p.ws + WS_WD), NPROMPT, DM, DFF, e);
      if (half == 0) xcd_barrier(p.ws);
    }
  }
}

extern "C" void kernel_launch(void* const* d_in, const int* in_sizes, int n_in, void* d_out, int out_size, void* d_ws, size_t ws_size, hipStream_t stream) {
  static int grid_blocks = 0;
  if (!grid_blocks) {
    if (n_in != 15 || ws_size < WS_NEED) { fprintf(stderr, "kernel_launch: unexpected n_in %d / ws_size %zu\n", n_in, ws_size); grid_blocks = -1; return; }
    int dev = 0, cus = 0, per_cu = 0;
    hipGetDevice(&dev);
    hipDeviceGetAttribute(&cus, hipDeviceAttributeMultiprocessorCount, dev);
    if (hipFuncSetAttribute((const void*)fwd_megakernel, hipFuncAttributeMaxDynamicSharedMemorySize, LDS_BYTES) != hipSuccess) { fprintf(stderr, "hipFuncSetAttribute failed\n"); grid_blocks = -1; return; }
    hipOccupancyMaxActiveBlocksPerMultiprocessor(&per_cu, (const void*)fwd_megakernel, 512, LDS_BYTES);
    if (per_cu < 1) { fprintf(stderr, "occupancy query says %d blocks/CU\n", per_cu); per_cu = 1; }
    (void)hipGetLastError();
    grid_blocks = cus;
  }
  if (grid_blocks < 0) return;
  if (hipMemsetAsync((char*)d_ws + WS_BAR, 0, 16384, stream) != hipSuccess) { fprintf(stderr, "hipMemsetAsync of the barrier words failed\n"); return; }
  Params p{};
  p.xp = (const float*)d_in[0]; p.xs = (const float*)d_in[1]; p.norm_attn = (const float*)d_in[2]; p.w_in = (const float*)d_in[3];
  p.qna = (const float*)d_in[4]; p.kna = (const float*)d_in[5]; p.qnb = (const float*)d_in[6]; p.knb = (const float*)d_in[7];
  p.sink = (const float*)d_in[8]; p.ona = (const float*)d_in[9]; p.onb = (const float*)d_in[10]; p.w_o = (const float*)d_in[11];
  p.norm_mlp = (const float*)d_in[12]; p.w_up = (const float*)d_in[13]; p.w_down = (const float*)d_in[14];
  p.out = (float*)d_out; p.ws = (unsigned char*)d_ws;
  void* args[] = {&p};
  hipError_t e = hipLaunchCooperativeKernel((const void*)fwd_megakernel, dim3(grid_blocks), dim3(512), args, LDS_BYTES, stream);
  if (e != hipSuccess) fprintf(stderr, "cooperative launch failed: %s (grid %d)\n", hipGetErrorString(e), grid_blocks);
}
```

```cpp
#include <hip/hip_runtime.h>
#include <hip/hip_cooperative_groups.h>
#include <cstdio>
#include <cstdint>
namespace cg = cooperative_groups;

typedef unsigned short bf16_t;
typedef short bf16x8 __attribute__((ext_vector_type(8)));
typedef float f32x4 __attribute__((ext_vector_type(4)));
typedef unsigned u32x4 __attribute__((ext_vector_type(4)));
typedef unsigned u32x2 __attribute__((ext_vector_type(2)));

constexpr int DM = 1024, NTOK = 65536, NPROMPT = 32768, INC = 2304, DFF = 4096;
constexpr float EPS = 1e-6f;
constexpr float LOG2E = 1.4426950408889634f;
constexpr float QSCALE = 0.18033688011112042f;

constexpr size_t MiB = 1048576;
constexpr size_t WS_WIN = 0, WS_WO = 4718592, WS_WUP = 6815744, WS_WD = 15204352, WS_RS1 = 23592960, WS_SSQ2 = 440 * MiB;
constexpr size_t WS_X = 24 * MiB;
constexpr size_t WS_QKV = 152 * MiB;
constexpr size_t WS_HB = 312 * MiB;
constexpr size_t WS_U = 24 * MiB;
constexpr size_t WS_SSQH = 444 * MiB;
constexpr size_t WS_BAR = 448 * MiB;
constexpr size_t WS_NEED = 449 * MiB;

constexpr int GEMM_LDS_BYTES = 131072, LDS_BYTES = GEMM_LDS_BYTES + 64;
constexpr bool GEMM_ALIGN = true, GEMM_SP2 = true;
constexpr int ATT_NACT = 8;
constexpr int ATT_SLOTS = 16 / ATT_NACT, ATT_LA = ATT_SLOTS - 1;

struct Params {
  const float *xp, *xs, *norm_attn, *w_in, *qna, *kna, *qnb, *knb, *sink, *ona, *onb, *w_o, *norm_mlp, *w_up, *w_down;
  float* out;
  unsigned char* ws;
};

extern __shared__ __attribute__((aligned(16))) unsigned char g_shm[];

typedef __bf16 bf16v2_t __attribute__((ext_vector_type(2)));
typedef float f32v2_t __attribute__((ext_vector_type(2)));
__device__ __forceinline__ unsigned pk2(float lo, float hi) { const f32v2_t f = {lo, hi}; const bf16v2_t b = __builtin_convertvector(f, bf16v2_t); return __builtin_bit_cast(unsigned, b); }
__device__ __forceinline__ float bf2f(unsigned short b) { return __uint_as_float(((unsigned)b) << 16); }
__device__ __forceinline__ f32x4 mfma16(bf16x8 a, bf16x8 b, f32x4 c) { return __builtin_amdgcn_mfma_f32_16x16x32_bf16(a, b, c, 0, 0, 0); }

__device__ __forceinline__ int col_slot(int c, int mode) {
  if (mode == 0) return 128 * ((c >> 3) & 1) + 32 * (c >> 6) + 16 * ((c >> 2) & 1) + 4 * ((c >> 4) & 3) + (c & 3);
  if (mode == 1) return 128 * ((c >> 5) & 1) + 32 * (c >> 6) + 16 * ((c >> 2) & 1) + 4 * ((c >> 3) & 3) + (c & 3);
  return c;
}

constexpr int BM = 256, BK = 64, HALF = 128, HT = HALF * BK;
__device__ __forceinline__ int lds_byte(int r, int c) {
  int st = (r >> 4) * 2 + (c >> 5), rr = r & 15, cc = c & 31, ob = rr * 64 + cc * 2;
  return st * 1024 + (ob ^ (((ob >> 9) & 1) << 5));
}
__device__ __forceinline__ void stage_rc(int b, int& R, int& C) {
  int st = b / 1024, sb = b % 1024, swz = sb ^ (((sb >> 9) & 1) << 5);
  R = (st >> 1) * 16 + swz / 64; C = (st & 1) * 32 + (swz % 64) / 2;
}

__device__ __forceinline__ bool tile_of(int L, int nM, int nN, int& pm, int& pn) {
  const int nwg = nM * nN; if (L >= nwg) return false;
  int wgid = L; { const int q = nwg / 8, r = nwg % 8, xcd = wgid % 8, off = wgid / 8; wgid = (xcd < r ? xcd * (q + 1) : r * (q + 1) + (xcd - r) * q) + off; }
  const int nig = 8 * nN, gid = wgid / nig, fm = gid * 8, gsz = (nM - fm) < 8 ? (nM - fm) : 8;
  pm = fm + ((wgid % nig) % gsz); pn = (wgid % nig) / gsz; return true;
}
#define LAS __attribute__((address_space(3)))
template <class Epi, bool ALIGN_EPI, bool SP2, bool MID = false>
__device__ __forceinline__ void gemm_phase(const bf16_t* __restrict__ Ag, const bf16_t* __restrict__ Btg, const int M, const int N, const int K, const Epi& E) {
  LAS unsigned char* lds = (LAS unsigned char*)g_shm;
  int tid = threadIdx.x; asm volatile("" : "+v"(tid));
  const int wid = __builtin_amdgcn_readfirstlane(tid >> 6), lane = tid & 63, wr = wid >> 2, wc = wid & 3, fr = lane & 15, fq = lane >> 4;
  const int nt = K / BK, nM = M / BM, nN = N / BM, G = gridDim.x, cu = blockIdx.x;
  constexpr int HTB = HALF * BK * 2;
  unsigned voff[2];
#pragma unroll
  for (int i = 0; i < 2; ++i) { int R, C; stage_rc(tid * 16 + i * 8192, R, C); voff[i] = (unsigned)(R * K + C) * 2u; }
  const size_t kstep = (size_t)(BK * 2), hstep = (size_t)HALF * K * 2, tstep = 2 * hstep;
  const unsigned ldsw = (unsigned)wid * 1024u;
  const int aoff = lds_byte(wr * 64 + fr, fq * 8), boff = lds_byte(wc * 32 + fr, fq * 8);
#define PG8_SA(b, h) (((b) * 2 + (h)) * HTB)
#define PG8_SB(b, h) ((4 + (b) * 2 + (h)) * HTB)
#define PG8_STAGE(bufoff, gbase) do { _Pragma("unroll") for (int _i = 0; _i < 2; ++_i) \
    __builtin_amdgcn_global_load_lds((const __attribute__((address_space(1))) unsigned*)((const char*)(gbase) + voff[_i]), (LAS unsigned*)(lds + (bufoff) + ldsw + _i * 8192), 16, 0, 0); } while (0)
#define PG8_LDA(dst, b, h) do { _Pragma("unroll") for (int m = 0; m < 4; ++m) _Pragma("unroll") for (int k = 0; k < 2; ++k) dst[m][k] = *(const LAS bf16x8*)(lds + PG8_SA(b, h) + aoff + m * 2048 + k * 1024); } while (0)
#define PG8_LDB(dst, b, h) do { _Pragma("unroll") for (int n = 0; n < 2; ++n) _Pragma("unroll") for (int k = 0; k < 2; ++k) dst[n][k] = *(const LAS bf16x8*)(lds + PG8_SB(b, h) + boff + n * 2048 + k * 1024); } while (0)
#define PG8_MMA(ai, bj, At, Bt) do { __builtin_amdgcn_s_setprio(1); _Pragma("unroll") for (int m = 0; m < 4; ++m) _Pragma("unroll") for (int n = 0; n < 2; ++n) _Pragma("unroll") for (int k = 0; k < 2; ++k) \
    acc[ai][bj][m][n] = __builtin_amdgcn_mfma_f32_16x16x32_bf16(Bt[n][k], At[m][k], acc[ai][bj][m][n], 0, 0, 0); __builtin_amdgcn_s_setprio(0); } while (0)
#define PG8_WAIT_V(n) asm volatile("s_waitcnt vmcnt(" #n ")" ::: "memory")
#define PG8_WAIT_L(n) asm volatile("s_waitcnt lgkmcnt(" #n ")" ::: "memory")
#define PG8_BAR __builtin_amdgcn_s_barrier()
#define PG8_SCHED __builtin_amdgcn_sched_barrier(0)
  int cpm, cpn, npm = 0, npn = 0, ui = 0;
  if (!tile_of(cu, nM, nN, cpm, cpn)) return;
  f32x4 acc[2][2][4][2];
#pragma unroll
  for (int a = 0; a < 2; ++a)
#pragma unroll
    for (int b = 0; b < 2; ++b)
#pragma unroll
      for (int m = 0; m < 4; ++m)
#pragma unroll
        for (int n = 0; n < 2; ++n) acc[a][b][m][n] = (f32x4){0.f, 0.f, 0.f, 0.f};
  bf16x8 At[4][2], B0[2][2], B1[2][2];
  const char* cA = (const char*)Ag + (size_t)cpm * tstep; const char* cB = (const char*)Btg + (size_t)cpn * tstep;
  static_assert(SP2, "this body is the two-super-phase loop");
  PG8_STAGE(PG8_SB(0, 0), cB); PG8_STAGE(PG8_SB(0, 1), cB + hstep); PG8_STAGE(PG8_SA(0, 0), cA); PG8_STAGE(PG8_SA(0, 1), cA + hstep);
  PG8_STAGE(PG8_SB(1, 0), cB + kstep); PG8_STAGE(PG8_SA(1, 0), cA + kstep); PG8_STAGE(PG8_SB(1, 1), cB + hstep + kstep);
  if (wr == 1) PG8_BAR;
  PG8_WAIT_V(0); PG8_BAR;
  PG8_BAR;
#define K2_ITER(FIRST) do { \
      const bool last = (t == nt - 2); \
      const char* a1 = cA + (size_t)(t + 1) * kstep; \
      const char* a2 = last ? nA : cA + (size_t)(t + 2) * kstep; const char* b2 = last ? nB : cB + (size_t)(t + 2) * kstep; \
      const char* a3 = a2 + kstep; const char* b3 = b2 + kstep; \
      if constexpr (MID) { if (t == (nt >> 1)) E.mid(acc, cpm * BM); } \
      PG8_LDB(B0, 0, 0); PG8_LDB(B1, 0, 1); PG8_SCHED; PG8_LDA(At, 0, 0); PG8_STAGE(PG8_SA(1, 1), a1 + hstep); \
      if constexpr (!(FIRST)) PG8_WAIT_V(8); \
      PG8_WAIT_L(0); PG8_BAR; PG8_MMA(0, 0, At, B0); PG8_MMA(0, 1, At, B1); PG8_BAR; PG8_SCHED; \
      PG8_LDA(At, 0, 1); PG8_STAGE(PG8_SB(0, 0), b2); PG8_STAGE(PG8_SB(0, 1), b2 + hstep); PG8_STAGE(PG8_SA(0, 0), a2); \
      if constexpr (!(FIRST)) PG8_WAIT_V(8); \
      PG8_WAIT_L(0); PG8_BAR; PG8_MMA(1, 0, At, B0); PG8_MMA(1, 1, At, B1); PG8_BAR; PG8_SCHED; \
      PG8_LDB(B0, 1, 0); PG8_LDB(B1, 1, 1); PG8_SCHED; PG8_LDA(At, 1, 0); PG8_STAGE(PG8_SA(0, 1), a2 + hstep); \
      PG8_WAIT_V(8); PG8_WAIT_L(0); PG8_BAR; PG8_MMA(0, 0, At, B0); PG8_MMA(0, 1, At, B1); PG8_BAR; PG8_SCHED; \
      PG8_LDA(At, 1, 1); PG8_STAGE(PG8_SB(1, 0), b3); PG8_STAGE(PG8_SB(1, 1), b3 + hstep); PG8_STAGE(PG8_SA(1, 0), a3); \
      PG8_WAIT_V(8); PG8_WAIT_L(0); PG8_BAR; PG8_MMA(1, 0, At, B0); PG8_MMA(1, 1, At, B1); PG8_BAR; PG8_SCHED; \
    } while (0)
  for (;;) {
    const bool has_next = tile_of((ui + 1) * G + cu, nM, nN, npm, npn);
    const char* nA = has_next ? (const char*)Ag + (size_t)npm * tstep : cA; const char* nB = has_next ? (const char*)Btg + (size_t)npn * tstep : cB;
    { const int t = 0; K2_ITER(true); }
    for (int t = 2; t < nt; t += 2) K2_ITER(false);
    const typename Epi::Pre pre = E.pre(cpm * BM, cpn * BM);
    if constexpr (ALIGN_EPI) { if (wr == 0) PG8_BAR; }
    PG8_WAIT_V(0);
    E(acc, cpm * BM, cpn * BM, pre);
    if (!has_next) break;
#pragma unroll
    for (int a = 0; a < 2; ++a)
#pragma unroll
      for (int b = 0; b < 2; ++b)
#pragma unroll
        for (int m = 0; m < 4; ++m)
#pragma unroll
          for (int n = 0; n < 2; ++n) acc[a][b][m][n] = (f32x4){0.f, 0.f, 0.f, 0.f};
    cpm = npm; cpn = npn; cA = nA; cB = nB; ++ui;
    if constexpr (ALIGN_EPI) { if (wr == 1) PG8_BAR; }
  }
  PG8_WAIT_V(0);
  if constexpr (!ALIGN_EPI) { if (wr == 0) PG8_BAR; }
  PG8_BAR;
#undef K2_ITER
#undef PG8_SA
#undef PG8_SB
#undef PG8_STAGE
#undef PG8_LDA
#undef PG8_LDB
#undef PG8_MMA
}

#define EPI_IDS \
    int tid_ = threadIdx.x; asm volatile("" : "+v"(tid_));     \
    const int wid_ = tid_ >> 6, lane_ = tid_ & 63, wr = wid_ >> 2, wc = wid_ & 3, fr = lane_ & 15, fq = lane_ >> 4;
#define PACK16(v, w0, w1) \
    w0.x = pk2(v[0], v[1]); w0.y = pk2(v[2], v[3]); w0.z = pk2(v[4], v[5]); w0.w = pk2(v[6], v[7]); \
    w1.x = pk2(v[8], v[9]); w1.y = pk2(v[10], v[11]); w1.z = pk2(v[12], v[13]); w1.w = pk2(v[14], v[15]);

struct EpiQKV {
  bf16_t* qkv; const float* rs1; const float *qna, *kna, *qnb, *knb;
  struct Pre { float rs[8]; float gn[16]; };
  __device__ __forceinline__ Pre pre(int brow, int bcol) const {
    EPI_IDS
    (void)fr;
    Pre r;
    const int ct = bcol >> 8;
    const float* gp = nullptr; float extra = 1.f;
    if (ct < 2) { gp = qna; extra = QSCALE; } else if (ct < 4) gp = kna; else if (ct < 6) gp = nullptr; else if (ct < 8) { gp = qnb; extra = QSCALE; } else gp = (wc < 2) ? knb : nullptr;
#pragma unroll
    for (int i = 0; i < 16; ++i) r.gn[i] = gp ? gp[32 * (i >> 3) + 8 * fq + (i & 7)] * extra : 0.f;
#pragma unroll
    for (int k = 0; k < 8; ++k) r.rs[k] = rs1[brow + (k >> 2) * HALF + wr * 64 + (k & 3) * 16 + fr];
    return r;
  }
  __device__ __forceinline__ void operator()(const f32x4 (&acc)[2][2][4][2], int brow, int bcol, const Pre& pre) const {
    EPI_IDS
    const int ct = bcol >> 8;
    const bool gp = !(ct == 4 || ct == 5 || (ct == 8 && wc >= 2));
    const int smask = (brow < NPROMPT) ? 2047 : 4095;
#pragma unroll
    for (int ai = 0; ai < 2; ++ai)
#pragma unroll
      for (int m = 0; m < 4; ++m) {
        const int row = brow + ai * HALF + wr * 64 + m * 16 + fr;
        const float rs = pre.rs[ai * 4 + m];
        float v[16];
#pragma unroll
        for (int bj = 0; bj < 2; ++bj)
#pragma unroll
          for (int n = 0; n < 2; ++n)
#pragma unroll
            for (int j = 0; j < 4; ++j) v[8 * bj + 4 * n + j] = acc[ai][bj][m][n][j] * rs;
        if (gp) {
          float ss = 0.f;
#pragma unroll
          for (int i = 0; i < 16; ++i) ss += v[i] * v[i];
          ss += __shfl_xor(ss, 16); ss += __shfl_xor(ss, 32);
          const float inv = rsqrtf(ss * (1.0f / 64.0f) + EPS);
#pragma unroll
          for (int i = 0; i < 16; ++i) v[i] = v[i] * inv * pre.gn[i];
          {
            const float pos = (float)(row & smask);
            const float sgn = fq == 0 ? -1.0f : 1.0f;
#pragma unroll
            for (int i = 0; i < 8; ++i) {
              const float ci = i == 0 ? 1.5915494309e-01f : i == 1 ? 3.0863763405e-02f : i == 2 ? 5.9851857127e-03f : i == 3 ? 1.1606636412e-03f : i == 4 ? 2.2507907904e-04f : i == 5 ? 4.3647952793e-05f : i == 6 ? 8.4643308082e-06f : 1.6414262628e-06f;
              const float vp = __shfl_xor(v[i], 16);
              const float tr = __builtin_amdgcn_fractf(pos * ci);
              const float c = __builtin_amdgcn_cosf(tr), s = __builtin_amdgcn_sinf(tr);
              const float r = v[i] * c + sgn * (vp * s);
              v[i] = fq < 2 ? r : v[i];
            }
          }
        }
        u32x4 w0, w1; PACK16(v, w0, w1)
        bf16_t* dst = qkv + (size_t)row * INC + bcol + 64 * wc + 8 * fq;
        *(u32x4*)dst = w0; *(u32x4*)(dst + 32) = w1;
      }
  }
};

struct EpiWo {
  const float *xp, *xs; bf16_t* hb; float* ssq2p; const float* ssqh;
  __device__ __forceinline__ void scales(int row, float& sa, float& sb) const {
    const float* sp = ssqh + (size_t)row * 16;
    const f32x4 a = *(const f32x4*)sp, b = *(const f32x4*)(sp + 4), c = *(const f32x4*)(sp + 8), d = *(const f32x4*)(sp + 12);
    sa = rsqrtf((((a[0] + a[1]) + (a[2] + a[3])) + ((b[0] + b[1]) + (b[2] + b[3]))) * (1.0f / 512.0f) + EPS);
    sb = rsqrtf((((c[0] + c[1]) + (c[2] + c[3])) + ((d[0] + d[1]) + (d[2] + d[3]))) * (1.0f / 512.0f) + EPS);
  }
  __device__ __forceinline__ void mid(f32x4 (&acc)[2][2][4][2], int brow) const {
    EPI_IDS
    (void)wc; (void)fq;
#pragma unroll
    for (int ai = 0; ai < 2; ++ai)
#pragma unroll
      for (int m = 0; m < 4; ++m) {
        float sa, sb; scales(brow + ai * HALF + wr * 64 + m * 16 + fr, sa, sb);
        const float ratio = sa / sb;
#pragma unroll
        for (int bj = 0; bj < 2; ++bj)
#pragma unroll
          for (int n = 0; n < 2; ++n) acc[ai][bj][m][n] = acc[ai][bj][m][n] * ratio;
      }
  }
  struct Pre { f32x4 xv0[4][4]; };
  __device__ __forceinline__ Pre pre(int brow, int bcol) const {
    EPI_IDS
    Pre r;
    const float* xbase = (brow < NPROMPT) ? (xp + (size_t)brow * DM) : (xs + (size_t)(brow - NPROMPT) * DM);
#pragma unroll
    for (int m = 0; m < 4; ++m) {
      const float* xr = xbase + (size_t)(wr * 64 + m * 16 + fr) * DM + bcol + 64 * wc + 8 * fq;
#pragma unroll
      for (int q = 0; q < 4; ++q) r.xv0[m][q] = __builtin_nontemporal_load((const f32x4*)(xr + 32 * (q >> 1) + 4 * (q & 1)));
    }
    return r;
  }
  __device__ __forceinline__ void operator()(const f32x4 (&acc)[2][2][4][2], int brow, int bcol, const Pre& pre) const {
    EPI_IDS
    const float* xbase = (brow < NPROMPT) ? (xp + (size_t)brow * DM) : (xs + (size_t)(brow - NPROMPT) * DM);
#pragma unroll
    for (int ai = 0; ai < 2; ++ai) {
      f32x4 xv[4][4]; float sbv[4];
#pragma unroll
      for (int m = 0; m < 4; ++m) {
        const int rl = ai * HALF + wr * 64 + m * 16 + fr;
        const float* xr = xbase + (size_t)rl * DM + bcol + 64 * wc + 8 * fq;
#pragma unroll
        for (int q = 0; q < 4; ++q) xv[m][q] = ai == 0 ? pre.xv0[m][q] : __builtin_nontemporal_load((const f32x4*)(xr + 32 * (q >> 1) + 4 * (q & 1)));
        float sa; scales(brow + rl, sa, sbv[m]);
      }
#pragma unroll
      for (int m = 0; m < 4; ++m) {
        const int rl = ai * HALF + wr * 64 + m * 16 + fr;
        float v[16]; float ss = 0.f;
#pragma unroll
        for (int bj = 0; bj < 2; ++bj)
#pragma unroll
          for (int n = 0; n < 2; ++n)
#pragma unroll
            for (int j = 0; j < 4; ++j) { const float h = xv[m][2 * bj + n][j] + acc[ai][bj][m][n][j] * sbv[m]; v[8 * bj + 4 * n + j] = h; ss += h * h; }
        ss += __shfl_xor(ss, 16); ss += __shfl_xor(ss, 32);
        if (fq == 0) ssq2p[(size_t)(brow + rl) * 16 + (bcol >> 8) * 4 + wc] = ss;
        u32x4 w0, w1; PACK16(v, w0, w1)
        bf16_t* dst = hb + (size_t)(brow + rl) * DM + bcol + 64 * wc + 8 * fq;
        *(u32x4*)dst = w0; *(u32x4*)(dst + 32) = w1;
      }
      __builtin_amdgcn_sched_barrier(0);
    }
  }
};

struct EpiUp {
  bf16_t* u;
  struct Pre {};
  __device__ __forceinline__ Pre pre(int, int) const { return Pre{}; }
  __device__ __forceinline__ void operator()(const f32x4 (&acc)[2][2][4][2], int brow, int bcol, const Pre&) const {
    EPI_IDS
#pragma unroll
    for (int ai = 0; ai < 2; ++ai)
#pragma unroll
      for (int m = 0; m < 4; ++m) {
        const int rl = brow + ai * HALF + wr * 64 + m * 16 + fr;
        float v[16];
#pragma unroll
        for (int bj = 0; bj < 2; ++bj)
#pragma unroll
          for (int n = 0; n < 2; ++n) {
            f32x4 z = acc[ai][bj][m][n];
#pragma unroll
            for (int j = 0; j < 4; ++j) z[j] = fmaxf(z[j], 0.f);
            z = z * z;
#pragma unroll
            for (int j = 0; j < 4; ++j) v[8 * bj + 4 * n + j] = z[j];
          }
        u32x4 w0, w1; PACK16(v, w0, w1)
        bf16_t* dst = u + (size_t)rl * DFF + bcol + 64 * wc + 8 * fq;
        *(u32x4*)dst = w0; *(u32x4*)(dst + 32) = w1;
      }
  }
};

struct EpiDown {
  const bf16_t* hb; float* out; const float* s2; int row_base;
  struct Pre { u32x2 hv[2][4][2][2]; float sq[8]; };
  __device__ __forceinline__ Pre pre(int brow, int bcol) const {
    EPI_IDS
    Pre r;
#pragma unroll
    for (int ai = 0; ai < 2; ++ai)
#pragma unroll
      for (int m = 0; m < 4; ++m) {
        const size_t off = (size_t)(row_base + brow + ai * HALF + wr * 64 + m * 16 + fr) * DM + bcol + 32 * wc + 4 * fq;
#pragma unroll
        for (int bj = 0; bj < 2; ++bj)
#pragma unroll
          for (int n = 0; n < 2; ++n) r.hv[ai][m][bj][n] = *(const u32x2*)(hb + off + 128 * bj + 16 * n);
        const float s = s2[row_base + brow + ai * HALF + wr * 64 + m * 16 + fr]; r.sq[ai * 4 + m] = s * s;
      }
    return r;
  }
  __device__ __forceinline__ void operator()(const f32x4 (&acc)[2][2][4][2], int brow, int bcol, const Pre& pre) const {
    EPI_IDS
#pragma unroll
    for (int ai = 0; ai < 2; ++ai)
#pragma unroll
      for (int m = 0; m < 4; ++m) {
        const size_t off = (size_t)(row_base + brow + ai * HALF + wr * 64 + m * 16 + fr) * DM + bcol + 32 * wc + 4 * fq;
        float* dst = out + off; const float sq = pre.sq[ai * 4 + m];
#pragma unroll
        for (int bj = 0; bj < 2; ++bj)
#pragma unroll
          for (int n = 0; n < 2; ++n) {
            const unsigned a = pre.hv[ai][m][bj][n].x, b = pre.hv[ai][m][bj][n].y;
            f32x4 o;
            o[0] = __uint_as_float(a << 16) + acc[ai][bj][m][n][0] * sq; o[1] = __uint_as_float(a & 0xffff0000u) + acc[ai][bj][m][n][1] * sq;
            o[2] = __uint_as_float(b << 16) + acc[ai][bj][m][n][2] * sq; o[3] = __uint_as_float(b & 0xffff0000u) + acc[ai][bj][m][n][3] * sq;
            *(f32x4*)(dst + 128 * bj + 16 * n) = o;
          }
      }
  }
};

__device__ __forceinline__ void p0_transpose_item(const float* __restrict__ W, int K, int N, bf16_t* __restrict__ WT, const float* __restrict__ g0, const float* __restrict__ g1, float* scr, int item, int lane, int mode) {
  const int nblk = N / 32, kb = item / nblk, nb = item % nblk, k0 = 64 * kb, n0 = 32 * nb;
#pragma unroll 8
  for (int i = 0; i < 32; ++i) {
    const int kk = 2 * i + (lane >> 5), k = k0 + kk;
    float gv = 1.f; if (g0) gv = (g1 && k >= 512) ? g1[k - 512] : g0[k];
    scr[kk * 33 + (lane & 31)] = __builtin_nontemporal_load(W + (size_t)k * N + n0 + (lane & 31)) * gv;
  }
  asm volatile("s_waitcnt lgkmcnt(0)" ::: "memory");
  const int c = lane & 7;
#pragma unroll
  for (int j = 0; j < 4; ++j) {
    const int n = (lane >> 3) + 8 * j; const float* s = scr + (8 * c) * 33 + n;
    u32x4 o; o.x = pk2(s[0 * 33], s[1 * 33]); o.y = pk2(s[2 * 33], s[3 * 33]); o.z = pk2(s[4 * 33], s[5 * 33]); o.w = pk2(s[6 * 33], s[7 * 33]);
    const int col = n0 + n, drow = (col & ~255) + col_slot(col & 255, mode);
    *(u32x4*)(WT + (size_t)drow * K + k0 + 8 * c) = o;
  }
  asm volatile("s_waitcnt lgkmcnt(0)" ::: "memory");
}

__device__ __forceinline__ void p0_prologue(const Params& p) {
  int tid = threadIdx.x; asm volatile("" : "+v"(tid));
  const int wave = tid >> 6, lane = tid & 63;
  const int gw = blockIdx.x * 8 + wave, NGW = gridDim.x * 8;
  float* scr = (float*)(g_shm + wave * 16384);
  bf16_t* WinT = (bf16_t*)(p.ws + WS_WIN); bf16_t* WoT = (bf16_t*)(p.ws + WS_WO); bf16_t* WupT = (bf16_t*)(p.ws + WS_WUP); bf16_t* WdT = (bf16_t*)(p.ws + WS_WD);
  constexpr int I_IN = 16 * 72, I_O = 16 * 32, I_UP = 16 * 128, I_DN = 64 * 32, NIT = I_IN + I_O + I_UP + I_DN;
  for (int it = gw; it < NIT; it += NGW) {
    int r = it;
    if (r < I_IN) { p0_transpose_item(p.w_in, DM, INC, WinT, p.norm_attn, nullptr, scr, r, lane, 1); continue; } r -= I_IN;
    if (r < I_O) { p0_transpose_item(p.w_o, DM, DM, WoT, p.ona, p.onb, scr, r, lane, 1); continue; } r -= I_O;
    if (r < I_UP) { p0_transpose_item(p.w_up, DM, DFF, WupT, p.norm_mlp, nullptr, scr, r, lane, 1); continue; } r -= I_UP;
    p0_transpose_item(p.w_down, DFF, DM, WdT, nullptr, nullptr, scr, r, lane, 2);
  }
  bf16_t* xb = (bf16_t*)(p.ws + WS_X); float* rs1 = (float*)(p.ws + WS_RS1);
  for (int row4 = gw * 4; row4 < NTOK; row4 += NGW * 4) {
    f32x4 v[4][4];
#pragma unroll
    for (int r = 0; r < 4; ++r) {
      const int row = row4 + r;
      const float* xr = (row < NPROMPT) ? (p.xp + (size_t)row * DM) : (p.xs + (size_t)(row - NPROMPT) * DM);
#pragma unroll
      for (int j = 0; j < 4; ++j) v[r][j] = __builtin_nontemporal_load((const f32x4*)(xr + 256 * j + 4 * lane));
    }
#pragma unroll
    for (int r = 0; r < 4; ++r) {
      const int row = row4 + r; float s = 0.f;
#pragma unroll
      for (int j = 0; j < 4; ++j) s += (v[r][j][0] * v[r][j][0] + v[r][j][1] * v[r][j][1]) + (v[r][j][2] * v[r][j][2] + v[r][j][3] * v[r][j][3]);
#pragma unroll
      for (int o = 1; o < 64; o <<= 1) s += __shfl_xor(s, o);
#pragma unroll
      for (int j = 0; j < 4; ++j) { u32x2 w; w.x = pk2(v[r][j][0], v[r][j][1]); w.y = pk2(v[r][j][2], v[r][j][3]); *(u32x2*)(xb + (size_t)row * DM + 256 * j + 4 * lane) = w; }
      if (lane == 0) rs1[row] = rsqrtf(s * (1.0f / DM) + EPS);
    }
  }
}

struct ChunkSrc { int rowc, d, M, kc0; };

__device__ __forceinline__ void issue_chunk(const bf16_t* __restrict__ qkv, const ChunkSrc cs, int koff, int voff, int lane, unsigned char* slot) {
  const unsigned ck = (unsigned)(koff * 2), cv = (unsigned)(voff * 2);
#pragma unroll
  for (int i = 0; i < 4; ++i) {
    const int r = (lane >> 3) + 8 * i;
    int kc = cs.kc0 + r; kc = kc < 0 ? 0 : (kc > cs.M - 1 ? cs.M - 1 : kc);
    const unsigned row = __umul24((unsigned)cs.d, (unsigned)kc) + (unsigned)cs.rowc;
    const unsigned rb = __umul24(row, (unsigned)(INC * 2));
    const unsigned chk = (unsigned)(((lane & 7) ^ ((r >> 1) & 7)) << 4), chv = (unsigned)(((lane & 7) ^ (((r >> 1) & 3) << 1)) << 4);
    __builtin_amdgcn_global_load_lds((const __attribute__((address_space(1))) unsigned*)((const char*)qkv + (rb + (ck + chk))), (LAS unsigned*)(slot + i * 1024), 16, 0, 0);
    __builtin_amdgcn_global_load_lds((const __attribute__((address_space(1))) unsigned*)((const char*)qkv + (rb + (cv + chv))), (LAS unsigned*)(slot + 4096 + i * 1024), 16, 0, 0);
  }
}
__device__ __forceinline__ void read_vt(unsigned a0, unsigned a1, unsigned a2, unsigned a3, bf16x8 (&Vt)[4]) {
  u32x2 r00, r01, r10, r11, r20, r21, r30, r31;
  asm volatile(
      "ds_read_b64_tr_b16 %0, %8\n\tds_read_b64_tr_b16 %1, %8 offset:2048\n\t"
      "ds_read_b64_tr_b16 %2, %9\n\tds_read_b64_tr_b16 %3, %9 offset:2048\n\t"
      "ds_read_b64_tr_b16 %4, %10\n\tds_read_b64_tr_b16 %5, %10 offset:2048\n\t"
      "ds_read_b64_tr_b16 %6, %11\n\tds_read_b64_tr_b16 %7, %11 offset:2048\n\t"
      "s_waitcnt lgkmcnt(0)"
      : "=&v"(r00), "=&v"(r01), "=&v"(r10), "=&v"(r11), "=&v"(r20), "=&v"(r21), "=&v"(r30), "=&v"(r31)
      : "v"(a0), "v"(a1), "v"(a2), "v"(a3) : "memory");
  u32x4 t;
  t.x = r00.x; t.y = r00.y; t.z = r01.x; t.w = r01.y; Vt[0] = __builtin_bit_cast(bf16x8, t);
  t.x = r10.x; t.y = r10.y; t.z = r11.x; t.w = r11.y; Vt[1] = __builtin_bit_cast(bf16x8, t);
  t.x = r20.x; t.y = r20.y; t.z = r21.x; t.w = r21.y; Vt[2] = __builtin_bit_cast(bf16x8, t);
  t.x = r30.x; t.y = r30.y; t.z = r31.x; t.w = r31.y; Vt[3] = __builtin_bit_cast(bf16x8, t);
}
__device__ __forceinline__ void tile_chunk(const bf16x8 (&Kf)[2][2], const bf16x8 (&Q)[2], const bf16x8 (&Vt)[4], f32x4 (&o)[4], f32x4& l, int kcl, int lo, unsigned span, float negm) {
  f32x4 s0 = {negm, negm, negm, negm}, s1 = s0;
  s0 = mfma16(Kf[0][0], Q[0], s0); s0 = mfma16(Kf[0][1], Q[1], s0);
  s1 = mfma16(Kf[1][0], Q[0], s1); s1 = mfma16(Kf[1][1], Q[1], s1);
  float pv[8];
#pragma unroll
  for (int j = 0; j < 4; ++j) {
    pv[j] = ((unsigned)(kcl + j - lo) <= span) ? __builtin_amdgcn_exp2f(s0[j]) : 0.f;
    pv[4 + j] = ((unsigned)(kcl + 16 + j - lo) <= span) ? __builtin_amdgcn_exp2f(s1[j]) : 0.f;
  }
  u32x4 pk; pk.x = pk2(pv[0], pv[1]); pk.y = pk2(pv[2], pv[3]); pk.z = pk2(pv[4], pv[5]); pk.w = pk2(pv[6], pv[7]);
  const bf16x8 P = __builtin_bit_cast(bf16x8, pk);
#pragma unroll
  for (int dt = 0; dt < 4; ++dt) o[dt] = mfma16(Vt[dt], P, o[dt]);
  const bf16x8 ones = {(short)0x3F80, (short)0x3F80, (short)0x3F80, (short)0x3F80, (short)0x3F80, (short)0x3F80, (short)0x3F80, (short)0x3F80};
  l = mfma16(ones, P, l);
}

template <int TMASK, class DESC>
__device__ __forceinline__ void run_branch(const bf16_t* __restrict__ qkv, const DESC& desc, int& gi, const int total, const int nchunks, const int M, const int kstart, int koff, int voff,
                                           int qcb, int qstep, int hw, float negm, int lane, unsigned char* ring, const bf16x8 (&Q)[4][2], f32x4 (&o)[4][4], f32x4 (&l)[4]) {
  const int g = lane >> 4;
  int lo[4]; unsigned span[4];
#pragma unroll
  for (int t = 0; t < 4; ++t) { const int qc = qcb + t * qstep; lo[t] = qc - hw < 0 ? 0 : qc - hw; const int hi = qc + hw > M - 1 ? M - 1 : qc + hw; span[t] = (unsigned)(hi - lo[t]); }
  const int qp = (lane & 15) >> 2, pp = lane & 3, rl = 4 * g + qp, f = (rl >> 1) & 3;
  const unsigned vbase = (unsigned)(size_t)ring + 4096 + rl * 128 + pp * 8;
  const unsigned a0 = vbase + ((0 ^ f) << 5), a1 = vbase + ((1 ^ f) << 5), a2 = vbase + ((2 ^ f) << 5), a3 = vbase + ((3 ^ f) << 5);
  const int krow = lane & 15;
  const LAS unsigned char* kb0 = (const LAS unsigned char*)ring + krow * 128 + (((0 + g) ^ (krow >> 1)) << 4);
  const LAS unsigned char* kb1 = (const LAS unsigned char*)ring + krow * 128 + (((4 + g) ^ (krow >> 1)) << 4);
#pragma unroll 1
  for (int c = 0; c < nchunks; ++c, ++gi) {
    const unsigned soff = (unsigned)(gi & (ATT_SLOTS - 1)) * 8192u;
    bf16x8 Kf[2][2];
    if constexpr (ATT_LA == 1) {
      asm volatile("s_waitcnt vmcnt(0)" ::: "memory");
      Kf[0][0] = *(const LAS bf16x8*)(kb0 + soff); Kf[0][1] = *(const LAS bf16x8*)(kb1 + soff);
      Kf[1][0] = *(const LAS bf16x8*)(kb0 + soff + 2048); Kf[1][1] = *(const LAS bf16x8*)(kb1 + soff + 2048);
      if (gi + 1 < total) issue_chunk(qkv, desc(gi + 1), koff, voff, lane, ring + ((gi + 1) & 1) * 8192);
    } else {
      if (gi + ATT_LA < total) issue_chunk(qkv, desc(gi + ATT_LA), koff, voff, lane, ring + ((gi + ATT_LA) & (ATT_SLOTS - 1)) * 8192);
      const int rem = total - 1 - gi;
      if (ATT_LA >= 3 && rem >= 3) asm volatile("s_waitcnt vmcnt(24)" ::: "memory");
      else if (ATT_LA >= 2 && rem >= 2) asm volatile("s_waitcnt vmcnt(16)" ::: "memory");
      else if (rem >= 1) asm volatile("s_waitcnt vmcnt(8)" ::: "memory");
      else asm volatile("s_waitcnt vmcnt(0)" ::: "memory");
      Kf[0][0] = *(const LAS bf16x8*)(kb0 + soff); Kf[0][1] = *(const LAS bf16x8*)(kb1 + soff);
      Kf[1][0] = *(const LAS bf16x8*)(kb0 + soff + 2048); Kf[1][1] = *(const LAS bf16x8*)(kb1 + soff + 2048);
    }
    bf16x8 Vt[4];
    read_vt(a0 + soff, a1 + soff, a2 + soff, a3 + soff, Vt);
    const int kcl = kstart + 32 * c + 4 * g;
#pragma unroll
    for (int t = 0; t < 4; ++t)
      if (TMASK & (1 << t)) tile_chunk(Kf, Q[t], Vt, o[t], l[t], kcl, lo[t], span[t], negm);
  }
}

__device__ __forceinline__ float wave_max(float v) {
#pragma unroll
  for (int o = 1; o < 64; o <<= 1) v = fmaxf(v, __shfl_xor(v, o));
  return v;
}

__device__ __forceinline__ void attn_phase(const Params& p) {
  int tid = threadIdx.x; asm volatile("" : "+v"(tid));
  const int wave = __builtin_amdgcn_readfirstlane(tid >> 6), lane = tid & 63, qi = lane & 15, g = lane >> 4;
  if (wave >= ATT_NACT) return;
  const bf16_t* qkv = (const bf16_t*)(p.ws + WS_QKV);
  bf16_t* mix = (bf16_t*)(p.ws + WS_X);
  float* ssqh = (float*)(p.ws + WS_SSQH);
  unsigned char* ring = g_shm + wave * (ATT_SLOTS * 8192);
  const float mfixA = 8.0f * LOG2E * wave_max(fabsf(p.qna[lane])) * wave_max(fabsf(p.kna[lane]));
  const float mfixB = 8.0f * LOG2E * wave_max(fabsf(p.qnb[lane])) * wave_max(fabsf(p.knb[lane]));
  const int xcd = blockIdx.x & 7, wx = (blockIdx.x >> 3) * ATT_NACT + wave, nwx = (gridDim.x >> 3) * ATT_NACT;
  for (int li = wx; li < 2048; li += nwx) {
    const int kind = (li / nwx) & 1;
    const int lk = ((li / nwx) >> 1) * nwx + (li % nwx);
    const int grp = xcd * 128 + (lk & 127), sub = lk >> 7;
    const int r64 = grp * 64;
    const int S = r64 < NPROMPT ? 2048 : 4096;
    const int row0 = r64 & ~(S - 1);
    bf16x8 Q[4][2]; f32x4 o[4][4]; f32x4 l[4];
#pragma unroll
    for (int t = 0; t < 4; ++t) {
#pragma unroll
      for (int dt = 0; dt < 4; ++dt) o[t][dt] = (f32x4){0.f, 0.f, 0.f, 0.f};
    }
    int tok[4], colb[4];
    int gi = 0;
    if (kind == 0) {
      const int sidx = (r64 - row0) >> 6, c4 = sidx & 3, p0 = (sidx >> 2) * 16, h = sub;
#pragma unroll
      for (int t = 0; t < 4; ++t) {
        tok[t] = 16 * (p0 + qi) + c4 + 4 * t; colb[t] = h * 64; l[t] = (f32x4){0.f, 0.f, 0.f, 0.f};
        const bf16_t* rp = qkv + (size_t)(row0 + tok[t]) * INC + h * 64 + g * 8;
        Q[t][0] = *(const bf16x8*)rp; Q[t][1] = *(const bf16x8*)(rp + 32);
      }
      const int koff = 512 + h * 64, voff = 1024 + h * 64;
      auto desc = [=](int i) -> ChunkSrc {
        ChunkSrc r;
        if (i < 12) { r.rowc = row0; r.d = 1; r.M = S; r.kc0 = 16 * p0 - 64 + 32 * i; }
        else if (i < 18) { r.rowc = row0 + c4; r.d = 4; r.M = S >> 2; r.kc0 = 4 * p0 - 64 + 32 * (i - 12); }
        else { const int j = i - 18, t = j / 5, c = j - 5 * t; r.rowc = row0 + c4 + 4 * t; r.d = 16; r.M = S >> 4; r.kc0 = p0 - 64 + 32 * c; }
        return r;
      };
      constexpr int TOTAL = 38;
#pragma unroll
      for (int i = 0; i < ATT_LA; ++i) issue_chunk(qkv, desc(i), koff, voff, lane, ring + i * 8192);
      run_branch<15>(qkv, desc, gi, TOTAL, 12, S, 16 * p0 - 64, koff, voff, 16 * (p0 + qi) + c4, 4, 64, -mfixA, lane, ring, Q, o, l);
      run_branch<15>(qkv, desc, gi, TOTAL, 6, S >> 2, 4 * p0 - 64, koff, voff, 4 * (p0 + qi), 1, 64, -mfixA, lane, ring, Q, o, l);
      run_branch<1>(qkv, desc, gi, TOTAL, 5, S >> 4, p0 - 64, koff, voff, p0 + qi, 0, 64, -mfixA, lane, ring, Q, o, l);
      run_branch<2>(qkv, desc, gi, TOTAL, 5, S >> 4, p0 - 64, koff, voff, p0 + qi, 0, 64, -mfixA, lane, ring, Q, o, l);
      run_branch<4>(qkv, desc, gi, TOTAL, 5, S >> 4, p0 - 64, koff, voff, p0 + qi, 0, 64, -mfixA, lane, ring, Q, o, l);
      run_branch<8>(qkv, desc, gi, TOTAL, 5, S >> 4, p0 - 64, koff, voff, p0 + qi, 0, 64, -mfixA, lane, ring, Q, o, l);
    } else {
      const int kvh = sub & 1, qsub = sub >> 1, q0 = (r64 - row0) + 16 * qsub;
#pragma unroll
      for (int t = 0; t < 4; ++t) {
        const int hq = kvh * 4 + t;
        tok[t] = q0 + qi; colb[t] = 512 + hq * 64;
        { const float sk = __builtin_amdgcn_exp2f(p.sink[hq] * LOG2E - mfixB); l[t] = (f32x4){sk, sk, sk, sk}; }
        const bf16_t* rp = qkv + (size_t)(row0 + tok[t]) * INC + 1536 + hq * 64 + g * 8;
        Q[t][0] = *(const bf16x8*)rp; Q[t][1] = *(const bf16x8*)(rp + 32);
      }
      const int koff = 2048 + kvh * 64, voff = 2176 + kvh * 64;
      auto desc = [=](int i) -> ChunkSrc { ChunkSrc r; r.rowc = row0; r.d = 1; r.M = S; r.kc0 = q0 - 128 + 32 * i; return r; };
      constexpr int TOTAL = 9;
#pragma unroll
      for (int i = 0; i < ATT_LA; ++i) issue_chunk(qkv, desc(i), koff, voff, lane, ring + i * 8192);
      run_branch<15>(qkv, desc, gi, TOTAL, 9, S, q0 - 128, koff, voff, q0 + qi, 0, 128, -mfixB, lane, ring, Q, o, l);
    }
#pragma unroll
    for (int t = 0; t < 4; ++t) {
      const float L = l[t][0];
      const float inv = 1.0f / L; float ss = 0.f;
#pragma unroll
      for (int dt = 0; dt < 4; ++dt)
#pragma unroll
        for (int j = 0; j < 4; ++j) { const float x = o[t][dt][j] * inv; o[t][dt][j] = x; ss += x * x; }
      ss += __shfl_xor(ss, 16); ss += __shfl_xor(ss, 32);
      const size_t row = (size_t)(row0 + tok[t]);
      if (g == 0) ssqh[row * 16 + (colb[t] >> 6)] = ss;
      bf16_t* dst = mix + row * DM + colb[t] + 4 * g;
#pragma unroll
      for (int dt = 0; dt < 4; ++dt) { u32x2 w; w.x = pk2(o[t][dt][0], o[t][dt][1]); w.y = pk2(o[t][dt][2], o[t][dt][3]); *(u32x2*)(dst + 16 * dt) = w; }
    }
  }
}

#define XB_TMO      128
#define XB_XCNT(j)  (256  + 64 * (j))
#define XB_XSUB(j)  (1280 + 64 * (j))
#define XB_XGEN(j)  (2304 + 64 * (j))
#define XB_TOP      3328
#define XB_TOPGEN   3392
#define XCD_BAR_WORDS 3456
#define XB_SPIN_CAP (1u << 18)
__device__ __forceinline__ unsigned xb_ld(unsigned* p)              { return __hip_atomic_load(p, __ATOMIC_RELAXED, __HIP_MEMORY_SCOPE_AGENT); }
__device__ __forceinline__ unsigned xb_add(unsigned* p, unsigned v) { return __hip_atomic_fetch_add(p, v, __ATOMIC_RELAXED, __HIP_MEMORY_SCOPE_AGENT); }
__device__ __forceinline__ unsigned xb_xcc_id() { return (unsigned)__builtin_amdgcn_s_getreg((3 << 11) | 20) & 0xFu; }
#define XB_SPIN(cond, bar) do { unsigned _sp = 0; while (cond) { __builtin_amdgcn_s_sleep(1); \
    if ((++_sp & 255u) == 0u) { if (xb_ld(&(bar)[XB_TMO])) break; if (_sp > XB_SPIN_CAP) { atomicAdd(&(bar)[XB_TMO], 1u); break; } } } } while (0)
struct XcdBarrier { unsigned* bar; unsigned x; volatile LAS unsigned* st; };
__device__ __forceinline__ XcdBarrier xcd_barrier_post(unsigned* bar, volatile LAS unsigned* st) {
  XcdBarrier b; b.bar = bar; b.x = xb_xcc_id(); b.st = st;
  if (threadIdx.x == 0) (void)xb_add(&bar[XB_XCNT(b.x)], 1u);
  return b;
}
__device__ __forceinline__ void xcd_barrier_complete(unsigned* bar, unsigned x, unsigned& nloc, unsigned& nx) {
  const unsigned G = gridDim.x * gridDim.y * gridDim.z;
  unsigned sum, cnt, mine, sp = 0u;
  for (;;) {
    sum = 0u; cnt = 0u; mine = 0u;
#pragma unroll
    for (unsigned j = 0; j < 16; ++j) { const unsigned c = xb_ld(&bar[XB_XCNT(j)]); sum += c; cnt += (c > 0u) ? 1u : 0u; mine = (j == x) ? c : mine; }
    if (sum == G) break;
    __builtin_amdgcn_s_sleep(1);
    if ((++sp & 255u) == 0u) { if (xb_ld(&bar[XB_TMO])) break; if (sp > XB_SPIN_CAP) { atomicAdd(&bar[XB_TMO], 1u); break; } }
  }
  nloc = mine > 0u ? mine : 1u; nx = cnt > 0u ? cnt : 1u;
}
__device__ __forceinline__ void xcd_barrier_impl(const XcdBarrier& b) {
  asm volatile("s_waitcnt vmcnt(0)" ::: "memory");
  __syncthreads();
  if (threadIdx.x == 0) {
    unsigned* bar = b.bar;
    __builtin_amdgcn_s_waitcnt(0);
    unsigned nloc = b.st[0], nx = b.st[1];
    if (nloc == 0u) { xcd_barrier_complete(bar, b.x, nloc, nx); b.st[0] = nloc; b.st[1] = nx; }
    const unsigned old = xb_add(&bar[XB_XSUB(b.x)], 1u);
    const unsigned gen = old / nloc;
    if (old + 1u == (gen + 1u) * nloc) {
      __builtin_amdgcn_fence(__ATOMIC_RELEASE, "agent");
      asm volatile("s_waitcnt vmcnt(0)" ::: "memory");
      const unsigned og = xb_add(&bar[XB_TOP], 1u);
      const unsigned tg = og / nx;
      if (og + 1u == (tg + 1u) * nx) xb_add(&bar[XB_TOPGEN], 1u);
      else XB_SPIN(xb_ld(&bar[XB_TOPGEN]) == tg, bar);
      __builtin_amdgcn_fence(__ATOMIC_ACQUIRE, "agent");
      xb_add(&bar[XB_XGEN(b.x)], 1u);
      asm volatile("s_waitcnt vmcnt(0)" ::: "memory");
    } else {
      XB_SPIN(xb_ld(&bar[XB_XGEN(b.x)]) == gen, bar);
      __builtin_amdgcn_fence(__ATOMIC_ACQUIRE, "agent");
      asm volatile("s_waitcnt vmcnt(0)" ::: "memory");
    }
  }
  __syncthreads();
}

__device__ __forceinline__ void xcd_barrier(unsigned char* ws) {
  XcdBarrier b; b.bar = (unsigned*)(ws + WS_BAR); b.x = xb_xcc_id(); b.st = (volatile LAS unsigned*)((LAS unsigned char*)g_shm + GEMM_LDS_BYTES);
  xcd_barrier_impl(b);
}

typedef const __attribute__((address_space(4))) Params* KArgs;
__device__ __forceinline__ Params load_params() {
#if defined(__HIP_DEVICE_COMPILE__)
  KArgs kp = (KArgs)__builtin_amdgcn_kernarg_segment_ptr();
  asm volatile("" : "+s"(kp));
  Params r;
  r.xp = kp->xp; r.xs = kp->xs; r.norm_attn = kp->norm_attn; r.w_in = kp->w_in; r.qna = kp->qna; r.kna = kp->kna; r.qnb = kp->qnb; r.knb = kp->knb; r.sink = kp->sink;
  r.ona = kp->ona; r.onb = kp->onb; r.w_o = kp->w_o; r.norm_mlp = kp->norm_mlp; r.w_up = kp->w_up; r.w_down = kp->w_down; r.out = kp->out; r.ws = kp->ws;
  return r;
#else
  return Params{};
#endif
}

__global__ void __launch_bounds__(512) fwd_megakernel(Params p_unused) {
  cg::grid_group grid = cg::this_grid();
  {
    const Params p = load_params();
    volatile LAS unsigned* xst = (volatile LAS unsigned*)((LAS unsigned char*)g_shm + GEMM_LDS_BYTES);
    if (threadIdx.x == 0) { xst[0] = 0u; xst[1] = 0u; }
    (void)xcd_barrier_post((unsigned*)(p.ws + WS_BAR), xst);
    p0_prologue(p);
    if (p.ws == nullptr) grid.sync();
    xcd_barrier(p.ws);
  }
  {
    const Params p = load_params();
    EpiQKV e{(bf16_t*)(p.ws + WS_QKV), (const float*)(p.ws + WS_RS1), p.qna, p.kna, p.qnb, p.knb};
    gemm_phase<EpiQKV, GEMM_ALIGN, GEMM_SP2>((const bf16_t*)(p.ws + WS_X), (const bf16_t*)(p.ws + WS_WIN), NTOK, INC, DM, e);
    xcd_barrier(p.ws);
  }
  {
    const Params p = load_params();
    attn_phase(p);
    xcd_barrier(p.ws);
  }
  {
    const Params p = load_params();
    EpiWo e{p.xp, p.xs, (bf16_t*)(p.ws + WS_HB), (float*)(p.ws + WS_SSQ2), (const float*)(p.ws + WS_SSQH)};
    gemm_phase<EpiWo, GEMM_ALIGN, GEMM_SP2, true>((const bf16_t*)(p.ws + WS_X), (const bf16_t*)(p.ws + WS_WO), NTOK, DM, DM, e);
    xcd_barrier(p.ws);
    { const float* sp = (const float*)(p.ws + WS_SSQ2); float* s2 = (float*)(p.ws + WS_RS1);
      for (int row = blockIdx.x * 512 + threadIdx.x; row < NTOK; row += gridDim.x * 512) {
        const f32x4 a = *(const f32x4*)(sp + (size_t)row * 16), b = *(const f32x4*)(sp + (size_t)row * 16 + 4), c = *(const f32x4*)(sp + (size_t)row * 16 + 8), d = *(const f32x4*)(sp + (size_t)row * 16 + 12);
        const float tot = (((a[0] + a[1]) + (a[2] + a[3])) + ((b[0] + b[1]) + (b[2] + b[3]))) + (((c[0] + c[1]) + (c[2] + c[3])) + ((d[0] + d[1]) + (d[2] + d[3])));
        s2[row] = rsqrtf(tot * (1.0f / DM) + EPS);
      } }
    xcd_barrier(p.ws);
  }
  for (int half = 0; half < 2; ++half) {
    const int rb = half * NPROMPT;
    {
      const Params p = load_params();
      EpiUp e{(bf16_t*)(p.ws + WS_U)};
      gemm_phase<EpiUp, GEMM_ALIGN, GEMM_SP2>((const bf16_t*)(p.ws + WS_HB) + (size_t)rb * DM, (const bf16_t*)(p.ws + WS_WUP), NPROMPT, DFF, DM, e);
      xcd_barrier(p.ws);
    }
    {
      const Params p = load_params();
      EpiDown e{(const bf16_t*)(p.ws + WS_HB), p.out, (const float*)(p.ws + WS_RS1), rb};
      gemm_phase<EpiDown, GEMM_ALIGN, GEMM_SP2>((const bf16_t*)(p.ws + WS_U), (const bf16_t*)(p.ws + WS_WD), NPROMPT, DM, DFF, e);
      if (half == 0) xcd_barrier(p.ws);
    }
  }
}

extern "C" void kernel_launch(void* const* d_in, const int* in_sizes, int n_in, void* d_out, int out_size, void* d_ws, size_t ws_size, hipStream_t stream) {
  static int grid_blocks = 0;
  if (!grid_blocks) {
    if (n_in != 15 || ws_size < WS_NEED) { fprintf(stderr, "kernel_launch: unexpected n_in %d / ws_size %zu\n", n_in, ws_size); grid_blocks = -1; return; }
    int dev = 0, cus = 0, per_cu = 0;
    hipGetDevice(&dev);
    hipDeviceGetAttribute(&cus, hipDeviceAttributeMultiprocessorCount, dev);
    if (hipFuncSetAttribute((const void*)fwd_megakernel, hipFuncAttributeMaxDynamicSharedMemorySize, LDS_BYTES) != hipSuccess) { fprintf(stderr, "hipFuncSetAttribute failed\n"); grid_blocks = -1; return; }
    hipOccupancyMaxActiveBlocksPerMultiprocessor(&per_cu, (const void*)fwd_megakernel, 512, LDS_BYTES);
    if (per_cu < 1) { fprintf(stderr, "occupancy query says %d blocks/CU\n", per_cu); per_cu = 1; }
    (void)hipGetLastError();
    grid_blocks = cus;
  }
  if (grid_blocks < 0) return;
  if (hipMemsetAsync((char*)d_ws + WS_BAR, 0, 16384, stream) != hipSuccess) { fprintf(stderr, "hipMemsetAsync of the barrier words failed\n"); return; }
  Params p{};
  p.xp = (const float*)d_in[0]; p.xs = (const float*)d_in[1]; p.norm_attn = (const float*)d_in[2]; p.w_in = (const float*)d_in[3];
  p.qna = (const float*)d_in[4]; p.kna = (const float*)d_in[5]; p.qnb = (const float*)d_in[6]; p.knb = (const float*)d_in[7];
  p.sink = (const float*)d_in[8]; p.ona = (const float*)d_in[9]; p.onb = (const float*)d_in[10]; p.w_o = (const float*)d_in[11];
  p.norm_mlp = (const float*)d_in[12]; p.w_up = (const float*)d_in[13]; p.w_down = (const float*)d_in[14];
  p.out = (float*)d_out; p.ws = (unsigned char*)d_ws;
  void* args[] = {&p};
  hipError_t e = hipLaunchCooperativeKernel((const void*)fwd_megakernel, dim3(grid_blocks), dim3(512), args, LDS_BYTES, stream);
  if (e != hipSuccess) fprintf(stderr, "cooperative launch failed: %s (grid %d)\n", hipGetErrorString(e), grid_blocks);
}
```

```cpp
#include <hip/hip_runtime.h>
#include <hip/hip_cooperative_groups.h>
#include <cstdio>
#include <cstdint>
namespace cg = cooperative_groups;

typedef unsigned short bf16_t;
typedef short bf16x8 __attribute__((ext_vector_type(8)));
typedef float f32x4 __attribute__((ext_vector_type(4)));
typedef unsigned u32x4 __attribute__((ext_vector_type(4)));
typedef unsigned u32x2 __attribute__((ext_vector_type(2)));

constexpr int DM = 1024, NTOK = 65536, NPROMPT = 32768, INC = 2304, DFF = 4096;
constexpr int FFP = DFF + 64;
constexpr float EPS = 1e-6f;
constexpr float LOG2E = 1.4426950408889634f;
constexpr float QSCALE = 0.18033688011112042f;

constexpr size_t MiB = 1048576;
constexpr size_t WS_WIN = 0, WS_WO = 4718592, WS_WUP = 6815744, WS_WD = 15204352, WS_RS1 = 23592960, WS_SSQ2 = 440 * MiB;
constexpr size_t WS_X = 24 * MiB;
constexpr size_t WS_QKV = 152 * MiB;
constexpr size_t WS_HB = 312 * MiB;
constexpr size_t WS_U = 24 * MiB;
constexpr size_t WS_SSQH = 444 * MiB;
constexpr size_t WS_BAR = 448 * MiB;
constexpr size_t WS_WDP = 450 * MiB;
constexpr size_t WS_NEED = 460 * MiB;

constexpr int GEMM_LDS_BYTES = 131072, LDS_BYTES = GEMM_LDS_BYTES + 64;
constexpr bool GEMM_ALIGN = true, GEMM_SP2 = true;
constexpr int ATT_NACT = 8;
constexpr int ATT_SLOTS = 16 / ATT_NACT, ATT_LA = ATT_SLOTS - 1;

struct Params {
  const float *xp, *xs, *norm_attn, *w_in, *qna, *kna, *qnb, *knb, *sink, *ona, *onb, *w_o, *norm_mlp, *w_up, *w_down;
  float* out;
  unsigned char* ws;
};

extern __shared__ __attribute__((aligned(16))) unsigned char g_shm[];

typedef __bf16 bf16v2_t __attribute__((ext_vector_type(2)));
typedef float f32v2_t __attribute__((ext_vector_type(2)));
__device__ __forceinline__ unsigned pk2(float lo, float hi) { const f32v2_t f = {lo, hi}; const bf16v2_t b = __builtin_convertvector(f, bf16v2_t); return __builtin_bit_cast(unsigned, b); }
__device__ __forceinline__ float bf2f(unsigned short b) { return __uint_as_float(((unsigned)b) << 16); }
__device__ __forceinline__ f32x4 mfma16(bf16x8 a, bf16x8 b, f32x4 c) { return __builtin_amdgcn_mfma_f32_16x16x32_bf16(a, b, c, 0, 0, 0); }

__device__ __forceinline__ int col_slot(int c, int mode) {
  if (mode == 0) return 128 * ((c >> 3) & 1) + 32 * (c >> 6) + 16 * ((c >> 2) & 1) + 4 * ((c >> 4) & 3) + (c & 3);
  if (mode == 1) return 128 * ((c >> 5) & 1) + 32 * (c >> 6) + 16 * ((c >> 2) & 1) + 4 * ((c >> 3) & 3) + (c & 3);
  return c;
}

constexpr int BM = 256, BK = 64, HALF = 128, HT = HALF * BK;
__device__ __forceinline__ int lds_byte(int r, int c) {
  int st = (r >> 4) * 2 + (c >> 5), rr = r & 15, cc = c & 31, ob = rr * 64 + cc * 2;
  return st * 1024 + (ob ^ (((ob >> 9) & 1) << 5));
}
__device__ __forceinline__ void stage_rc(int b, int& R, int& C) {
  int st = b / 1024, sb = b % 1024, swz = sb ^ (((sb >> 9) & 1) << 5);
  R = (st >> 1) * 16 + swz / 64; C = (st & 1) * 32 + (swz % 64) / 2;
}

__device__ __forceinline__ bool tile_of(int L, int nM, int nN, int& pm, int& pn) {
  const int nwg = nM * nN; if (L >= nwg) return false;
  int wgid = L; { const int q = nwg / 8, r = nwg % 8, xcd = wgid % 8, off = wgid / 8; wgid = (xcd < r ? xcd * (q + 1) : r * (q + 1) + (xcd - r) * q) + off; }
  const int nig = 8 * nN, gid = wgid / nig, fm = gid * 8, gsz = (nM - fm) < 8 ? (nM - fm) : 8;
  pm = fm + ((wgid % nig) % gsz); pn = (wgid % nig) / gsz; return true;
}
#define LAS __attribute__((address_space(3)))
template <class Epi, bool ALIGN_EPI, bool SP2, bool MID = false>
__device__ __forceinline__ void gemm_phase(const bf16_t* __restrict__ Ag, const bf16_t* __restrict__ Btg, const int M, const int N, const int K, const Epi& E, const int ld = 0  ) {
  LAS unsigned char* lds = (LAS unsigned char*)g_shm;
  int tid = threadIdx.x; asm volatile("" : "+v"(tid));
  const int wid = __builtin_amdgcn_readfirstlane(tid >> 6), lane = tid & 63, wr = wid >> 2, wc = wid & 3, fr = lane & 15, fq = lane >> 4;
  const int nt = K / BK, nM = M / BM, nN = N / BM, G = gridDim.x, cu = blockIdx.x;
  constexpr int HTB = HALF * BK * 2;
  unsigned voff[2];
  const int LD = ld ? ld : K;
#pragma unroll
  for (int i = 0; i < 2; ++i) { int R, C; stage_rc(tid * 16 + i * 8192, R, C); voff[i] = (unsigned)(R * LD + C) * 2u; }
  const size_t kstep = (size_t)(BK * 2), hstep = (size_t)HALF * LD * 2, tstep = 2 * hstep;
  const unsigned ldsw = (unsigned)wid * 1024u;
  const int aoff = lds_byte(wr * 64 + fr, fq * 8), boff = lds_byte(wc * 32 + fr, fq * 8);
#define PG8_SA(b, h) (((b) * 2 + (h)) * HTB)
#define PG8_SB(b, h) ((4 + (b) * 2 + (h)) * HTB)
#define PG8_STAGE(bufoff, gbase) do { _Pragma("unroll") for (int _i = 0; _i < 2; ++_i) \
    __builtin_amdgcn_global_load_lds((const __attribute__((address_space(1))) unsigned*)((const char*)(gbase) + voff[_i]), (LAS unsigned*)(lds + (bufoff) + ldsw + _i * 8192), 16, 0, 0); } while (0)
#define PG8_LDA(dst, b, h) do { _Pragma("unroll") for (int m = 0; m < 4; ++m) _Pragma("unroll") for (int k = 0; k < 2; ++k) dst[m][k] = *(const LAS bf16x8*)(lds + PG8_SA(b, h) + aoff + m * 2048 + k * 1024); } while (0)
#define PG8_LDB(dst, b, h) do { _Pragma("unroll") for (int n = 0; n < 2; ++n) _Pragma("unroll") for (int k = 0; k < 2; ++k) dst[n][k] = *(const LAS bf16x8*)(lds + PG8_SB(b, h) + boff + n * 2048 + k * 1024); } while (0)
#define PG8_MMA(ai, bj, At, Bt) do { __builtin_amdgcn_s_setprio(1); _Pragma("unroll") for (int m = 0; m < 4; ++m) _Pragma("unroll") for (int n = 0; n < 2; ++n) _Pragma("unroll") for (int k = 0; k < 2; ++k) \
    acc[ai][bj][m][n] = __builtin_amdgcn_mfma_f32_16x16x32_bf16(Bt[n][k], At[m][k], acc[ai][bj][m][n], 0, 0, 0); __builtin_amdgcn_s_setprio(0); } while (0)
#define PG8_WAIT_V(n) asm volatile("s_waitcnt vmcnt(" #n ")" ::: "memory")
#define PG8_WAIT_L(n) asm volatile("s_waitcnt lgkmcnt(" #n ")" ::: "memory")
#define PG8_BAR __builtin_amdgcn_s_barrier()
#define PG8_SCHED __builtin_amdgcn_sched_barrier(0)
  int cpm, cpn, npm = 0, npn = 0, ui = 0;
  if (!tile_of(cu, nM, nN, cpm, cpn)) return;
  f32x4 acc[2][2][4][2];
#pragma unroll
  for (int a = 0; a < 2; ++a)
#pragma unroll
    for (int b = 0; b < 2; ++b)
#pragma unroll
      for (int m = 0; m < 4; ++m)
#pragma unroll
        for (int n = 0; n < 2; ++n) acc[a][b][m][n] = (f32x4){0.f, 0.f, 0.f, 0.f};
  bf16x8 At[4][2], B0[2][2], B1[2][2];
  const char* cA = (const char*)Ag + (size_t)cpm * tstep; const char* cB = (const char*)Btg + (size_t)cpn * tstep;
  static_assert(SP2, "this body is the two-super-phase loop");
  PG8_STAGE(PG8_SB(0, 0), cB); PG8_STAGE(PG8_SB(0, 1), cB + hstep); PG8_STAGE(PG8_SA(0, 0), cA); PG8_STAGE(PG8_SA(0, 1), cA + hstep);
  PG8_STAGE(PG8_SB(1, 0), cB + kstep); PG8_STAGE(PG8_SA(1, 0), cA + kstep); PG8_STAGE(PG8_SB(1, 1), cB + hstep + kstep);
  if (wr == 1) PG8_BAR;
  PG8_WAIT_V(0); PG8_BAR;
  PG8_BAR;
#define K2_ITER(FIRST) do { \
      const bool last = (t == nt - 2); \
      const char* a1 = cA + (size_t)(t + 1) * kstep; \
      const char* a2 = last ? nA : cA + (size_t)(t + 2) * kstep; const char* b2 = last ? nB : cB + (size_t)(t + 2) * kstep; \
      const char* a3 = a2 + kstep; const char* b3 = b2 + kstep; \
      if constexpr (MID) { if (t == (nt >> 1)) E.mid(acc, cpm * BM); } \
      PG8_LDB(B0, 0, 0); PG8_LDB(B1, 0, 1); PG8_SCHED; PG8_LDA(At, 0, 0); PG8_STAGE(PG8_SA(1, 1), a1 + hstep); \
      if constexpr (!(FIRST)) PG8_WAIT_V(8); \
      PG8_WAIT_L(0); PG8_BAR; PG8_MMA(0, 0, At, B0); PG8_MMA(0, 1, At, B1); PG8_BAR; PG8_SCHED; \
      PG8_LDA(At, 0, 1); PG8_STAGE(PG8_SB(0, 0), b2); PG8_STAGE(PG8_SB(0, 1), b2 + hstep); PG8_STAGE(PG8_SA(0, 0), a2); \
      if constexpr (!(FIRST)) PG8_WAIT_V(8); \
      PG8_WAIT_L(0); PG8_BAR; PG8_MMA(1, 0, At, B0); PG8_MMA(1, 1, At, B1); PG8_BAR; PG8_SCHED; \
      PG8_LDB(B0, 1, 0); PG8_LDB(B1, 1, 1); PG8_SCHED; PG8_LDA(At, 1, 0); PG8_STAGE(PG8_SA(0, 1), a2 + hstep); \
      PG8_WAIT_V(8); PG8_WAIT_L(0); PG8_BAR; PG8_MMA(0, 0, At, B0); PG8_MMA(0, 1, At, B1); PG8_BAR; PG8_SCHED; \
      PG8_LDA(At, 1, 1); PG8_STAGE(PG8_SB(1, 0), b3); PG8_STAGE(PG8_SB(1, 1), b3 + hstep); PG8_STAGE(PG8_SA(1, 0), a3); \
      PG8_WAIT_V(8); PG8_WAIT_L(0); PG8_BAR; PG8_MMA(1, 0, At, B0); PG8_MMA(1, 1, At, B1); PG8_BAR; PG8_SCHED; \
    } while (0)
  for (;;) {
    const bool has_next = tile_of((ui + 1) * G + cu, nM, nN, npm, npn);
    const char* nA = has_next ? (const char*)Ag + (size_t)npm * tstep : cA; const char* nB = has_next ? (const char*)Btg + (size_t)npn * tstep : cB;
    { const int t = 0; K2_ITER(true); }
    for (int t = 2; t < nt; t += 2) K2_ITER(false);
    const typename Epi::Pre pre = E.pre(cpm * BM, cpn * BM);
    if constexpr (ALIGN_EPI) { if (wr == 0) PG8_BAR; }
    PG8_WAIT_V(0);
    E(acc, cpm * BM, cpn * BM, pre);
    if (!has_next) break;
#pragma unroll
    for (int a = 0; a < 2; ++a)
#pragma unroll
      for (int b = 0; b < 2; ++b)
#pragma unroll
        for (int m = 0; m < 4; ++m)
#pragma unroll
          for (int n = 0; n < 2; ++n) acc[a][b][m][n] = (f32x4){0.f, 0.f, 0.f, 0.f};
    cpm = npm; cpn = npn; cA = nA; cB = nB; ++ui;
    if constexpr (ALIGN_EPI) { if (wr == 1) PG8_BAR; }
  }
  PG8_WAIT_V(0);
  if constexpr (!ALIGN_EPI) { if (wr == 0) PG8_BAR; }
  PG8_BAR;
#undef K2_ITER
#undef PG8_SA
#undef PG8_SB
#undef PG8_STAGE
#undef PG8_LDA
#undef PG8_LDB
#undef PG8_MMA
}

#define EPI_IDS \
    int tid_ = threadIdx.x; asm volatile("" : "+v"(tid_));     \
    const int wid_ = tid_ >> 6, lane_ = tid_ & 63, wr = wid_ >> 2, wc = wid_ & 3, fr = lane_ & 15, fq = lane_ >> 4;
#define PACK16(v, w0, w1) \
    w0.x = pk2(v[0], v[1]); w0.y = pk2(v[2], v[3]); w0.z = pk2(v[4], v[5]); w0.w = pk2(v[6], v[7]); \
    w1.x = pk2(v[8], v[9]); w1.y = pk2(v[10], v[11]); w1.z = pk2(v[12], v[13]); w1.w = pk2(v[14], v[15]);

struct EpiQKV {
  bf16_t* qkv; const float* rs1; const float *qna, *kna, *qnb, *knb;
  struct Pre { float rs[8]; float gn[16]; };
  __device__ __forceinline__ Pre pre(int brow, int bcol) const {
    EPI_IDS
    (void)fr;
    Pre r;
    const int ct = bcol >> 8;
    const float* gp = nullptr; float extra = 1.f;
    if (ct < 2) { gp = qna; extra = QSCALE; } else if (ct < 4) gp = kna; else if (ct < 6) gp = nullptr; else if (ct < 8) { gp = qnb; extra = QSCALE; } else gp = (wc < 2) ? knb : nullptr;
#pragma unroll
    for (int i = 0; i < 16; ++i) r.gn[i] = gp ? gp[32 * (i >> 3) + 8 * fq + (i & 7)] * extra : 0.f;
#pragma unroll
    for (int k = 0; k < 8; ++k) r.rs[k] = rs1[brow + (k >> 2) * HALF + wr * 64 + (k & 3) * 16 + fr];
    return r;
  }
  __device__ __forceinline__ void operator()(const f32x4 (&acc)[2][2][4][2], int brow, int bcol, const Pre& pre) const {
    EPI_IDS
    const int ct = bcol >> 8;
    const bool gp = !(ct == 4 || ct == 5 || (ct == 8 && wc >= 2));
    const int smask = (brow < NPROMPT) ? 2047 : 4095;
#pragma unroll
    for (int ai = 0; ai < 2; ++ai)
#pragma unroll
      for (int m = 0; m < 4; ++m) {
        const int row = brow + ai * HALF + wr * 64 + m * 16 + fr;
        const float rs = pre.rs[ai * 4 + m];
        float v[16];
#pragma unroll
        for (int bj = 0; bj < 2; ++bj)
#pragma unroll
          for (int n = 0; n < 2; ++n)
#pragma unroll
            for (int j = 0; j < 4; ++j) v[8 * bj + 4 * n + j] = acc[ai][bj][m][n][j] * rs;
        if (gp) {
          float ss = 0.f;
#pragma unroll
          for (int i = 0; i < 16; ++i) ss += v[i] * v[i];
          ss += __shfl_xor(ss, 16); ss += __shfl_xor(ss, 32);
          const float inv = rsqrtf(ss * (1.0f / 64.0f) + EPS);
#pragma unroll
          for (int i = 0; i < 16; ++i) v[i] = v[i] * inv * pre.gn[i];
          {
            const float pos = (float)(row & smask);
            const float sgn = fq == 0 ? -1.0f : 1.0f;
#pragma unroll
            for (int i = 0; i < 8; ++i) {
              const float ci = i == 0 ? 1.5915494309e-01f : i == 1 ? 3.0863763405e-02f : i == 2 ? 5.9851857127e-03f : i == 3 ? 1.1606636412e-03f : i == 4 ? 2.2507907904e-04f : i == 5 ? 4.3647952793e-05f : i == 6 ? 8.4643308082e-06f : 1.6414262628e-06f;
              const float vp = __shfl_xor(v[i], 16);
              const float tr = __builtin_amdgcn_fractf(pos * ci);
              const float c = __builtin_amdgcn_cosf(tr), s = __builtin_amdgcn_sinf(tr);
              const float r = v[i] * c + sgn * (vp * s);
              v[i] = fq < 2 ? r : v[i];
            }
          }
        }
        u32x4 w0, w1; PACK16(v, w0, w1)
        bf16_t* dst = qkv + (size_t)row * INC + bcol + 64 * wc + 8 * fq;
        *(u32x4*)dst = w0; *(u32x4*)(dst + 32) = w1;
      }
  }
};

struct EpiWo {
  const float *xp, *xs; bf16_t* hb; float* ssq2p; const float* ssqh;
  __device__ __forceinline__ void scales(int row, float& sa, float& sb) const {
    const float* sp = ssqh + (size_t)row * 16;
    const f32x4 a = *(const f32x4*)sp, b = *(const f32x4*)(sp + 4), c = *(const f32x4*)(sp + 8), d = *(const f32x4*)(sp + 12);
    sa = rsqrtf((((a[0] + a[1]) + (a[2] + a[3])) + ((b[0] + b[1]) + (b[2] + b[3]))) * (1.0f / 512.0f) + EPS);
    sb = rsqrtf((((c[0] + c[1]) + (c[2] + c[3])) + ((d[0] + d[1]) + (d[2] + d[3]))) * (1.0f / 512.0f) + EPS);
  }
  __device__ __forceinline__ void mid(f32x4 (&acc)[2][2][4][2], int brow) const {
    EPI_IDS
    (void)wc; (void)fq;
#pragma unroll
    for (int ai = 0; ai < 2; ++ai)
#pragma unroll
      for (int m = 0; m < 4; ++m) {
        float sa, sb; scales(brow + ai * HALF + wr * 64 + m * 16 + fr, sa, sb);
        const float ratio = sa / sb;
#pragma unroll
        for (int bj = 0; bj < 2; ++bj)
#pragma unroll
          for (int n = 0; n < 2; ++n) acc[ai][bj][m][n] = acc[ai][bj][m][n] * ratio;
      }
  }
  struct Pre { f32x4 xv0[4][4]; };
  __device__ __forceinline__ Pre pre(int brow, int bcol) const {
    EPI_IDS
    Pre r;
    const float* xbase = (brow < NPROMPT) ? (xp + (size_t)brow * DM) : (xs + (size_t)(brow - NPROMPT) * DM);
#pragma unroll
    for (int m = 0; m < 4; ++m) {
      const float* xr = xbase + (size_t)(wr * 64 + m * 16 + fr) * DM + bcol + 64 * wc + 8 * fq;
#pragma unroll
      for (int q = 0; q < 4; ++q) r.xv0[m][q] = __builtin_nontemporal_load((const f32x4*)(xr + 32 * (q >> 1) + 4 * (q & 1)));
    }
    return r;
  }
  __device__ __forceinline__ void operator()(const f32x4 (&acc)[2][2][4][2], int brow, int bcol, const Pre& pre) const {
    EPI_IDS
    const float* xbase = (brow < NPROMPT) ? (xp + (size_t)brow * DM) : (xs + (size_t)(brow - NPROMPT) * DM);
#pragma unroll
    for (int ai = 0; ai < 2; ++ai) {
      f32x4 xv[4][4]; float sbv[4];
#pragma unroll
      for (int m = 0; m < 4; ++m) {
        const int rl = ai * HALF + wr * 64 + m * 16 + fr;
        const float* xr = xbase + (size_t)rl * DM + bcol + 64 * wc + 8 * fq;
#pragma unroll
        for (int q = 0; q < 4; ++q) xv[m][q] = ai == 0 ? pre.xv0[m][q] : __builtin_nontemporal_load((const f32x4*)(xr + 32 * (q >> 1) + 4 * (q & 1)));
        float sa; scales(brow + rl, sa, sbv[m]);
      }
#pragma unroll
      for (int m = 0; m < 4; ++m) {
        const int rl = ai * HALF + wr * 64 + m * 16 + fr;
        float v[16]; float ss = 0.f;
#pragma unroll
        for (int bj = 0; bj < 2; ++bj)
#pragma unroll
          for (int n = 0; n < 2; ++n)
#pragma unroll
            for (int j = 0; j < 4; ++j) { const float h = xv[m][2 * bj + n][j] + acc[ai][bj][m][n][j] * sbv[m]; v[8 * bj + 4 * n + j] = h; ss += h * h; }
        ss += __shfl_xor(ss, 16); ss += __shfl_xor(ss, 32);
        if (fq == 0) ssq2p[(size_t)(brow + rl) * 16 + (bcol >> 8) * 4 + wc] = ss;
        u32x4 w0, w1; PACK16(v, w0, w1)
        bf16_t* dst = hb + (size_t)(brow + rl) * DM + bcol + 64 * wc + 8 * fq;
        *(u32x4*)dst = w0; *(u32x4*)(dst + 32) = w1;
      }
      __builtin_amdgcn_sched_barrier(0);
    }
  }
};

struct EpiUp {
  bf16_t* u;
  struct Pre {};
  __device__ __forceinline__ Pre pre(int, int) const { return Pre{}; }
  __device__ __forceinline__ void operator()(const f32x4 (&acc)[2][2][4][2], int brow, int bcol, const Pre&) const {
    EPI_IDS
#pragma unroll
    for (int ai = 0; ai < 2; ++ai)
#pragma unroll
      for (int m = 0; m < 4; ++m) {
        const int rl = brow + ai * HALF + wr * 64 + m * 16 + fr;
        float v[16];
#pragma unroll
        for (int bj = 0; bj < 2; ++bj)
#pragma unroll
          for (int n = 0; n < 2; ++n) {
            f32x4 z = acc[ai][bj][m][n];
#pragma unroll
            for (int j = 0; j < 4; ++j) z[j] = fmaxf(z[j], 0.f);
            z = z * z;
#pragma unroll
            for (int j = 0; j < 4; ++j) v[8 * bj + 4 * n + j] = z[j];
          }
        u32x4 w0, w1; PACK16(v, w0, w1)
        bf16_t* dst = u + (size_t)rl * FFP + bcol + 64 * wc + 8 * fq;
        *(u32x4*)dst = w0; *(u32x4*)(dst + 32) = w1;
      }
  }
};

struct EpiDown {
  const bf16_t* hb; float* out; const float* s2; int row_base;
  struct Pre { u32x2 hv[2][4][2][2]; float sq[8]; };
  __device__ __forceinline__ Pre pre(int brow, int bcol) const {
    EPI_IDS
    Pre r;
#pragma unroll
    for (int ai = 0; ai < 2; ++ai)
#pragma unroll
      for (int m = 0; m < 4; ++m) {
        const size_t off = (size_t)(row_base + brow + ai * HALF + wr * 64 + m * 16 + fr) * DM + bcol + 32 * wc + 4 * fq;
#pragma unroll
        for (int bj = 0; bj < 2; ++bj)
#pragma unroll
          for (int n = 0; n < 2; ++n) r.hv[ai][m][bj][n] = *(const u32x2*)(hb + off + 128 * bj + 16 * n);
        const float s = s2[row_base + brow + ai * HALF + wr * 64 + m * 16 + fr]; r.sq[ai * 4 + m] = s * s;
      }
    return r;
  }
  __device__ __forceinline__ void operator()(const f32x4 (&acc)[2][2][4][2], int brow, int bcol, const Pre& pre) const {
    EPI_IDS
#pragma unroll
    for (int ai = 0; ai < 2; ++ai)
#pragma unroll
      for (int m = 0; m < 4; ++m) {
        const size_t off = (size_t)(row_base + brow + ai * HALF + wr * 64 + m * 16 + fr) * DM + bcol + 32 * wc + 4 * fq;
        float* dst = out + off; const float sq = pre.sq[ai * 4 + m];
#pragma unroll
        for (int bj = 0; bj < 2; ++bj)
#pragma unroll
          for (int n = 0; n < 2; ++n) {
            const unsigned a = pre.hv[ai][m][bj][n].x, b = pre.hv[ai][m][bj][n].y;
            f32x4 o;
            o[0] = __uint_as_float(a << 16) + acc[ai][bj][m][n][0] * sq; o[1] = __uint_as_float(a & 0xffff0000u) + acc[ai][bj][m][n][1] * sq;
            o[2] = __uint_as_float(b << 16) + acc[ai][bj][m][n][2] * sq; o[3] = __uint_as_float(b & 0xffff0000u) + acc[ai][bj][m][n][3] * sq;
            *(f32x4*)(dst + 128 * bj + 16 * n) = o;
          }
      }
  }
};

__device__ __forceinline__ void p0_transpose_item(const float* __restrict__ W, int K, int N, bf16_t* __restrict__ WT, const float* __restrict__ g0, const float* __restrict__ g1, float* scr, int item, int lane, int mode, int ldw = 0  ) {
  const int nblk = N / 32, kb = item / nblk, nb = item % nblk, k0 = 64 * kb, n0 = 32 * nb;
#pragma unroll 8
  for (int i = 0; i < 32; ++i) {
    const int kk = 2 * i + (lane >> 5), k = k0 + kk;
    float gv = 1.f; if (g0) gv = (g1 && k >= 512) ? g1[k - 512] : g0[k];
    scr[kk * 33 + (lane & 31)] = __builtin_nontemporal_load(W + (size_t)k * N + n0 + (lane & 31)) * gv;
  }
  asm volatile("s_waitcnt lgkmcnt(0)" ::: "memory");
  const int c = lane & 7;
#pragma unroll
  for (int j = 0; j < 4; ++j) {
    const int n = (lane >> 3) + 8 * j; const float* s = scr + (8 * c) * 33 + n;
    u32x4 o; o.x = pk2(s[0 * 33], s[1 * 33]); o.y = pk2(s[2 * 33], s[3 * 33]); o.z = pk2(s[4 * 33], s[5 * 33]); o.w = pk2(s[6 * 33], s[7 * 33]);
    const int col = n0 + n, drow = (col & ~255) + col_slot(col & 255, mode);
    *(u32x4*)(WT + (size_t)drow * (ldw ? ldw : K) + k0 + 8 * c) = o;
  }
  asm volatile("s_waitcnt lgkmcnt(0)" ::: "memory");
}

__device__ __forceinline__ void p0_prologue(const Params& p) {
  int tid = threadIdx.x; asm volatile("" : "+v"(tid));
  const int wave = tid >> 6, lane = tid & 63;
  const int gw = blockIdx.x * 8 + wave, NGW = gridDim.x * 8;
  float* scr = (float*)(g_shm + wave * 16384);
  bf16_t* WinT = (bf16_t*)(p.ws + WS_WIN); bf16_t* WoT = (bf16_t*)(p.ws + WS_WO); bf16_t* WupT = (bf16_t*)(p.ws + WS_WUP); bf16_t* WdT = (bf16_t*)(p.ws + WS_WDP);
  constexpr int I_IN = 16 * 72, I_O = 16 * 32, I_UP = 16 * 128, I_DN = 64 * 32, NIT = I_IN + I_O + I_UP + I_DN;
  for (int it = gw; it < NIT; it += NGW) {
    int r = it;
    if (r < I_IN) { p0_transpose_item(p.w_in, DM, INC, WinT, p.norm_attn, nullptr, scr, r, lane, 1); continue; } r -= I_IN;
    if (r < I_O) { p0_transpose_item(p.w_o, DM, DM, WoT, p.ona, p.onb, scr, r, lane, 1); continue; } r -= I_O;
    if (r < I_UP) { p0_transpose_item(p.w_up, DM, DFF, WupT, p.norm_mlp, nullptr, scr, r, lane, 1); continue; } r -= I_UP;
    p0_transpose_item(p.w_down, DFF, DM, WdT, nullptr, nullptr, scr, r, lane, 2, FFP);
  }
  bf16_t* xb = (bf16_t*)(p.ws + WS_X); float* rs1 = (float*)(p.ws + WS_RS1);
  for (int row4 = gw * 4; row4 < NTOK; row4 += NGW * 4) {
    f32x4 v[4][4];
#pragma unroll
    for (int r = 0; r < 4; ++r) {
      const int row = row4 + r;
      const float* xr = (row < NPROMPT) ? (p.xp + (size_t)row * DM) : (p.xs + (size_t)(row - NPROMPT) * DM);
#pragma unroll
      for (int j = 0; j < 4; ++j) v[r][j] = __builtin_nontemporal_load((const f32x4*)(xr + 256 * j + 4 * lane));
    }
#pragma unroll
    for (int r = 0; r < 4; ++r) {
      const int row = row4 + r; float s = 0.f;
#pragma unroll
      for (int j = 0; j < 4; ++j) s += (v[r][j][0] * v[r][j][0] + v[r][j][1] * v[r][j][1]) + (v[r][j][2] * v[r][j][2] + v[r][j][3] * v[r][j][3]);
#pragma unroll
      for (int o = 1; o < 64; o <<= 1) s += __shfl_xor(s, o);
#pragma unroll
      for (int j = 0; j < 4; ++j) { u32x2 w; w.x = pk2(v[r][j][0], v[r][j][1]); w.y = pk2(v[r][j][2], v[r][j][3]); *(u32x2*)(xb + (size_t)row * DM + 256 * j + 4 * lane) = w; }
      if (lane == 0) rs1[row] = rsqrtf(s * (1.0f / DM) + EPS);
    }
  }
}

struct ChunkSrc { int rowc, d, M, kc0; };

__device__ __forceinline__ void issue_chunk(const bf16_t* __restrict__ qkv, const ChunkSrc cs, int koff, int voff, int lane, unsigned char* slot) {
  const unsigned ck = (unsigned)(koff * 2), cv = (unsigned)(voff * 2);
#pragma unroll
  for (int i = 0; i < 4; ++i) {
    const int r = (lane >> 3) + 8 * i;
    int kc = cs.kc0 + r; kc = kc < 0 ? 0 : (kc > cs.M - 1 ? cs.M - 1 : kc);
    const unsigned row = __umul24((unsigned)cs.d, (unsigned)kc) + (unsigned)cs.rowc;
    const unsigned rb = __umul24(row, (unsigned)(INC * 2));
    const unsigned chk = (unsigned)(((lane & 7) ^ ((r >> 1) & 7)) << 4), chv = (unsigned)(((lane & 7) ^ (((r >> 1) & 3) << 1)) << 4);
    __builtin_amdgcn_global_load_lds((const __attribute__((address_space(1))) unsigned*)((const char*)qkv + (rb + (ck + chk))), (LAS unsigned*)(slot + i * 1024), 16, 0, 0);
    __builtin_amdgcn_global_load_lds((const __attribute__((address_space(1))) unsigned*)((const char*)qkv + (rb + (cv + chv))), (LAS unsigned*)(slot + 4096 + i * 1024), 16, 0, 0);
  }
}
__device__ __forceinline__ void read_vt(unsigned a0, unsigned a1, unsigned a2, unsigned a3, bf16x8 (&Vt)[4]) {
  u32x2 r00, r01, r10, r11, r20, r21, r30, r31;
  asm volatile(
      "ds_read_b64_tr_b16 %0, %8\n\tds_read_b64_tr_b16 %1, %8 offset:2048\n\t"
      "ds_read_b64_tr_b16 %2, %9\n\tds_read_b64_tr_b16 %3, %9 offset:2048\n\t"
      "ds_read_b64_tr_b16 %4, %10\n\tds_read_b64_tr_b16 %5, %10 offset:2048\n\t"
      "ds_read_b64_tr_b16 %6, %11\n\tds_read_b64_tr_b16 %7, %11 offset:2048\n\t"
      "s_waitcnt lgkmcnt(0)"
      : "=&v"(r00), "=&v"(r01), "=&v"(r10), "=&v"(r11), "=&v"(r20), "=&v"(r21), "=&v"(r30), "=&v"(r31)
      : "v"(a0), "v"(a1), "v"(a2), "v"(a3) : "memory");
  u32x4 t;
  t.x = r00.x; t.y = r00.y; t.z = r01.x; t.w = r01.y; Vt[0] = __builtin_bit_cast(bf16x8, t);
  t.x = r10.x; t.y = r10.y; t.z = r11.x; t.w = r11.y; Vt[1] = __builtin_bit_cast(bf16x8, t);
  t.x = r20.x; t.y = r20.y; t.z = r21.x; t.w = r21.y; Vt[2] = __builtin_bit_cast(bf16x8, t);
  t.x = r30.x; t.y = r30.y; t.z = r31.x; t.w = r31.y; Vt[3] = __builtin_bit_cast(bf16x8, t);
}
__device__ __forceinline__ void tile_chunk(const bf16x8 (&Kf)[2][2], const bf16x8 (&Q)[2], const bf16x8 (&Vt)[4], f32x4 (&o)[4], f32x4& l, int kcl, int lo, unsigned span, float negm) {
  f32x4 s0 = {negm, negm, negm, negm}, s1 = s0;
  s0 = mfma16(Kf[0][0], Q[0], s0); s0 = mfma16(Kf[0][1], Q[1], s0);
  s1 = mfma16(Kf[1][0], Q[0], s1); s1 = mfma16(Kf[1][1], Q[1], s1);
  float pv[8];
#pragma unroll
  for (int j = 0; j < 4; ++j) {
    pv[j] = ((unsigned)(kcl + j - lo) <= span) ? __builtin_amdgcn_exp2f(s0[j]) : 0.f;
    pv[4 + j] = ((unsigned)(kcl + 16 + j - lo) <= span) ? __builtin_amdgcn_exp2f(s1[j]) : 0.f;
  }
  u32x4 pk; pk.x = pk2(pv[0], pv[1]); pk.y = pk2(pv[2], pv[3]); pk.z = pk2(pv[4], pv[5]); pk.w = pk2(pv[6], pv[7]);
  const bf16x8 P = __builtin_bit_cast(bf16x8, pk);
#pragma unroll
  for (int dt = 0; dt < 4; ++dt) o[dt] = mfma16(Vt[dt], P, o[dt]);
  const bf16x8 ones = {(short)0x3F80, (short)0x3F80, (short)0x3F80, (short)0x3F80, (short)0x3F80, (short)0x3F80, (short)0x3F80, (short)0x3F80};
  l = mfma16(ones, P, l);
}

template <int TMASK, class DESC>
__device__ __forceinline__ void run_branch(const bf16_t* __restrict__ qkv, const DESC& desc, int& gi, const int total, const int nchunks, const int M, const int kstart, int koff, int voff,
                                           int qcb, int qstep, int hw, float negm, int lane, unsigned char* ring, const bf16x8 (&Q)[4][2], f32x4 (&o)[4][4], f32x4 (&l)[4]) {
  const int g = lane >> 4;
  int lo[4]; unsigned span[4];
#pragma unroll
  for (int t = 0; t < 4; ++t) { const int qc = qcb + t * qstep; lo[t] = qc - hw < 0 ? 0 : qc - hw; const int hi = qc + hw > M - 1 ? M - 1 : qc + hw; span[t] = (unsigned)(hi - lo[t]); }
  const int qp = (lane & 15) >> 2, pp = lane & 3, rl = 4 * g + qp, f = (rl >> 1) & 3;
  const unsigned vbase = (unsigned)(size_t)ring + 4096 + rl * 128 + pp * 8;
  const unsigned a0 = vbase + ((0 ^ f) << 5), a1 = vbase + ((1 ^ f) << 5), a2 = vbase + ((2 ^ f) << 5), a3 = vbase + ((3 ^ f) << 5);
  const int krow = lane & 15;
  const LAS unsigned char* kb0 = (const LAS unsigned char*)ring + krow * 128 + (((0 + g) ^ (krow >> 1)) << 4);
  const LAS unsigned char* kb1 = (const LAS unsigned char*)ring + krow * 128 + (((4 + g) ^ (krow >> 1)) << 4);
#pragma unroll 1
  for (int c = 0; c < nchunks; ++c, ++gi) {
    const unsigned soff = (unsigned)(gi & (ATT_SLOTS - 1)) * 8192u;
    bf16x8 Kf[2][2];
    if constexpr (ATT_LA == 1) {
      asm volatile("s_waitcnt vmcnt(0)" ::: "memory");
      Kf[0][0] = *(const LAS bf16x8*)(kb0 + soff); Kf[0][1] = *(const LAS bf16x8*)(kb1 + soff);
      Kf[1][0] = *(const LAS bf16x8*)(kb0 + soff + 2048); Kf[1][1] = *(const LAS bf16x8*)(kb1 + soff + 2048);
      if (gi + 1 < total) issue_chunk(qkv, desc(gi + 1), koff, voff, lane, ring + ((gi + 1) & 1) * 8192);
    } else {
      if (gi + ATT_LA < total) issue_chunk(qkv, desc(gi + ATT_LA), koff, voff, lane, ring + ((gi + ATT_LA) & (ATT_SLOTS - 1)) * 8192);
      const int rem = total - 1 - gi;
      if (ATT_LA >= 3 && rem >= 3) asm volatile("s_waitcnt vmcnt(24)" ::: "memory");
      else if (ATT_LA >= 2 && rem >= 2) asm volatile("s_waitcnt vmcnt(16)" ::: "memory");
      else if (rem >= 1) asm volatile("s_waitcnt vmcnt(8)" ::: "memory");
      else asm volatile("s_waitcnt vmcnt(0)" ::: "memory");
      Kf[0][0] = *(const LAS bf16x8*)(kb0 + soff); Kf[0][1] = *(const LAS bf16x8*)(kb1 + soff);
      Kf[1][0] = *(const LAS bf16x8*)(kb0 + soff + 2048); Kf[1][1] = *(const LAS bf16x8*)(kb1 + soff + 2048);
    }
    bf16x8 Vt[4];
    read_vt(a0 + soff, a1 + soff, a2 + soff, a3 + soff, Vt);
    const int kcl = kstart + 32 * c + 4 * g;
#pragma unroll
    for (int t = 0; t < 4; ++t)
      if (TMASK & (1 << t)) tile_chunk(Kf, Q[t], Vt, o[t], l[t], kcl, lo[t], span[t], negm);
  }
}

__device__ __forceinline__ float wave_max(float v) {
#pragma unroll
  for (int o = 1; o < 64; o <<= 1) v = fmaxf(v, __shfl_xor(v, o));
  return v;
}

__device__ __forceinline__ void attn_phase(const Params& p) {
  int tid = threadIdx.x; asm volatile("" : "+v"(tid));
  const int wave = __builtin_amdgcn_readfirstlane(tid >> 6), lane = tid & 63, qi = lane & 15, g = lane >> 4;
  if (wave >= ATT_NACT) return;
  const bf16_t* qkv = (const bf16_t*)(p.ws + WS_QKV);
  bf16_t* mix = (bf16_t*)(p.ws + WS_X);
  float* ssqh = (float*)(p.ws + WS_SSQH);
  unsigned char* ring = g_shm + wave * (ATT_SLOTS * 8192);
  const float mfixA = 8.0f * LOG2E * wave_max(fabsf(p.qna[lane])) * wave_max(fabsf(p.kna[lane]));
  const float mfixB = 8.0f * LOG2E * wave_max(fabsf(p.qnb[lane])) * wave_max(fabsf(p.knb[lane]));
  const int xcd = blockIdx.x & 7, wx = (blockIdx.x >> 3) * ATT_NACT + wave, nwx = (gridDim.x >> 3) * ATT_NACT;
  for (int li = wx; li < 2048; li += nwx) {
    const int kind = (li / nwx) & 1;
    const int lk = ((li / nwx) >> 1) * nwx + (li % nwx);
    const int grp = xcd * 128 + (lk & 127), sub = lk >> 7;
    const int r64 = grp * 64;
    const int S = r64 < NPROMPT ? 2048 : 4096;
    const int row0 = r64 & ~(S - 1);
    bf16x8 Q[4][2]; f32x4 o[4][4]; f32x4 l[4];
#pragma unroll
    for (int t = 0; t < 4; ++t) {
#pragma unroll
      for (int dt = 0; dt < 4; ++dt) o[t][dt] = (f32x4){0.f, 0.f, 0.f, 0.f};
    }
    int tok[4], colb[4];
    int gi = 0;
    if (kind == 0) {
      const int sidx = (r64 - row0) >> 6, c4 = sidx & 3, p0 = (sidx >> 2) * 16, h = sub;
#pragma unroll
      for (int t = 0; t < 4; ++t) {
        tok[t] = 16 * (p0 + qi) + c4 + 4 * t; colb[t] = h * 64; l[t] = (f32x4){0.f, 0.f, 0.f, 0.f};
        const bf16_t* rp = qkv + (size_t)(row0 + tok[t]) * INC + h * 64 + g * 8;
        Q[t][0] = *(const bf16x8*)rp; Q[t][1] = *(const bf16x8*)(rp + 32);
      }
      const int koff = 512 + h * 64, voff = 1024 + h * 64;
      auto desc = [=](int i) -> ChunkSrc {
        ChunkSrc r;
        if (i < 12) { r.rowc = row0; r.d = 1; r.M = S; r.kc0 = 16 * p0 - 64 + 32 * i; }
        else if (i < 18) { r.rowc = row0 + c4; r.d = 4; r.M = S >> 2; r.kc0 = 4 * p0 - 64 + 32 * (i - 12); }
        else { const int j = i - 18, t = j / 5, c = j - 5 * t; r.rowc = row0 + c4 + 4 * t; r.d = 16; r.M = S >> 4; r.kc0 = p0 - 64 + 32 * c; }
        return r;
      };
      constexpr int TOTAL = 38;
#pragma unroll
      for (int i = 0; i < ATT_LA; ++i) issue_chunk(qkv, desc(i), koff, voff, lane, ring + i * 8192);
      run_branch<15>(qkv, desc, gi, TOTAL, 12, S, 16 * p0 - 64, koff, voff, 16 * (p0 + qi) + c4, 4, 64, -mfixA, lane, ring, Q, o, l);
      run_branch<15>(qkv, desc, gi, TOTAL, 6, S >> 2, 4 * p0 - 64, koff, voff, 4 * (p0 + qi), 1, 64, -mfixA, lane, ring, Q, o, l);
      run_branch<1>(qkv, desc, gi, TOTAL, 5, S >> 4, p0 - 64, koff, voff, p0 + qi, 0, 64, -mfixA, lane, ring, Q, o, l);
      run_branch<2>(qkv, desc, gi, TOTAL, 5, S >> 4, p0 - 64, koff, voff, p0 + qi, 0, 64, -mfixA, lane, ring, Q, o, l);
      run_branch<4>(qkv, desc, gi, TOTAL, 5, S >> 4, p0 - 64, koff, voff, p0 + qi, 0, 64, -mfixA, lane, ring, Q, o, l);
      run_branch<8>(qkv, desc, gi, TOTAL, 5, S >> 4, p0 - 64, koff, voff, p0 + qi, 0, 64, -mfixA, lane, ring, Q, o, l);
    } else {
      const int kvh = sub & 1, qsub = sub >> 1, q0 = (r64 - row0) + 16 * qsub;
#pragma unroll
      for (int t = 0; t < 4; ++t) {
        const int hq = kvh * 4 + t;
        tok[t] = q0 + qi; colb[t] = 512 + hq * 64;
        { const float sk = __builtin_amdgcn_exp2f(p.sink[hq] * LOG2E - mfixB); l[t] = (f32x4){sk, sk, sk, sk}; }
        const bf16_t* rp = qkv + (size_t)(row0 + tok[t]) * INC + 1536 + hq * 64 + g * 8;
        Q[t][0] = *(const bf16x8*)rp; Q[t][1] = *(const bf16x8*)(rp + 32);
      }
      const int koff = 2048 + kvh * 64, voff = 2176 + kvh * 64;
      auto desc = [=](int i) -> ChunkSrc { ChunkSrc r; r.rowc = row0; r.d = 1; r.M = S; r.kc0 = q0 - 128 + 32 * i; return r; };
      constexpr int TOTAL = 9;
#pragma unroll
      for (int i = 0; i < ATT_LA; ++i) issue_chunk(qkv, desc(i), koff, voff, lane, ring + i * 8192);
      run_branch<15>(qkv, desc, gi, TOTAL, 9, S, q0 - 128, koff, voff, q0 + qi, 0, 128, -mfixB, lane, ring, Q, o, l);
    }
#pragma unroll
    for (int t = 0; t < 4; ++t) {
      const float L = l[t][0];
      const float inv = 1.0f / L; float ss = 0.f;
#pragma unroll
      for (int dt = 0; dt < 4; ++dt)
#pragma unroll
        for (int j = 0; j < 4; ++j) { const float x = o[t][dt][j] * inv; o[t][dt][j] = x; ss += x * x; }
      ss += __shfl_xor(ss, 16); ss += __shfl_xor(ss, 32);
      const size_t row = (size_t)(row0 + tok[t]);
      if (g == 0) ssqh[row * 16 + (colb[t] >> 6)] = ss;
      bf16_t* dst = mix + row * DM + colb[t] + 4 * g;
#pragma unroll
      for (int dt = 0; dt < 4; ++dt) { u32x2 w; w.x = pk2(o[t][dt][0], o[t][dt][1]); w.y = pk2(o[t][dt][2], o[t][dt][3]); *(u32x2*)(dst + 16 * dt) = w; }
    }
  }
}

#define XB_TMO      128
#define XB_XCNT(j)  (256  + 64 * (j))
#define XB_XSUB(j)  (1280 + 64 * (j))
#define XB_XGEN(j)  (2304 + 64 * (j))
#define XB_TOP      3328
#define XB_TOPGEN   3392
#define XCD_BAR_WORDS 3456
#define XB_SPIN_CAP (1u << 18)
__device__ __forceinline__ unsigned xb_ld(unsigned* p)              { return __hip_atomic_load(p, __ATOMIC_RELAXED, __HIP_MEMORY_SCOPE_AGENT); }
__device__ __forceinline__ unsigned xb_add(unsigned* p, unsigned v) { return __hip_atomic_fetch_add(p, v, __ATOMIC_RELAXED, __HIP_MEMORY_SCOPE_AGENT); }
__device__ __forceinline__ unsigned xb_xcc_id() { return (unsigned)__builtin_amdgcn_s_getreg((3 << 11) | 20) & 0xFu; }
#define XB_SPIN(cond, bar) do { unsigned _sp = 0; while (cond) { __builtin_amdgcn_s_sleep(1); \
    if ((++_sp & 255u) == 0u) { if (xb_ld(&(bar)[XB_TMO])) break; if (_sp > XB_SPIN_CAP) { atomicAdd(&(bar)[XB_TMO], 1u); break; } } } } while (0)
struct XcdBarrier { unsigned* bar; unsigned x; volatile LAS unsigned* st; };
__device__ __forceinline__ XcdBarrier xcd_barrier_post(unsigned* bar, volatile LAS unsigned* st) {
  XcdBarrier b; b.bar = bar; b.x = xb_xcc_id(); b.st = st;
  if (threadIdx.x == 0) (void)xb_add(&bar[XB_XCNT(b.x)], 1u);
  return b;
}
__device__ __forceinline__ void xcd_barrier_complete(unsigned* bar, unsigned x, unsigned& nloc, unsigned& nx) {
  const unsigned G = gridDim.x * gridDim.y * gridDim.z;
  unsigned sum, cnt, mine, sp = 0u;
  for (;;) {
    sum = 0u; cnt = 0u; mine = 0u;
#pragma unroll
    for (unsigned j = 0; j < 16; ++j) { const unsigned c = xb_ld(&bar[XB_XCNT(j)]); sum += c; cnt += (c > 0u) ? 1u : 0u; mine = (j == x) ? c : mine; }
    if (sum == G) break;
    __builtin_amdgcn_s_sleep(1);
    if ((++sp & 255u) == 0u) { if (xb_ld(&bar[XB_TMO])) break; if (sp > XB_SPIN_CAP) { atomicAdd(&bar[XB_TMO], 1u); break; } }
  }
  nloc = mine > 0u ? mine : 1u; nx = cnt > 0u ? cnt : 1u;
}
__device__ __forceinline__ void xcd_barrier_impl(const XcdBarrier& b) {
  asm volatile("s_waitcnt vmcnt(0)" ::: "memory");
  __syncthreads();
  if (threadIdx.x == 0) {
    unsigned* bar = b.bar;
    __builtin_amdgcn_s_waitcnt(0);
    unsigned nloc = b.st[0], nx = b.st[1];
    if (nloc == 0u) { xcd_barrier_complete(bar, b.x, nloc, nx); b.st[0] = nloc; b.st[1] = nx; }
    const unsigned old = xb_add(&bar[XB_XSUB(b.x)], 1u);
    const unsigned gen = old / nloc;
    if (old + 1u == (gen + 1u) * nloc) {
      __builtin_amdgcn_fence(__ATOMIC_RELEASE, "agent");
      asm volatile("s_waitcnt vmcnt(0)" ::: "memory");
      const unsigned og = xb_add(&bar[XB_TOP], 1u);
      const unsigned tg = og / nx;
      if (og + 1u == (tg + 1u) * nx) xb_add(&bar[XB_TOPGEN], 1u);
      else XB_SPIN(xb_ld(&bar[XB_TOPGEN]) == tg, bar);
      __builtin_amdgcn_fence(__ATOMIC_ACQUIRE, "agent");
      xb_add(&bar[XB_XGEN(b.x)], 1u);
      asm volatile("s_waitcnt vmcnt(0)" ::: "memory");
    } else {
      XB_SPIN(xb_ld(&bar[XB_XGEN(b.x)]) == gen, bar);
      __builtin_amdgcn_fence(__ATOMIC_ACQUIRE, "agent");
      asm volatile("s_waitcnt vmcnt(0)" ::: "memory");
    }
  }
  __syncthreads();
}

__device__ __forceinline__ void xcd_barrier(unsigned char* ws) {
  XcdBarrier b; b.bar = (unsigned*)(ws + WS_BAR); b.x = xb_xcc_id(); b.st = (volatile LAS unsigned*)((LAS unsigned char*)g_shm + GEMM_LDS_BYTES);
  xcd_barrier_impl(b);
}

typedef const __attribute__((address_space(4))) Params* KArgs;
__device__ __forceinline__ Params load_params() {
#if defined(__HIP_DEVICE_COMPILE__)
  KArgs kp = (KArgs)__builtin_amdgcn_kernarg_segment_ptr();
  asm volatile("" : "+s"(kp));
  Params r;
  r.xp = kp->xp; r.xs = kp->xs; r.norm_attn = kp->norm_attn; r.w_in = kp->w_in; r.qna = kp->qna; r.kna = kp->kna; r.qnb = kp->qnb; r.knb = kp->knb; r.sink = kp->sink;
  r.ona = kp->ona; r.onb = kp->onb; r.w_o = kp->w_o; r.norm_mlp = kp->norm_mlp; r.w_up = kp->w_up; r.w_down = kp->w_down; r.out = kp->out; r.ws = kp->ws;
  return r;
#else
  return Params{};
#endif
}

__global__ void __launch_bounds__(512) fwd_megakernel(Params p_unused) {
  cg::grid_group grid = cg::this_grid();
  {
    const Params p = load_params();
    volatile LAS unsigned* xst = (volatile LAS unsigned*)((LAS unsigned char*)g_shm + GEMM_LDS_BYTES);
    if (threadIdx.x == 0) { xst[0] = 0u; xst[1] = 0u; }
    (void)xcd_barrier_post((unsigned*)(p.ws + WS_BAR), xst);
    p0_prologue(p);
    if (p.ws == nullptr) grid.sync();
    xcd_barrier(p.ws);
  }
  {
    const Params p = load_params();
    EpiQKV e{(bf16_t*)(p.ws + WS_QKV), (const float*)(p.ws + WS_RS1), p.qna, p.kna, p.qnb, p.knb};
    gemm_phase<EpiQKV, GEMM_ALIGN, GEMM_SP2>((const bf16_t*)(p.ws + WS_X), (const bf16_t*)(p.ws + WS_WIN), NTOK, INC, DM, e);
    xcd_barrier(p.ws);
  }
  {
    const Params p = load_params();
    attn_phase(p);
    xcd_barrier(p.ws);
  }
  {
    const Params p = load_params();
    EpiWo e{p.xp, p.xs, (bf16_t*)(p.ws + WS_HB), (float*)(p.ws + WS_SSQ2), (const float*)(p.ws + WS_SSQH)};
    gemm_phase<EpiWo, GEMM_ALIGN, GEMM_SP2, true>((const bf16_t*)(p.ws + WS_X), (const bf16_t*)(p.ws + WS_WO), NTOK, DM, DM, e);
    xcd_barrier(p.ws);
    { const float* sp = (const float*)(p.ws + WS_SSQ2); float* s2 = (float*)(p.ws + WS_RS1);
      for (int row = blockIdx.x * 512 + threadIdx.x; row < NTOK; row += gridDim.x * 512) {
        const f32x4 a = *(const f32x4*)(sp + (size_t)row * 16), b = *(const f32x4*)(sp + (size_t)row * 16 + 4), c = *(const f32x4*)(sp + (size_t)row * 16 + 8), d = *(const f32x4*)(sp + (size_t)row * 16 + 12);
        const float tot = (((a[0] + a[1]) + (a[2] + a[3])) + ((b[0] + b[1]) + (b[2] + b[3]))) + (((c[0] + c[1]) + (c[2] + c[3])) + ((d[0] + d[1]) + (d[2] + d[3])));
        s2[row] = rsqrtf(tot * (1.0f / DM) + EPS);
      } }
    xcd_barrier(p.ws);
  }
  for (int half = 0; half < 2; ++half) {
    const int rb = half * NPROMPT;
    {
      const Params p = load_params();
      EpiUp e{(bf16_t*)(p.ws + WS_U)};
      gemm_phase<EpiUp, GEMM_ALIGN, GEMM_SP2>((const bf16_t*)(p.ws + WS_HB) + (size_t)rb * DM, (const bf16_t*)(p.ws + WS_WUP), NPROMPT, DFF, DM, e);
      xcd_barrier(p.ws);
    }
    {
      const Params p = load_params();
      EpiDown e{(const bf16_t*)(p.ws + WS_HB), p.out, (const float*)(p.ws + WS_RS1), rb};
      gemm_phase<EpiDown, GEMM_ALIGN, GEMM_SP2>((const bf16_t*)(p.ws + WS_U), (const bf16_t*)(p.ws + WS_WDP), NPROMPT, DM, DFF, e, FFP);
      if (half == 0) xcd_barrier(p.ws);
    }
  }
}

extern "C" void kernel_launch(void* const* d_in, const int* in_sizes, int n_in, void* d_out, int out_size, void* d_ws, size_t ws_size, hipStream_t stream) {
  static int grid_blocks = 0;
  if (!grid_blocks) {
    if (n_in != 15 || ws_size < WS_NEED) { fprintf(stderr, "kernel_launch: unexpected n_in %d / ws_size %zu\n", n_in, ws_size); grid_blocks = -1; return; }
    int dev = 0, cus = 0, per_cu = 0;
    hipGetDevice(&dev);
    hipDeviceGetAttribute(&cus, hipDeviceAttributeMultiprocessorCount, dev);
    if (hipFuncSetAttribute((const void*)fwd_megakernel, hipFuncAttributeMaxDynamicSharedMemorySize, LDS_BYTES) != hipSuccess) { fprintf(stderr, "hipFuncSetAttribute failed\n"); grid_blocks = -1; return; }
    hipOccupancyMaxActiveBlocksPerMultiprocessor(&per_cu, (const void*)fwd_megakernel, 512, LDS_BYTES);
    if (per_cu < 1) { fprintf(stderr, "occupancy query says %d blocks/CU\n", per_cu); per_cu = 1; }
    (void)hipGetLastError();
    grid_blocks = cus;
  }
  if (grid_blocks < 0) return;
  if (hipMemsetAsync((char*)d_ws + WS_BAR, 0, 16384, stream) != hipSuccess) { fprintf(stderr, "hipMemsetAsync of the barrier words failed\n"); return; }
  Params p{};
  p.xp = (const float*)d_in[0]; p.xs = (const float*)d_in[1]; p.norm_attn = (const float*)d_in[2]; p.w_in = (const float*)d_in[3];
  p.qna = (const float*)d_in[4]; p.kna = (const float*)d_in[5]; p.qnb = (const float*)d_in[6]; p.knb = (const float*)d_in[7];
  p.sink = (const float*)d_in[8]; p.ona = (const float*)d_in[9]; p.onb = (const float*)d_in[10]; p.w_o = (const float*)d_in[11];
  p.norm_mlp = (const float*)d_in[12]; p.w_up = (const float*)d_in[13]; p.w_down = (const float*)d_in[14];
  p.out = (float*)d_out; p.ws = (unsigned char*)d_ws;
  void* args[] = {&p};
  hipError_t e = hipLaunchCooperativeKernel((const void*)fwd_megakernel, dim3(grid_blocks), dim3(512), args, LDS_BYTES, stream);
  if (e != hipSuccess) fprintf(stderr, "cooperative launch failed: %s (grid %d)\n", hipGetErrorString(e), grid_blocks);
}
```

```cpp
#include <hip/hip_runtime.h>
#include <hip/hip_cooperative_groups.h>
#include <cstdio>
#include <cstdint>
namespace cg = cooperative_groups;

typedef unsigned short bf16_t;
typedef short bf16x8 __attribute__((ext_vector_type(8)));
typedef float f32x4 __attribute__((ext_vector_type(4)));
typedef unsigned u32x4 __attribute__((ext_vector_type(4)));
typedef unsigned u32x2 __attribute__((ext_vector_type(2)));

constexpr int DM = 1024, NTOK = 65536, NPROMPT = 32768, INC = 2304, DFF = 4096;
constexpr int FFP = DFF + 64;
constexpr float EPS = 1e-6f;
constexpr float LOG2E = 1.4426950408889634f;
constexpr float QSCALE = 0.18033688011112042f;

constexpr size_t MiB = 1048576;
constexpr size_t WS_WIN = 0, WS_WO = 4718592, WS_WUP = 6815744, WS_WD = 15204352, WS_RS1 = 23592960, WS_SSQ2 = 440 * MiB;
constexpr size_t WS_X = 24 * MiB;
constexpr size_t WS_QKV = 152 * MiB;
constexpr size_t WS_HB = 312 * MiB;
constexpr size_t WS_U = 24 * MiB;
constexpr size_t WS_SSQH = 444 * MiB;
constexpr size_t WS_BAR = 448 * MiB;
constexpr size_t WS_WDP = 450 * MiB;
constexpr size_t WS_NEED = 460 * MiB;

constexpr int GEMM_LDS_BYTES = 131072, LDS_BYTES = GEMM_LDS_BYTES + 64;
constexpr bool GEMM_ALIGN = true, GEMM_SP2 = true;
constexpr int ATT_NACT = 8;
constexpr int ATT_SLOTS = 16 / ATT_NACT, ATT_LA = ATT_SLOTS - 1;

struct Params {
  const float *xp, *xs, *norm_attn, *w_in, *qna, *kna, *qnb, *knb, *sink, *ona, *onb, *w_o, *norm_mlp, *w_up, *w_down;
  float* out;
  unsigned char* ws;
};

extern __shared__ __attribute__((aligned(16))) unsigned char g_shm[];

typedef __bf16 bf16v2_t __attribute__((ext_vector_type(2)));
typedef float f32v2_t __attribute__((ext_vector_type(2)));
__device__ __forceinline__ unsigned pk2(float lo, float hi) { const f32v2_t f = {lo, hi}; const bf16v2_t b = __builtin_convertvector(f, bf16v2_t); return __builtin_bit_cast(unsigned, b); }
__device__ __forceinline__ float bf2f(unsigned short b) { return __uint_as_float(((unsigned)b) << 16); }
__device__ __forceinline__ f32x4 mfma16(bf16x8 a, bf16x8 b, f32x4 c) { return __builtin_amdgcn_mfma_f32_16x16x32_bf16(a, b, c, 0, 0, 0); }

__device__ __forceinline__ int col_slot(int c, int mode) {
  if (mode == 0) return 128 * ((c >> 3) & 1) + 32 * (c >> 6) + 16 * ((c >> 2) & 1) + 4 * ((c >> 4) & 3) + (c & 3);
  if (mode == 1) return 128 * ((c >> 5) & 1) + 32 * (c >> 6) + 16 * ((c >> 2) & 1) + 4 * ((c >> 3) & 3) + (c & 3);
  return c;
}

constexpr int BM = 256, BK = 64, HALF = 128, HT = HALF * BK;
__device__ __forceinline__ int lds_byte(int r, int c) {
  int st = (r >> 4) * 2 + (c >> 5), rr = r & 15, cc = c & 31, ob = rr * 64 + cc * 2;
  return st * 1024 + (ob ^ (((ob >> 9) & 1) << 5));
}
__device__ __forceinline__ void stage_rc(int b, int& R, int& C) {
  int st = b / 1024, sb = b % 1024, swz = sb ^ (((sb >> 9) & 1) << 5);
  R = (st >> 1) * 16 + swz / 64; C = (st & 1) * 32 + (swz % 64) / 2;
}

__device__ __forceinline__ bool tile_of(int L, int nM, int nN, int& pm, int& pn) {
  const int nwg = nM * nN; if (L >= nwg) return false;
  int wgid = L; { const int q = nwg / 8, r = nwg % 8, xcd = wgid % 8, off = wgid / 8; wgid = (xcd < r ? xcd * (q + 1) : r * (q + 1) + (xcd - r) * q) + off; }
  const int nig = 8 * nN, gid = wgid / nig, fm = gid * 8, gsz = (nM - fm) < 8 ? (nM - fm) : 8;
  pm = fm + ((wgid % nig) % gsz); pn = (wgid % nig) / gsz; return true;
}
#define LAS __attribute__((address_space(3)))
template <class Epi, bool ALIGN_EPI, bool SP2, bool MID = false>
__device__ __forceinline__ void gemm_phase(const bf16_t* __restrict__ Ag, const bf16_t* __restrict__ Btg, const int M, const int N, const int K, const Epi& E, const int ld = 0  ) {
  LAS unsigned char* lds = (LAS unsigned char*)g_shm;
  int tid = threadIdx.x; asm volatile("" : "+v"(tid));
  const int wid = __builtin_amdgcn_readfirstlane(tid >> 6), lane = tid & 63, wr = wid >> 2, wc = wid & 3, fr = lane & 15, fq = lane >> 4;
  const int nt = K / BK, nM = M / BM, nN = N / BM, G = gridDim.x, cu = blockIdx.x;
  constexpr int HTB = HALF * BK * 2;
  unsigned voff[2];
  const bool kblocked = ld < 0;
  const int LD = kblocked ? BK : (ld ? ld : K);
#pragma unroll
  for (int i = 0; i < 2; ++i) { int R, C; stage_rc(tid * 16 + i * 8192, R, C); voff[i] = (unsigned)(R * LD + C) * 2u; }
  const size_t kstep = kblocked ? (size_t)(BM * BK * 2) : (size_t)(BK * 2), hstep = (size_t)HALF * LD * 2, tstep = kblocked ? (size_t)nt * kstep : 2 * hstep;
  const unsigned ldsw = (unsigned)wid * 1024u;
  const int aoff = lds_byte(wr * 64 + fr, fq * 8), boff = lds_byte(wc * 32 + fr, fq * 8);
#define PG8_SA(b, h) (((b) * 2 + (h)) * HTB)
#define PG8_SB(b, h) ((4 + (b) * 2 + (h)) * HTB)
#define PG8_STAGE(bufoff, gbase) do { _Pragma("unroll") for (int _i = 0; _i < 2; ++_i) \
    __builtin_amdgcn_global_load_lds((const __attribute__((address_space(1))) unsigned*)((const char*)(gbase) + voff[_i]), (LAS unsigned*)(lds + (bufoff) + ldsw + _i * 8192), 16, 0, 0); } while (0)
#define PG8_LDA(dst, b, h) do { _Pragma("unroll") for (int m = 0; m < 4; ++m) _Pragma("unroll") for (int k = 0; k < 2; ++k) dst[m][k] = *(const LAS bf16x8*)(lds + PG8_SA(b, h) + aoff + m * 2048 + k * 1024); } while (0)
#define PG8_LDB(dst, b, h) do { _Pragma("unroll") for (int n = 0; n < 2; ++n) _Pragma("unroll") for (int k = 0; k < 2; ++k) dst[n][k] = *(const LAS bf16x8*)(lds + PG8_SB(b, h) + boff + n * 2048 + k * 1024); } while (0)
#define PG8_MMA(ai, bj, At, Bt) do { __builtin_amdgcn_s_setprio(1); _Pragma("unroll") for (int m = 0; m < 4; ++m) _Pragma("unroll") for (int n = 0; n < 2; ++n) _Pragma("unroll") for (int k = 0; k < 2; ++k) \
    acc[ai][bj][m][n] = __builtin_amdgcn_mfma_f32_16x16x32_bf16(Bt[n][k], At[m][k], acc[ai][bj][m][n], 0, 0, 0); __builtin_amdgcn_s_setprio(0); } while (0)
#define PG8_WAIT_V(n) asm volatile("s_waitcnt vmcnt(" #n ")" ::: "memory")
#define PG8_WAIT_L(n) asm volatile("s_waitcnt lgkmcnt(" #n ")" ::: "memory")
#define PG8_BAR __builtin_amdgcn_s_barrier()
#define PG8_SCHED __builtin_amdgcn_sched_barrier(0)
  int cpm, cpn, npm = 0, npn = 0, ui = 0;
  if (!tile_of(cu, nM, nN, cpm, cpn)) return;
  f32x4 acc[2][2][4][2];
#pragma unroll
  for (int a = 0; a < 2; ++a)
#pragma unroll
    for (int b = 0; b < 2; ++b)
#pragma unroll
      for (int m = 0; m < 4; ++m)
#pragma unroll
        for (int n = 0; n < 2; ++n) acc[a][b][m][n] = (f32x4){0.f, 0.f, 0.f, 0.f};
  bf16x8 At[4][2], B0[2][2], B1[2][2];
  const char* cA = (const char*)Ag + (size_t)cpm * tstep; const char* cB = (const char*)Btg + (size_t)cpn * tstep;
  static_assert(SP2, "this body is the two-super-phase loop");
  PG8_STAGE(PG8_SB(0, 0), cB); PG8_STAGE(PG8_SB(0, 1), cB + hstep); PG8_STAGE(PG8_SA(0, 0), cA); PG8_STAGE(PG8_SA(0, 1), cA + hstep);
  PG8_STAGE(PG8_SB(1, 0), cB + kstep); PG8_STAGE(PG8_SA(1, 0), cA + kstep); PG8_STAGE(PG8_SB(1, 1), cB + hstep + kstep);
  if (wr == 1) PG8_BAR;
  PG8_WAIT_V(0); PG8_BAR;
  PG8_BAR;
#define K2_ITER(FIRST) do { \
      const bool last = (t == nt - 2); \
      const char* a1 = cA + (size_t)(t + 1) * kstep; \
      const char* a2 = last ? nA : cA + (size_t)(t + 2) * kstep; const char* b2 = last ? nB : cB + (size_t)(t + 2) * kstep; \
      const char* a3 = a2 + kstep; const char* b3 = b2 + kstep; \
      if constexpr (MID) { if (t == (nt >> 1)) E.mid(acc, cpm * BM); } \
      PG8_LDB(B0, 0, 0); PG8_LDB(B1, 0, 1); PG8_SCHED; PG8_LDA(At, 0, 0); PG8_STAGE(PG8_SA(1, 1), a1 + hstep); \
      if constexpr (!(FIRST)) PG8_WAIT_V(8); \
      PG8_WAIT_L(0); PG8_BAR; PG8_MMA(0, 0, At, B0); PG8_MMA(0, 1, At, B1); PG8_BAR; PG8_SCHED; \
      PG8_LDA(At, 0, 1); PG8_STAGE(PG8_SB(0, 0), b2); PG8_STAGE(PG8_SB(0, 1), b2 + hstep); PG8_STAGE(PG8_SA(0, 0), a2); \
      if constexpr (!(FIRST)) PG8_WAIT_V(8); \
      PG8_WAIT_L(0); PG8_BAR; PG8_MMA(1, 0, At, B0); PG8_MMA(1, 1, At, B1); PG8_BAR; PG8_SCHED; \
      PG8_LDB(B0, 1, 0); PG8_LDB(B1, 1, 1); PG8_SCHED; PG8_LDA(At, 1, 0); PG8_STAGE(PG8_SA(0, 1), a2 + hstep); \
      PG8_WAIT_V(8); PG8_WAIT_L(0); PG8_BAR; PG8_MMA(0, 0, At, B0); PG8_MMA(0, 1, At, B1); PG8_BAR; PG8_SCHED; \
      PG8_LDA(At, 1, 1); PG8_STAGE(PG8_SB(1, 0), b3); PG8_STAGE(PG8_SB(1, 1), b3 + hstep); PG8_STAGE(PG8_SA(1, 0), a3); \
      PG8_WAIT_V(8); PG8_WAIT_L(0); PG8_BAR; PG8_MMA(1, 0, At, B0); PG8_MMA(1, 1, At, B1); PG8_BAR; PG8_SCHED; \
    } while (0)
  for (;;) {
    const bool has_next = tile_of((ui + 1) * G + cu, nM, nN, npm, npn);
    const char* nA = has_next ? (const char*)Ag + (size_t)npm * tstep : cA; const char* nB = has_next ? (const char*)Btg + (size_t)npn * tstep : cB;
    { const int t = 0; K2_ITER(true); }
    for (int t = 2; t < nt; t += 2) K2_ITER(false);
    const typename Epi::Pre pre = E.pre(cpm * BM, cpn * BM);
    if constexpr (ALIGN_EPI) { if (wr == 0) PG8_BAR; }
    PG8_WAIT_V(0);
    E(acc, cpm * BM, cpn * BM, pre);
    if (!has_next) break;
#pragma unroll
    for (int a = 0; a < 2; ++a)
#pragma unroll
      for (int b = 0; b < 2; ++b)
#pragma unroll
        for (int m = 0; m < 4; ++m)
#pragma unroll
          for (int n = 0; n < 2; ++n) acc[a][b][m][n] = (f32x4){0.f, 0.f, 0.f, 0.f};
    cpm = npm; cpn = npn; cA = nA; cB = nB; ++ui;
    if constexpr (ALIGN_EPI) { if (wr == 1) PG8_BAR; }
  }
  PG8_WAIT_V(0);
  if constexpr (!ALIGN_EPI) { if (wr == 0) PG8_BAR; }
  PG8_BAR;
#undef K2_ITER
#undef PG8_SA
#undef PG8_SB
#undef PG8_STAGE
#undef PG8_LDA
#undef PG8_LDB
#undef PG8_MMA
}

#define EPI_IDS \
    int tid_ = threadIdx.x; asm volatile("" : "+v"(tid_));     \
    const int wid_ = tid_ >> 6, lane_ = tid_ & 63, wr = wid_ >> 2, wc = wid_ & 3, fr = lane_ & 15, fq = lane_ >> 4;
#define PACK16(v, w0, w1) \
    w0.x = pk2(v[0], v[1]); w0.y = pk2(v[2], v[3]); w0.z = pk2(v[4], v[5]); w0.w = pk2(v[6], v[7]); \
    w1.x = pk2(v[8], v[9]); w1.y = pk2(v[10], v[11]); w1.z = pk2(v[12], v[13]); w1.w = pk2(v[14], v[15]);

struct EpiQKV {
  bf16_t* qkv; const float* rs1; const float *qna, *kna, *qnb, *knb;
  struct Pre { float rs[8]; float gn[16]; };
  __device__ __forceinline__ Pre pre(int brow, int bcol) const {
    EPI_IDS
    (void)fr;
    Pre r;
    const int ct = bcol >> 8;
    const float* gp = nullptr; float extra = 1.f;
    if (ct < 2) { gp = qna; extra = QSCALE; } else if (ct < 4) gp = kna; else if (ct < 6) gp = nullptr; else if (ct < 8) { gp = qnb; extra = QSCALE; } else gp = (wc < 2) ? knb : nullptr;
#pragma unroll
    for (int i = 0; i < 16; ++i) r.gn[i] = gp ? gp[32 * (i >> 3) + 8 * fq + (i & 7)] * extra : 0.f;
#pragma unroll
    for (int k = 0; k < 8; ++k) r.rs[k] = rs1[brow + (k >> 2) * HALF + wr * 64 + (k & 3) * 16 + fr];
    return r;
  }
  __device__ __forceinline__ void operator()(const f32x4 (&acc)[2][2][4][2], int brow, int bcol, const Pre& pre) const {
    EPI_IDS
    const int ct = bcol >> 8;
    const bool gp = !(ct == 4 || ct == 5 || (ct == 8 && wc >= 2));
    const int smask = (brow < NPROMPT) ? 2047 : 4095;
#pragma unroll
    for (int ai = 0; ai < 2; ++ai)
#pragma unroll
      for (int m = 0; m < 4; ++m) {
        const int row = brow + ai * HALF + wr * 64 + m * 16 + fr;
        const float rs = pre.rs[ai * 4 + m];
        float v[16];
#pragma unroll
        for (int bj = 0; bj < 2; ++bj)
#pragma unroll
          for (int n = 0; n < 2; ++n)
#pragma unroll
            for (int j = 0; j < 4; ++j) v[8 * bj + 4 * n + j] = acc[ai][bj][m][n][j] * rs;
        if (gp) {
          float ss = 0.f;
#pragma unroll
          for (int i = 0; i < 16; ++i) ss += v[i] * v[i];
          ss += __shfl_xor(ss, 16); ss += __shfl_xor(ss, 32);
          const float inv = rsqrtf(ss * (1.0f / 64.0f) + EPS);
#pragma unroll
          for (int i = 0; i < 16; ++i) v[i] = v[i] * inv * pre.gn[i];
          {
            const float pos = (float)(row & smask);
            const float sgn = fq == 0 ? -1.0f : 1.0f;
#pragma unroll
            for (int i = 0; i < 8; ++i) {
              const float ci = i == 0 ? 1.5915494309e-01f : i == 1 ? 3.0863763405e-02f : i == 2 ? 5.9851857127e-03f : i == 3 ? 1.1606636412e-03f : i == 4 ? 2.2507907904e-04f : i == 5 ? 4.3647952793e-05f : i == 6 ? 8.4643308082e-06f : 1.6414262628e-06f;
              const float vp = __shfl_xor(v[i], 16);
              const float tr = __builtin_amdgcn_fractf(pos * ci);
              const float c = __builtin_amdgcn_cosf(tr), s = __builtin_amdgcn_sinf(tr);
              const float r = v[i] * c + sgn * (vp * s);
              v[i] = fq < 2 ? r : v[i];
            }
          }
        }
        u32x4 w0, w1; PACK16(v, w0, w1)
        bf16_t* dst = qkv + (size_t)row * INC + bcol + 64 * wc + 8 * fq;
        *(u32x4*)dst = w0; *(u32x4*)(dst + 32) = w1;
      }
  }
};

struct EpiWo {
  const float *xp, *xs; bf16_t* hb; float* ssq2p; const float* ssqh;
  __device__ __forceinline__ void scales(int row, float& sa, float& sb) const {
    const float* sp = ssqh + (size_t)row * 16;
    const f32x4 a = *(const f32x4*)sp, b = *(const f32x4*)(sp + 4), c = *(const f32x4*)(sp + 8), d = *(const f32x4*)(sp + 12);
    sa = rsqrtf((((a[0] + a[1]) + (a[2] + a[3])) + ((b[0] + b[1]) + (b[2] + b[3]))) * (1.0f / 512.0f) + EPS);
    sb = rsqrtf((((c[0] + c[1]) + (c[2] + c[3])) + ((d[0] + d[1]) + (d[2] + d[3]))) * (1.0f / 512.0f) + EPS);
  }
  __device__ __forceinline__ void mid(f32x4 (&acc)[2][2][4][2], int brow) const {
    EPI_IDS
    (void)wc; (void)fq;
#pragma unroll
    for (int ai = 0; ai < 2; ++ai)
#pragma unroll
      for (int m = 0; m < 4; ++m) {
        float sa, sb; scales(brow + ai * HALF + wr * 64 + m * 16 + fr, sa, sb);
        const float ratio = sa / sb;
#pragma unroll
        for (int bj = 0; bj < 2; ++bj)
#pragma unroll
          for (int n = 0; n < 2; ++n) acc[ai][bj][m][n] = acc[ai][bj][m][n] * ratio;
      }
  }
  struct Pre { f32x4 xv0[4][4]; };
  __device__ __forceinline__ Pre pre(int brow, int bcol) const {
    EPI_IDS
    Pre r;
    const float* xbase = (brow < NPROMPT) ? (xp + (size_t)brow * DM) : (xs + (size_t)(brow - NPROMPT) * DM);
#pragma unroll
    for (int m = 0; m < 4; ++m) {
      const float* xr = xbase + (size_t)(wr * 64 + m * 16 + fr) * DM + bcol + 64 * wc + 8 * fq;
#pragma unroll
      for (int q = 0; q < 4; ++q) r.xv0[m][q] = __builtin_nontemporal_load((const f32x4*)(xr + 32 * (q >> 1) + 4 * (q & 1)));
    }
    return r;
  }
  __device__ __forceinline__ void operator()(const f32x4 (&acc)[2][2][4][2], int brow, int bcol, const Pre& pre) const {
    EPI_IDS
    const float* xbase = (brow < NPROMPT) ? (xp + (size_t)brow * DM) : (xs + (size_t)(brow - NPROMPT) * DM);
#pragma unroll
    for (int ai = 0; ai < 2; ++ai) {
      f32x4 xv[4][4]; float sbv[4];
#pragma unroll
      for (int m = 0; m < 4; ++m) {
        const int rl = ai * HALF + wr * 64 + m * 16 + fr;
        const float* xr = xbase + (size_t)rl * DM + bcol + 64 * wc + 8 * fq;
#pragma unroll
        for (int q = 0; q < 4; ++q) xv[m][q] = ai == 0 ? pre.xv0[m][q] : __builtin_nontemporal_load((const f32x4*)(xr + 32 * (q >> 1) + 4 * (q & 1)));
        float sa; scales(brow + rl, sa, sbv[m]);
      }
#pragma unroll
      for (int m = 0; m < 4; ++m) {
        const int rl = ai * HALF + wr * 64 + m * 16 + fr;
        float v[16]; float ss = 0.f;
#pragma unroll
        for (int bj = 0; bj < 2; ++bj)
#pragma unroll
          for (int n = 0; n < 2; ++n)
#pragma unroll
            for (int j = 0; j < 4; ++j) { const float h = xv[m][2 * bj + n][j] + acc[ai][bj][m][n][j] * sbv[m]; v[8 * bj + 4 * n + j] = h; ss += h * h; }
        ss += __shfl_xor(ss, 16); ss += __shfl_xor(ss, 32);
        if (fq == 0) ssq2p[(size_t)(brow + rl) * 16 + (bcol >> 8) * 4 + wc] = ss;
        u32x4 w0, w1; PACK16(v, w0, w1)
        bf16_t* dst = hb + (size_t)(brow + rl) * DM + bcol + 64 * wc + 8 * fq;
        *(u32x4*)dst = w0; *(u32x4*)(dst + 32) = w1;
      }
      __builtin_amdgcn_sched_barrier(0);
    }
  }
};

struct EpiUp {
  bf16_t* u;
  struct Pre {};
  __device__ __forceinline__ Pre pre(int, int) const { return Pre{}; }
  __device__ __forceinline__ void operator()(const f32x4 (&acc)[2][2][4][2], int brow, int bcol, const Pre&) const {
    EPI_IDS
#pragma unroll
    for (int ai = 0; ai < 2; ++ai)
#pragma unroll
      for (int m = 0; m < 4; ++m) {
        const int rl = brow + ai * HALF + wr * 64 + m * 16 + fr;
        float v[16];
#pragma unroll
        for (int bj = 0; bj < 2; ++bj)
#pragma unroll
          for (int n = 0; n < 2; ++n) {
            f32x4 z = acc[ai][bj][m][n];
#pragma unroll
            for (int j = 0; j < 4; ++j) z[j] = fmaxf(z[j], 0.f);
            z = z * z;
#pragma unroll
            for (int j = 0; j < 4; ++j) v[8 * bj + 4 * n + j] = z[j];
          }
        u32x4 w0, w1; PACK16(v, w0, w1)
        bf16_t* dst = u + ((((size_t)(brow >> 8) * (DFF / 64) + (bcol >> 6) + wc) * 256 + (ai * HALF + wr * 64 + m * 16 + fr)) * 64 + 8 * fq);
        *(u32x4*)dst = w0; *(u32x4*)(dst + 32) = w1;
      }
  }
};

struct EpiDown {
  const bf16_t* hb; float* out; const float* s2; int row_base;
  struct Pre { u32x2 hv[2][4][2][2]; float sq[8]; };
  __device__ __forceinline__ Pre pre(int brow, int bcol) const {
    EPI_IDS
    Pre r;
#pragma unroll
    for (int ai = 0; ai < 2; ++ai)
#pragma unroll
      for (int m = 0; m < 4; ++m) {
        const size_t off = (size_t)(row_base + brow + ai * HALF + wr * 64 + m * 16 + fr) * DM + bcol + 32 * wc + 4 * fq;
#pragma unroll
        for (int bj = 0; bj < 2; ++bj)
#pragma unroll
          for (int n = 0; n < 2; ++n) r.hv[ai][m][bj][n] = *(const u32x2*)(hb + off + 128 * bj + 16 * n);
        const float s = s2[row_base + brow + ai * HALF + wr * 64 + m * 16 + fr]; r.sq[ai * 4 + m] = s * s;
      }
    return r;
  }
  __device__ __forceinline__ void operator()(const f32x4 (&acc)[2][2][4][2], int brow, int bcol, const Pre& pre) const {
    EPI_IDS
#pragma unroll
    for (int ai = 0; ai < 2; ++ai)
#pragma unroll
      for (int m = 0; m < 4; ++m) {
        const size_t off = (size_t)(row_base + brow + ai * HALF + wr * 64 + m * 16 + fr) * DM + bcol + 32 * wc + 4 * fq;
        float* dst = out + off; const float sq = pre.sq[ai * 4 + m];
#pragma unroll
        for (int bj = 0; bj < 2; ++bj)
#pragma unroll
          for (int n = 0; n < 2; ++n) {
            const unsigned a = pre.hv[ai][m][bj][n].x, b = pre.hv[ai][m][bj][n].y;
            f32x4 o;
            o[0] = __uint_as_float(a << 16) + acc[ai][bj][m][n][0] * sq; o[1] = __uint_as_float(a & 0xffff0000u) + acc[ai][bj][m][n][1] * sq;
            o[2] = __uint_as_float(b << 16) + acc[ai][bj][m][n][2] * sq; o[3] = __uint_as_float(b & 0xffff0000u) + acc[ai][bj][m][n][3] * sq;
            *(f32x4*)(dst + 128 * bj + 16 * n) = o;
          }
      }
  }
};

__device__ __forceinline__ void p0_transpose_item(const float* __restrict__ W, int K, int N, bf16_t* __restrict__ WT, const float* __restrict__ g0, const float* __restrict__ g1, float* scr, int item, int lane, int mode, int ldw = 0  ) {
  const int nblk = N / 32, kb = item / nblk, nb = item % nblk, k0 = 64 * kb, n0 = 32 * nb;
#pragma unroll 8
  for (int i = 0; i < 32; ++i) {
    const int kk = 2 * i + (lane >> 5), k = k0 + kk;
    float gv = 1.f; if (g0) gv = (g1 && k >= 512) ? g1[k - 512] : g0[k];
    scr[kk * 33 + (lane & 31)] = __builtin_nontemporal_load(W + (size_t)k * N + n0 + (lane & 31)) * gv;
  }
  asm volatile("s_waitcnt lgkmcnt(0)" ::: "memory");
  const int c = lane & 7;
#pragma unroll
  for (int j = 0; j < 4; ++j) {
    const int n = (lane >> 3) + 8 * j; const float* s = scr + (8 * c) * 33 + n;
    u32x4 o; o.x = pk2(s[0 * 33], s[1 * 33]); o.y = pk2(s[2 * 33], s[3 * 33]); o.z = pk2(s[4 * 33], s[5 * 33]); o.w = pk2(s[6 * 33], s[7 * 33]);
    const int col = n0 + n, drow = (col & ~255) + col_slot(col & 255, mode);
    if (ldw < 0) *(u32x4*)(WT + ((((size_t)(drow >> 8) * (K / 64) + kb) * 256 + (drow & 255)) * 64 + 8 * c)) = o;
    else *(u32x4*)(WT + (size_t)drow * (ldw ? ldw : K) + k0 + 8 * c) = o;
  }
  asm volatile("s_waitcnt lgkmcnt(0)" ::: "memory");
}

__device__ __forceinline__ void p0_prologue(const Params& p) {
  int tid = threadIdx.x; asm volatile("" : "+v"(tid));
  const int wave = tid >> 6, lane = tid & 63;
  const int gw = blockIdx.x * 8 + wave, NGW = gridDim.x * 8;
  float* scr = (float*)(g_shm + wave * 16384);
  bf16_t* WinT = (bf16_t*)(p.ws + WS_WIN); bf16_t* WoT = (bf16_t*)(p.ws + WS_WO); bf16_t* WupT = (bf16_t*)(p.ws + WS_WUP); bf16_t* WdT = (bf16_t*)(p.ws + WS_WDP);
  constexpr int I_IN = 16 * 72, I_O = 16 * 32, I_UP = 16 * 128, I_DN = 64 * 32, NIT = I_IN + I_O + I_UP + I_DN;
  for (int it = gw; it < NIT; it += NGW) {
    int r = it;
    if (r < I_IN) { p0_transpose_item(p.w_in, DM, INC, WinT, p.norm_attn, nullptr, scr, r, lane, 1); continue; } r -= I_IN;
    if (r < I_O) { p0_transpose_item(p.w_o, DM, DM, WoT, p.ona, p.onb, scr, r, lane, 1); continue; } r -= I_O;
    if (r < I_UP) { p0_transpose_item(p.w_up, DM, DFF, WupT, p.norm_mlp, nullptr, scr, r, lane, 1); continue; } r -= I_UP;
    p0_transpose_item(p.w_down, DFF, DM, WdT, nullptr, nullptr, scr, r, lane, 2, -1);
  }
  bf16_t* xb = (bf16_t*)(p.ws + WS_X); float* rs1 = (float*)(p.ws + WS_RS1);
  for (int row4 = gw * 4; row4 < NTOK; row4 += NGW * 4) {
    f32x4 v[4][4];
#pragma unroll
    for (int r = 0; r < 4; ++r) {
      const int row = row4 + r;
      const float* xr = (row < NPROMPT) ? (p.xp + (size_t)row * DM) : (p.xs + (size_t)(row - NPROMPT) * DM);
#pragma unroll
      for (int j = 0; j < 4; ++j) v[r][j] = __builtin_nontemporal_load((const f32x4*)(xr + 256 * j + 4 * lane));
    }
#pragma unroll
    for (int r = 0; r < 4; ++r) {
      const int row = row4 + r; float s = 0.f;
#pragma unroll
      for (int j = 0; j < 4; ++j) s += (v[r][j][0] * v[r][j][0] + v[r][j][1] * v[r][j][1]) + (v[r][j][2] * v[r][j][2] + v[r][j][3] * v[r][j][3]);
#pragma unroll
      for (int o = 1; o < 64; o <<= 1) s += __shfl_xor(s, o);
#pragma unroll
      for (int j = 0; j < 4; ++j) { u32x2 w; w.x = pk2(v[r][j][0], v[r][j][1]); w.y = pk2(v[r][j][2], v[r][j][3]); *(u32x2*)(xb + (size_t)row * DM + 256 * j + 4 * lane) = w; }
      if (lane == 0) rs1[row] = rsqrtf(s * (1.0f / DM) + EPS);
    }
  }
}

struct ChunkSrc { int rowc, d, M, kc0; };

__device__ __forceinline__ void issue_chunk(const bf16_t* __restrict__ qkv, const ChunkSrc cs, int koff, int voff, int lane, unsigned char* slot) {
  const unsigned ck = (unsigned)(koff * 2), cv = (unsigned)(voff * 2);
#pragma unroll
  for (int i = 0; i < 4; ++i) {
    const int r = (lane >> 3) + 8 * i;
    int kc = cs.kc0 + r; kc = kc < 0 ? 0 : (kc > cs.M - 1 ? cs.M - 1 : kc);
    const unsigned row = __umul24((unsigned)cs.d, (unsigned)kc) + (unsigned)cs.rowc;
    const unsigned rb = __umul24(row, (unsigned)(INC * 2));
    const unsigned chk = (unsigned)(((lane & 7) ^ ((r >> 1) & 7)) << 4), chv = (unsigned)(((lane & 7) ^ (((r >> 1) & 3) << 1)) << 4);
    __builtin_amdgcn_global_load_lds((const __attribute__((address_space(1))) unsigned*)((const char*)qkv + (rb + (ck + chk))), (LAS unsigned*)(slot + i * 1024), 16, 0, 0);
    __builtin_amdgcn_global_load_lds((const __attribute__((address_space(1))) unsigned*)((const char*)qkv + (rb + (cv + chv))), (LAS unsigned*)(slot + 4096 + i * 1024), 16, 0, 0);
  }
}
__device__ __forceinline__ void read_vt(unsigned a0, unsigned a1, unsigned a2, unsigned a3, bf16x8 (&Vt)[4]) {
  u32x2 r00, r01, r10, r11, r20, r21, r30, r31;
  asm volatile(
      "ds_read_b64_tr_b16 %0, %8\n\tds_read_b64_tr_b16 %1, %8 offset:2048\n\t"
      "ds_read_b64_tr_b16 %2, %9\n\tds_read_b64_tr_b16 %3, %9 offset:2048\n\t"
      "ds_read_b64_tr_b16 %4, %10\n\tds_read_b64_tr_b16 %5, %10 offset:2048\n\t"
      "ds_read_b64_tr_b16 %6, %11\n\tds_read_b64_tr_b16 %7, %11 offset:2048\n\t"
      "s_waitcnt lgkmcnt(0)"
      : "=&v"(r00), "=&v"(r01), "=&v"(r10), "=&v"(r11), "=&v"(r20), "=&v"(r21), "=&v"(r30), "=&v"(r31)
      : "v"(a0), "v"(a1), "v"(a2), "v"(a3) : "memory");
  u32x4 t;
  t.x = r00.x; t.y = r00.y; t.z = r01.x; t.w = r01.y; Vt[0] = __builtin_bit_cast(bf16x8, t);
  t.x = r10.x; t.y = r10.y; t.z = r11.x; t.w = r11.y; Vt[1] = __builtin_bit_cast(bf16x8, t);
  t.x = r20.x; t.y = r20.y; t.z = r21.x; t.w = r21.y; Vt[2] = __builtin_bit_cast(bf16x8, t);
  t.x = r30.x; t.y = r30.y; t.z = r31.x; t.w = r31.y; Vt[3] = __builtin_bit_cast(bf16x8, t);
}
__device__ __forceinline__ void tile_chunk(const bf16x8 (&Kf)[2][2], const bf16x8 (&Q)[2], const bf16x8 (&Vt)[4], f32x4 (&o)[4], f32x4& l, int kcl, int lo, unsigned span, float negm) {
  f32x4 s0 = {negm, negm, negm, negm}, s1 = s0;
  s0 = mfma16(Kf[0][0], Q[0], s0); s0 = mfma16(Kf[0][1], Q[1], s0);
  s1 = mfma16(Kf[1][0], Q[0], s1); s1 = mfma16(Kf[1][1], Q[1], s1);
  float pv[8];
#pragma unroll
  for (int j = 0; j < 4; ++j) {
    pv[j] = ((unsigned)(kcl + j - lo) <= span) ? __builtin_amdgcn_exp2f(s0[j]) : 0.f;
    pv[4 + j] = ((unsigned)(kcl + 16 + j - lo) <= span) ? __builtin_amdgcn_exp2f(s1[j]) : 0.f;
  }
  u32x4 pk; pk.x = pk2(pv[0], pv[1]); pk.y = pk2(pv[2], pv[3]); pk.z = pk2(pv[4], pv[5]); pk.w = pk2(pv[6], pv[7]);
  const bf16x8 P = __builtin_bit_cast(bf16x8, pk);
#pragma unroll
  for (int dt = 0; dt < 4; ++dt) o[dt] = mfma16(Vt[dt], P, o[dt]);
  const bf16x8 ones = {(short)0x3F80, (short)0x3F80, (short)0x3F80, (short)0x3F80, (short)0x3F80, (short)0x3F80, (short)0x3F80, (short)0x3F80};
  l = mfma16(ones, P, l);
}

template <int TMASK, class DESC>
__device__ __forceinline__ void run_branch(const bf16_t* __restrict__ qkv, const DESC& desc, int& gi, const int total, const int nchunks, const int M, const int kstart, int koff, int voff,
                                           int qcb, int qstep, int hw, float negm, int lane, unsigned char* ring, const bf16x8 (&Q)[4][2], f32x4 (&o)[4][4], f32x4 (&l)[4]) {
  const int g = lane >> 4;
  int lo[4]; unsigned span[4];
#pragma unroll
  for (int t = 0; t < 4; ++t) { const int qc = qcb + t * qstep; lo[t] = qc - hw < 0 ? 0 : qc - hw; const int hi = qc + hw > M - 1 ? M - 1 : qc + hw; span[t] = (unsigned)(hi - lo[t]); }
  const int qp = (lane & 15) >> 2, pp = lane & 3, rl = 4 * g + qp, f = (rl >> 1) & 3;
  const unsigned vbase = (unsigned)(size_t)ring + 4096 + rl * 128 + pp * 8;
  const unsigned a0 = vbase + ((0 ^ f) << 5), a1 = vbase + ((1 ^ f) << 5), a2 = vbase + ((2 ^ f) << 5), a3 = vbase + ((3 ^ f) << 5);
  const int krow = lane & 15;
  const LAS unsigned char* kb0 = (const LAS unsigned char*)ring + krow * 128 + (((0 + g) ^ (krow >> 1)) << 4);
  const LAS unsigned char* kb1 = (const LAS unsigned char*)ring + krow * 128 + (((4 + g) ^ (krow >> 1)) << 4);
#pragma unroll 1
  for (int c = 0; c < nchunks; ++c, ++gi) {
    const unsigned soff = (unsigned)(gi & (ATT_SLOTS - 1)) * 8192u;
    bf16x8 Kf[2][2];
    if constexpr (ATT_LA == 1) {
      asm volatile("s_waitcnt vmcnt(0)" ::: "memory");
      Kf[0][0] = *(const LAS bf16x8*)(kb0 + soff); Kf[0][1] = *(const LAS bf16x8*)(kb1 + soff);
      Kf[1][0] = *(const LAS bf16x8*)(kb0 + soff + 2048); Kf[1][1] = *(const LAS bf16x8*)(kb1 + soff + 2048);
      if (gi + 1 < total) issue_chunk(qkv, desc(gi + 1), koff, voff, lane, ring + ((gi + 1) & 1) * 8192);
    } else {
      if (gi + ATT_LA < total) issue_chunk(qkv, desc(gi + ATT_LA), koff, voff, lane, ring + ((gi + ATT_LA) & (ATT_SLOTS - 1)) * 8192);
      const int rem = total - 1 - gi;
      if (ATT_LA >= 3 && rem >= 3) asm volatile("s_waitcnt vmcnt(24)" ::: "memory");
      else if (ATT_LA >= 2 && rem >= 2) asm volatile("s_waitcnt vmcnt(16)" ::: "memory");
      else if (rem >= 1) asm volatile("s_waitcnt vmcnt(8)" ::: "memory");
      else asm volatile("s_waitcnt vmcnt(0)" ::: "memory");
      Kf[0][0] = *(const LAS bf16x8*)(kb0 + soff); Kf[0][1] = *(const LAS bf16x8*)(kb1 + soff);
      Kf[1][0] = *(const LAS bf16x8*)(kb0 + soff + 2048); Kf[1][1] = *(const LAS bf16x8*)(kb1 + soff + 2048);
    }
    bf16x8 Vt[4];
    read_vt(a0 + soff, a1 + soff, a2 + soff, a3 + soff, Vt);
    const int kcl = kstart + 32 * c + 4 * g;
#pragma unroll
    for (int t = 0; t < 4; ++t)
      if (TMASK & (1 << t)) tile_chunk(Kf, Q[t], Vt, o[t], l[t], kcl, lo[t], span[t], negm);
  }
}

__device__ __forceinline__ float wave_max(float v) {
#pragma unroll
  for (int o = 1; o < 64; o <<= 1) v = fmaxf(v, __shfl_xor(v, o));
  return v;
}

__device__ __forceinline__ void attn_phase(const Params& p) {
  int tid = threadIdx.x; asm volatile("" : "+v"(tid));
  const int wave = __builtin_amdgcn_readfirstlane(tid >> 6), lane = tid & 63, qi = lane & 15, g = lane >> 4;
  if (wave >= ATT_NACT) return;
  const bf16_t* qkv = (const bf16_t*)(p.ws + WS_QKV);
  bf16_t* mix = (bf16_t*)(p.ws + WS_X);
  float* ssqh = (float*)(p.ws + WS_SSQH);
  unsigned char* ring = g_shm + wave * (ATT_SLOTS * 8192);
  const float mfixA = 8.0f * LOG2E * wave_max(fabsf(p.qna[lane])) * wave_max(fabsf(p.kna[lane]));
  const float mfixB = 8.0f * LOG2E * wave_max(fabsf(p.qnb[lane])) * wave_max(fabsf(p.knb[lane]));
  const int xcd = blockIdx.x & 7, wx = (blockIdx.x >> 3) * ATT_NACT + wave, nwx = (gridDim.x >> 3) * ATT_NACT;
  for (int li = wx; li < 2048; li += nwx) {
    const int kind = (li / nwx) & 1;
    const int lk = ((li / nwx) >> 1) * nwx + (li % nwx);
    const int grp = xcd * 128 + (lk & 127), sub = lk >> 7;
    const int r64 = grp * 64;
    const int S = r64 < NPROMPT ? 2048 : 4096;
    const int row0 = r64 & ~(S - 1);
    bf16x8 Q[4][2]; f32x4 o[4][4]; f32x4 l[4];
#pragma unroll
    for (int t = 0; t < 4; ++t) {
#pragma unroll
      for (int dt = 0; dt < 4; ++dt) o[t][dt] = (f32x4){0.f, 0.f, 0.f, 0.f};
    }
    int tok[4], colb[4];
    int gi = 0;
    if (kind == 0) {
      const int sidx = (r64 - row0) >> 6, c4 = sidx & 3, p0 = (sidx >> 2) * 16, h = sub;
#pragma unroll
      for (int t = 0; t < 4; ++t) {
        tok[t] = 16 * (p0 + qi) + c4 + 4 * t; colb[t] = h * 64; l[t] = (f32x4){0.f, 0.f, 0.f, 0.f};
        const bf16_t* rp = qkv + (size_t)(row0 + tok[t]) * INC + h * 64 + g * 8;
        Q[t][0] = *(const bf16x8*)rp; Q[t][1] = *(const bf16x8*)(rp + 32);
      }
      const int koff = 512 + h * 64, voff = 1024 + h * 64;
      auto desc = [=](int i) -> ChunkSrc {
        ChunkSrc r;
        if (i < 12) { r.rowc = row0; r.d = 1; r.M = S; r.kc0 = 16 * p0 - 64 + 32 * i; }
        else if (i < 18) { r.rowc = row0 + c4; r.d = 4; r.M = S >> 2; r.kc0 = 4 * p0 - 64 + 32 * (i - 12); }
        else { const int j = i - 18, t = j / 5, c = j - 5 * t; r.rowc = row0 + c4 + 4 * t; r.d = 16; r.M = S >> 4; r.kc0 = p0 - 64 + 32 * c; }
        return r;
      };
      constexpr int TOTAL = 38;
#pragma unroll
      for (int i = 0; i < ATT_LA; ++i) issue_chunk(qkv, desc(i), koff, voff, lane, ring + i * 8192);
      run_branch<15>(qkv, desc, gi, TOTAL, 12, S, 16 * p0 - 64, koff, voff, 16 * (p0 + qi) + c4, 4, 64, -mfixA, lane, ring, Q, o, l);
      run_branch<15>(qkv, desc, gi, TOTAL, 6, S >> 2, 4 * p0 - 64, koff, voff, 4 * (p0 + qi), 1, 64, -mfixA, lane, ring, Q, o, l);
      run_branch<1>(qkv, desc, gi, TOTAL, 5, S >> 4, p0 - 64, koff, voff, p0 + qi, 0, 64, -mfixA, lane, ring, Q, o, l);
      run_branch<2>(qkv, desc, gi, TOTAL, 5, S >> 4, p0 - 64, koff, voff, p0 + qi, 0, 64, -mfixA, lane, ring, Q, o, l);
      run_branch<4>(qkv, desc, gi, TOTAL, 5, S >> 4, p0 - 64, koff, voff, p0 + qi, 0, 64, -mfixA, lane, ring, Q, o, l);
      run_branch<8>(qkv, desc, gi, TOTAL, 5, S >> 4, p0 - 64, koff, voff, p0 + qi, 0, 64, -mfixA, lane, ring, Q, o, l);
    } else {
      const int kvh = sub & 1, qsub = sub >> 1, q0 = (r64 - row0) + 16 * qsub;
#pragma unroll
      for (int t = 0; t < 4; ++t) {
        const int hq = kvh * 4 + t;
        tok[t] = q0 + qi; colb[t] = 512 + hq * 64;
        { const float sk = __builtin_amdgcn_exp2f(p.sink[hq] * LOG2E - mfixB); l[t] = (f32x4){sk, sk, sk, sk}; }
        const bf16_t* rp = qkv + (size_t)(row0 + tok[t]) * INC + 1536 + hq * 64 + g * 8;
        Q[t][0] = *(const bf16x8*)rp; Q[t][1] = *(const bf16x8*)(rp + 32);
      }
      const int koff = 2048 + kvh * 64, voff = 2176 + kvh * 64;
      auto desc = [=](int i) -> ChunkSrc { ChunkSrc r; r.rowc = row0; r.d = 1; r.M = S; r.kc0 = q0 - 128 + 32 * i; return r; };
      constexpr int TOTAL = 9;
#pragma unroll
      for (int i = 0; i < ATT_LA; ++i) issue_chunk(qkv, desc(i), koff, voff, lane, ring + i * 8192);
      run_branch<15>(qkv, desc, gi, TOTAL, 9, S, q0 - 128, koff, voff, q0 + qi, 0, 128, -mfixB, lane, ring, Q, o, l);
    }
#pragma unroll
    for (int t = 0; t < 4; ++t) {
      const float L = l[t][0];
      const float inv = 1.0f / L; float ss = 0.f;
#pragma unroll
      for (int dt = 0; dt < 4; ++dt)
#pragma unroll
        for (int j = 0; j < 4; ++j) { const float x = o[t][dt][j] * inv; o[t][dt][j] = x; ss += x * x; }
      ss += __shfl_xor(ss, 16); ss += __shfl_xor(ss, 32);
      const size_t row = (size_t)(row0 + tok[t]);
      if (g == 0) ssqh[row * 16 + (colb[t] >> 6)] = ss;
      bf16_t* dst = mix + row * DM + colb[t] + 4 * g;
#pragma unroll
      for (int dt = 0; dt < 4; ++dt) { u32x2 w; w.x = pk2(o[t][dt][0], o[t][dt][1]); w.y = pk2(o[t][dt][2], o[t][dt][3]); *(u32x2*)(dst + 16 * dt) = w; }
    }
  }
}

#define XB_TMO      128
#define XB_XCNT(j)  (256  + 64 * (j))
#define XB_XSUB(j)  (1280 + 64 * (j))
#define XB_XGEN(j)  (2304 + 64 * (j))
#define XB_TOP      3328
#define XB_TOPGEN   3392
#define XCD_BAR_WORDS 3456
#define XB_SPIN_CAP (1u << 18)
__device__ __forceinline__ unsigned xb_ld(unsigned* p)              { return __hip_atomic_load(p, __ATOMIC_RELAXED, __HIP_MEMORY_SCOPE_AGENT); }
__device__ __forceinline__ unsigned xb_add(unsigned* p, unsigned v) { return __hip_atomic_fetch_add(p, v, __ATOMIC_RELAXED, __HIP_MEMORY_SCOPE_AGENT); }
__device__ __forceinline__ unsigned xb_xcc_id() { return (unsigned)__builtin_amdgcn_s_getreg((3 << 11) | 20) & 0xFu; }
#define XB_SPIN(cond, bar) do { unsigned _sp = 0; while (cond) { __builtin_amdgcn_s_sleep(1); \
    if ((++_sp & 255u) == 0u) { if (xb_ld(&(bar)[XB_TMO])) break; if (_sp > XB_SPIN_CAP) { atomicAdd(&(bar)[XB_TMO], 1u); break; } } } } while (0)
struct XcdBarrier { unsigned* bar; unsigned x; volatile LAS unsigned* st; };
__device__ __forceinline__ XcdBarrier xcd_barrier_post(unsigned* bar, volatile LAS unsigned* st) {
  XcdBarrier b; b.bar = bar; b.x = xb_xcc_id(); b.st = st;
  if (threadIdx.x == 0) (void)xb_add(&bar[XB_XCNT(b.x)], 1u);
  return b;
}
__device__ __forceinline__ void xcd_barrier_complete(unsigned* bar, unsigned x, unsigned& nloc, unsigned& nx) {
  const unsigned G = gridDim.x * gridDim.y * gridDim.z;
  unsigned sum, cnt, mine, sp = 0u;
  for (;;) {
    sum = 0u; cnt = 0u; mine = 0u;
#pragma unroll
    for (unsigned j = 0; j < 16; ++j) { const unsigned c = xb_ld(&bar[XB_XCNT(j)]); sum += c; cnt += (c > 0u) ? 1u : 0u; mine = (j == x) ? c : mine; }
    if (sum == G) break;
    __builtin_amdgcn_s_sleep(1);
    if ((++sp & 255u) == 0u) { if (xb_ld(&bar[XB_TMO])) break; if (sp > XB_SPIN_CAP) { atomicAdd(&bar[XB_TMO], 1u); break; } }
  }
  nloc = mine > 0u ? mine : 1u; nx = cnt > 0u ? cnt : 1u;
}
__device__ __forceinline__ void xcd_barrier_impl(const XcdBarrier& b) {
  asm volatile("s_waitcnt vmcnt(0)" ::: "memory");
  __syncthreads();
  if (threadIdx.x == 0) {
    unsigned* bar = b.bar;
    __builtin_amdgcn_s_waitcnt(0);
    unsigned nloc = b.st[0], nx = b.st[1];
    if (nloc == 0u) { xcd_barrier_complete(bar, b.x, nloc, nx); b.st[0] = nloc; b.st[1] = nx; }
    const unsigned old = xb_add(&bar[XB_XSUB(b.x)], 1u);
    const unsigned gen = old / nloc;
    if (old + 1u == (gen + 1u) * nloc) {
      __builtin_amdgcn_fence(__ATOMIC_RELEASE, "agent");
      asm volatile("s_waitcnt vmcnt(0)" ::: "memory");
      const unsigned og = xb_add(&bar[XB_TOP], 1u);
      const unsigned tg = og / nx;
      if (og + 1u == (tg + 1u) * nx) xb_add(&bar[XB_TOPGEN], 1u);
      else XB_SPIN(xb_ld(&bar[XB_TOPGEN]) == tg, bar);
      __builtin_amdgcn_fence(__ATOMIC_ACQUIRE, "agent");
      xb_add(&bar[XB_XGEN(b.x)], 1u);
      asm volatile("s_waitcnt vmcnt(0)" ::: "memory");
    } else {
      XB_SPIN(xb_ld(&bar[XB_XGEN(b.x)]) == gen, bar);
      __builtin_amdgcn_fence(__ATOMIC_ACQUIRE, "agent");
      asm volatile("s_waitcnt vmcnt(0)" ::: "memory");
    }
  }
  __syncthreads();
}

__device__ __forceinline__ void xcd_barrier(unsigned char* ws) {
  XcdBarrier b; b.bar = (unsigned*)(ws + WS_BAR); b.x = xb_xcc_id(); b.st = (volatile LAS unsigned*)((LAS unsigned char*)g_shm + GEMM_LDS_BYTES);
  xcd_barrier_impl(b);
}

typedef const __attribute__((address_space(4))) Params* KArgs;
__device__ __forceinline__ Params load_params() {
#if defined(__HIP_DEVICE_COMPILE__)
  KArgs kp = (KArgs)__builtin_amdgcn_kernarg_segment_ptr();
  asm volatile("" : "+s"(kp));
  Params r;
  r.xp = kp->xp; r.xs = kp->xs; r.norm_attn = kp->norm_attn; r.w_in = kp->w_in; r.qna = kp->qna; r.kna = kp->kna; r.qnb = kp->qnb; r.knb = kp->knb; r.sink = kp->sink;
  r.ona = kp->ona; r.onb = kp->onb; r.w_o = kp->w_o; r.norm_mlp = kp->norm_mlp; r.w_up = kp->w_up; r.w_down = kp->w_down; r.out = kp->out; r.ws = kp->ws;
  return r;
#else
  return Params{};
#endif
}

__global__ void __launch_bounds__(512) fwd_megakernel(Params p_unused) {
  cg::grid_group grid = cg::this_grid();
  {
    const Params p = load_params();
    volatile LAS unsigned* xst = (volatile LAS unsigned*)((LAS unsigned char*)g_shm + GEMM_LDS_BYTES);
    if (threadIdx.x == 0) { xst[0] = 0u; xst[1] = 0u; }
    (void)xcd_barrier_post((unsigned*)(p.ws + WS_BAR), xst);
    p0_prologue(p);
    if (p.ws == nullptr) grid.sync();
    xcd_barrier(p.ws);
  }
  {
    const Params p = load_params();
    EpiQKV e{(bf16_t*)(p.ws + WS_QKV), (const float*)(p.ws + WS_RS1), p.qna, p.kna, p.qnb, p.knb};
    gemm_phase<EpiQKV, GEMM_ALIGN, GEMM_SP2>((const bf16_t*)(p.ws + WS_X), (const bf16_t*)(p.ws + WS_WIN), NTOK, INC, DM, e);
    xcd_barrier(p.ws);
  }
  {
    const Params p = load_params();
    attn_phase(p);
    xcd_barrier(p.ws);
  }
  {
    const Params p = load_params();
    EpiWo e{p.xp, p.xs, (bf16_t*)(p.ws + WS_HB), (float*)(p.ws + WS_SSQ2), (const float*)(p.ws + WS_SSQH)};
    gemm_phase<EpiWo, GEMM_ALIGN, GEMM_SP2, true>((const bf16_t*)(p.ws + WS_X), (const bf16_t*)(p.ws + WS_WO), NTOK, DM, DM, e);
    xcd_barrier(p.ws);
    { const float* sp = (const float*)(p.ws + WS_SSQ2); float* s2 = (float*)(p.ws + WS_RS1);
      for (int row = blockIdx.x * 512 + threadIdx.x; row < NTOK; row += gridDim.x * 512) {
        const f32x4 a = *(const f32x4*)(sp + (size_t)row * 16), b = *(const f32x4*)(sp + (size_t)row * 16 + 4), c = *(const f32x4*)(sp + (size_t)row * 16 + 8), d = *(const f32x4*)(sp + (size_t)row * 16 + 12);
        const float tot = (((a[0] + a[1]) + (a[2] + a[3])) + ((b[0] + b[1]) + (b[2] + b[3]))) + (((c[0] + c[1]) + (c[2] + c[3])) + ((d[0] + d[1]) + (d[2] + d[3])));
        s2[row] = rsqrtf(tot * (1.0f / DM) + EPS);
      } }
    xcd_barrier(p.ws);
  }
  for (int half = 0; half < 2; ++half) {
    const int rb = half * NPROMPT;
    {
      const Params p = load_params();
      EpiUp e{(bf16_t*)(p.ws + WS_U)};
      gemm_phase<EpiUp, GEMM_ALIGN, GEMM_SP2>((const bf16_t*)(p.ws + WS_HB) + (size_t)rb * DM, (const bf16_t*)(p.ws + WS_WUP), NPROMPT, DFF, DM, e);
      xcd_barrier(p.ws);
    }
    {
      const Params p = load_params();
      EpiDown e{(const bf16_t*)(p.ws + WS_HB), p.out, (const float*)(p.ws + WS_RS1), rb};
      gemm_phase<EpiDown, GEMM_ALIGN, GEMM_SP2>((const bf16_t*)(p.ws + WS_U), (const bf16_t*)(p.ws + WS_WDP), NPROMPT, DM, DFF, e, -1);
      if (half == 0) xcd_barrier(p.ws);
    }
  }
}

extern "C" void kernel_launch(void* const* d_in, const int* in_sizes, int n_in, void* d_out, int out_size, void* d_ws, size_t ws_size, hipStream_t stream) {
  static int grid_blocks = 0;
  if (!grid_blocks) {
    if (n_in != 15 || ws_size < WS_NEED) { fprintf(stderr, "kernel_launch: unexpected n_in %d / ws_size %zu\n", n_in, ws_size); grid_blocks = -1; return; }
    int dev = 0, cus = 0, per_cu = 0;
    hipGetDevice(&dev);
    hipDeviceGetAttribute(&cus, hipDeviceAttributeMultiprocessorCount, dev);
    if (hipFuncSetAttribute((const void*)fwd_megakernel, hipFuncAttributeMaxDynamicSharedMemorySize, LDS_BYTES) != hipSuccess) { fprintf(stderr, "hipFuncSetAttribute failed\n"); grid_blocks = -1; return; }
    hipOccupancyMaxActiveBlocksPerMultiprocessor(&per_cu, (const void*)fwd_megakernel, 512, LDS_BYTES);
    if (per_cu < 1) { fprintf(stderr, "occupancy query says %d blocks/CU\n", per_cu); per_cu = 1; }
    (void)hipGetLastError();
    grid_blocks = cus;
  }
  if (grid_blocks < 0) return;
  if (hipMemsetAsync((char*)d_ws + WS_BAR, 0, 16384, stream) != hipSuccess) { fprintf(stderr, "hipMemsetAsync of the barrier words failed\n"); return; }
  Params p{};
  p.xp = (const float*)d_in[0]; p.xs = (const float*)d_in[1]; p.norm_attn = (const float*)d_in[2]; p.w_in = (const float*)d_in[3];
  p.qna = (const float*)d_in[4]; p.kna = (const float*)d_in[5]; p.qnb = (const float*)d_in[6]; p.knb = (const float*)d_in[7];
  p.sink = (const float*)d_in[8]; p.ona = (const float*)d_in[9]; p.onb = (const float*)d_in[10]; p.w_o = (const float*)d_in[11];
  p.norm_mlp = (const float*)d_in[12]; p.w_up = (const float*)d_in[13]; p.w_down = (const float*)d_in[14];
  p.out = (float*)d_out; p.ws = (unsigned char*)d_ws;
  void* args[] = {&p};
  hipError_t e = hipLaunchCooperativeKernel((const void*)fwd_megakernel, dim3(grid_blocks), dim3(512), args, LDS_BYTES, stream);
  if (e != hipSuccess) fprintf(stderr, "cooperative launch failed: %s (grid %d)\n", hipGetErrorString(e), grid_blocks);
}
```
